# Optimizing an MI355X kernel written in HIP

```python
import math
import jax, jax.numpy as jnp
from jax import lax
import numpy as np

D_MODEL = 1024
BATCH = 16
SEQ = 256
DEPTH = 4
DEC_BATCH = 8
DEC_SEQ = 1024
PAST_LEN = 256

GRID_W = 64
N_MOD = 9
FFN_HIDDEN = 2816
NORM_EPS = 1e-6

GLA_HEADS = 6
GLA_DK = 32
GLA_DV = 64
GLA_QK = GLA_HEADS * GLA_DK
GLA_WIDTH = GLA_HEADS * GLA_DV
GLA_RANK = 16
GLA_TAU = 16.0
GLA_CHUNK = 64
GLA_COLS = 2 * GLA_QK + 2 * GLA_WIDTH + 2 * GLA_RANK

HY_WIDTH = 256
HY_BANDS = 16
HY_EMB = 1 + 2 * HY_BANDS
HY_HIDDEN = 64
HY_CONV_W = 3
HY_TARGET = 1e-2
HY_FAST = 0.3
HY_SLOW = 1.5
HY_COLS = 3 * HY_WIDTH

RW_HEADS = 6
RW_N = 64
RW_WIDTH = RW_HEADS * RW_N
RW_DECAY_RANK = 32
RW_AAA_RANK = 32
RW_GATE_RANK = 64
RW_LN_EPS = 64e-5
RW_COLS = 3 * RW_WIDTH + 2 * RW_DECAY_RANK + RW_AAA_RANK + RW_GATE_RANK

MIX_WIDTH = GLA_WIDTH + HY_WIDTH + RW_WIDTH
IN_COLS = GLA_COLS + HY_COLS + RW_COLS

kernel_name = 'hymba_gla_hyena_rwkv7_flow_backbone_step'


def _split(x, widths):
    idx = [int(s) for s in np.cumsum(widths)[:-1]]
    return jnp.split(x, idx, axis=-1)


def _shift_prev(x):
    return jnp.pad(x[:, :-1], ((0, 0), (1, 0), (0, 0)))


def _shift_next(x):
    return jnp.pad(x[:, 1:], ((0, 0), (0, 1), (0, 0)))


def _flip(t):
    return t[:, ::-1]


def _rmsnorm(x, gain):
    xf = x.astype(jnp.float32)
    y = xf * lax.rsqrt(jnp.mean(xf * xf, axis=-1, keepdims=True) + NORM_EPS)
    return (y * gain).astype(x.dtype)


def _swiglu(h, w_in, w_out):
    gate, up = jnp.split(h @ w_in, 2, axis=-1)
    return (jax.nn.silu(gate) * up) @ w_out


def _adaln(cond, w, b):
    mod = jax.nn.silu(cond) @ w + b
    return mod.reshape(cond.shape[0], N_MOD, D_MODEL)


def _grid_transpose(x, rows, cols):
    b_sz, seq_len, ch = x.shape
    return x.reshape(b_sz, rows, cols, ch).transpose(0, 2, 1, 3).reshape(b_sz, seq_len, ch)


def _gla_direction(q, k, v, log_a, s0):
    b_sz, seq_len = q.shape[0], q.shape[1]
    n_chunks = seq_len // GLA_CHUNK

    def chunks(t):
        return t.reshape(b_sz, n_chunks, GLA_CHUNK, t.shape[2], t.shape[3])

    q, k, v, log_a = chunks(q), chunks(k), chunks(v), chunks(log_a)
    cum = jnp.cumsum(log_a, axis=2)
    q_dec = q * jnp.exp(cum)
    k_dec = k * jnp.exp(-cum)
    causal = jnp.tril(jnp.ones((GLA_CHUNK, GLA_CHUNK), jnp.float32))
    att = jnp.einsum('bnihd,bnjhd->bnhij', q_dec, k_dec) * causal
    o_intra = jnp.einsum('bnhij,bnjhe->bnihe', att, v)
    cum_last = cum[:, :, -1]
    k_to_end = k * jnp.exp(cum_last[:, :, None] - cum)
    chunk_update = jnp.einsum('bnjhd,bnjhe->bnhde', k_to_end, v)

    def step(state, inp):
        decay_c, update_c = inp
        return state * decay_c[..., None] + update_c, state

    s_final, s_start = lax.scan(step, s0, (jnp.moveaxis(jnp.exp(cum_last), 1, 0),
                                           jnp.moveaxis(chunk_update, 1, 0)))
    o_inter = jnp.einsum('bnihd,bnhde->bnihe', q_dec, jnp.moveaxis(s_start, 0, 1))
    o = (o_intra + o_inter).reshape(b_sz, seq_len, v.shape[3], v.shape[4])
    return o, s_final


def _gla_mixer(p, lp, s0):
    b_sz, seq_len, _ = p.shape
    q, k, v, g, lr = _split(p, [GLA_QK, GLA_QK, GLA_WIDTH, GLA_WIDTH, 2 * GLA_RANK])
    q = q.reshape(b_sz, seq_len, GLA_HEADS, GLA_DK) * (GLA_DK ** -0.5)
    k = k.reshape(b_sz, seq_len, GLA_HEADS, GLA_DK)
    v = v.reshape(b_sz, seq_len, GLA_HEADS, GLA_DV)
    lr = lr.reshape(b_sz, seq_len, 2, GLA_RANK)
    log_a = jax.nn.log_sigmoid(jnp.einsum('blzr,zrd->blzd', lr, lp['gla_alpha_w2']) + lp['gla_alpha_b']) / GLA_TAU
    log_a = log_a.astype(jnp.float32).reshape(b_sz, seq_len, 2, GLA_HEADS, GLA_DK)
    s0 = s0.astype(jnp.float32)
    o_f, s_f = _gla_direction(q, k, v, log_a[:, :, 0], s0[:, 0])
    o_b, s_b = _gla_direction(_flip(q), _flip(k), _flip(v), _flip(log_a[:, :, 1]), s0[:, 1])
    o = o_f + _flip(o_b)
    o = o * lax.rsqrt(jnp.mean(o * o, axis=-1, keepdims=True) + NORM_EPS) * lp['gla_norm']
    o = o.reshape(b_sz, seq_len, GLA_WIDTH) * jax.nn.silu(g)
    return o, jnp.stack([s_f, s_b], axis=1)


def _hyena_filter(seq_len, lp):
    t = jnp.linspace(0.0, 1.0, seq_len, dtype=jnp.float32)[:, None]
    w = 2.0 * math.pi * jnp.arange(seq_len, dtype=jnp.float32)[:, None] / seq_len
    f = jnp.linspace(1e-4, HY_BANDS - 1, HY_BANDS, dtype=jnp.float32)[None, :]
    z = jnp.concatenate([t, jnp.cos(f * w), -jnp.sin(f * w)], axis=-1)
    h = jnp.sin(lp['hy_freq'][0] * (z @ lp['hy_w1'] + lp['hy_b1']))
    h = jnp.sin(lp['hy_freq'][1] * (h @ lp['hy_w2'] + lp['hy_b2']))
    h = (h @ lp['hy_w3']).astype(jnp.float32)
    deltas = jnp.abs(jnp.linspace(math.log(HY_TARGET) / HY_SLOW, math.log(HY_TARGET) / HY_FAST,
                                  HY_WIDTH, dtype=jnp.float32))
    window = jnp.exp(-t * deltas[None, :])
    h_fwd = h[:, :HY_WIDTH] * window
    h_bwd = h[:, HY_WIDTH:] * window
    return jnp.concatenate([h_fwd, jnp.zeros((1, HY_WIDTH), jnp.float32), h_bwd[1:][::-1]], axis=0)


def _hyena_mixer(p, lp):
    seq_len = p.shape[1]
    cw = lp['hy_conv_w']
    u = _shift_prev(p) * cw[0] + p * cw[1] + _shift_next(p) * cw[2] + lp['hy_conv_b']
    x0, x1, v = _split(u, [HY_WIDTH, HY_WIDTH, HY_WIDTH])
    z = x1 * v
    filt = _hyena_filter(seq_len, lp)
    n_fft = 2 * seq_len
    zf = jnp.fft.rfft(z, n=n_fft, axis=1)
    hf = jnp.fft.rfft(filt, n=n_fft, axis=0)
    y = jnp.fft.irfft(zf * hf[None], n=n_fft, axis=1)[:, :seq_len] + z * lp['hy_bias']
    return x0 * y


def _rwkv_direction(r, w, k, v, a, b, s0):
    def step(state, inp):
        r_t, w_t, k_t, v_t, a_t, b_t = inp
        sa = jnp.einsum('bhvk,bhk->bhv', state, a_t)
        state = (state * w_t[:, :, None, :] + sa[..., None] * b_t[:, :, None, :]
                 + v_t[..., None] * k_t[:, :, None, :])
        return state, jnp.einsum('bhvk,bhk->bhv', state, r_t)

    xs = tuple(jnp.moveaxis(t, 1, 0) for t in (r, w, k, v, a, b))
    s_final, out = lax.scan(step, s0, xs)
    return jnp.moveaxis(out, 0, 1), s_final


def _rwkv_mixer(p, lp, s0, grid):
    b_sz, seq_len, _ = p.shape
    if grid:
        rows = seq_len // GRID_W
        p = _grid_transpose(p, rows, GRID_W)
    p = p + (0.5 * (_shift_prev(p) + _shift_next(p)) - p) * lp['rw_mu']
    r, k, v, wl, al, gl = _split(p, [RW_WIDTH, RW_WIDTH, RW_WIDTH, 2 * RW_DECAY_RANK, RW_AAA_RANK, RW_GATE_RANK])
    a = jax.nn.sigmoid(lp['rw_a0'] + al @ lp['rw_a2'])
    g = jax.nn.sigmoid(gl) @ lp['rw_g2']

    def heads(t):
        return t.reshape(b_sz, seq_len, RW_HEADS, RW_N)

    kk = heads(k * lp['rw_k_k'])
    kk = kk * lax.rsqrt(jnp.maximum(jnp.sum(kk * kk, axis=-1, keepdims=True), 1e-24))
    k = k * (1.0 + (a - 1.0) * lp['rw_k_a'])
    wl = wl.reshape(b_sz, seq_len, 2, RW_DECAY_RANK)
    w_log = -jax.nn.softplus(-(lp['rw_w0'] + jnp.einsum('blzr,zrd->blzd', jnp.tanh(wl), lp['rw_w2']))) - 0.5
    decay = jnp.exp(-jnp.exp(w_log.astype(jnp.float32))).reshape(b_sz, seq_len, 2, RW_HEADS, RW_N)
    r, k, v, a = heads(r), heads(k), heads(v), heads(a)
    a_vec, b_vec = -kk, kk * a
    s0 = s0.astype(jnp.float32)
    o_f, s_f = _rwkv_direction(r, decay[:, :, 0], k, v, a_vec, b_vec, s0[:, 0])
    o_b, s_b = _rwkv_direction(_flip(r), _flip(decay[:, :, 1]), _flip(k), _flip(v),
                               _flip(a_vec), _flip(b_vec), s0[:, 1])
    o = o_f + _flip(o_b)
    mu = jnp.mean(o, axis=-1, keepdims=True)
    var = jnp.mean(jnp.square(o - mu), axis=-1, keepdims=True)
    o = (o - mu) * lax.rsqrt(var + RW_LN_EPS)
    o = o * lp['rw_ln_w'].reshape(RW_HEADS, RW_N) + lp['rw_ln_b'].reshape(RW_HEADS, RW_N)
    bonus = jnp.sum(r * k * lp['rw_r_k'], axis=-1, keepdims=True) * v
    o = (o + bonus).reshape(b_sz, seq_len, RW_WIDTH) * g
    if grid:
        o = _grid_transpose(o, GRID_W, rows)
    return o, jnp.stack([s_f, s_b], axis=1)


def _token_mix(h, lp, gla_s0, rw_s0, grid):
    p = (h @ lp['mix_w_in']).astype(jnp.float32)
    p_gla, p_hy, p_rw = _split(p, [GLA_COLS, HY_COLS, RW_COLS])
    o_gla, s_gla = _gla_mixer(p_gla, lp, gla_s0)
    o_hy = _hyena_mixer(p_hy, lp)
    o_rw, s_rw = _rwkv_mixer(p_rw, lp, rw_s0, grid)
    o = jnp.concatenate([o_gla, o_hy, o_rw], axis=-1).astype(h.dtype)
    return o @ lp['mix_w_out'], s_gla, s_rw


def _trunk_layer(x, mod, lp, gla_s0, rw_s0, grid):
    sh1, sc1, gt1, sh2, sc2, gt2, sh3, sc3, gt3 = [mod[:, j, None, :] for j in range(N_MOD)]
    h = _rmsnorm(x, lp['ffn1_norm']) * (1.0 + sc1) + sh1
    x = x + 0.5 * gt1 * _swiglu(h, lp['ffn1_w_in'], lp['ffn1_w_out'])
    h = _rmsnorm(x, lp['mix_norm']) * (1.0 + sc2) + sh2
    m, s_gla, s_rw = _token_mix(h, lp, gla_s0, rw_s0, grid)
    x = x + gt2 * m
    h = _rmsnorm(x, lp['ffn2_norm']) * (1.0 + sc3) + sh3
    x = x + 0.5 * gt3 * _swiglu(h, lp['ffn2_w_in'], lp['ffn2_w_out'])
    return x, s_gla, s_rw


def setup_inputs(seed: int = 0) -> dict:
    key = jax.random.key(seed)
    ks = iter(jax.random.split(key, 64))

    def nrm(shape, scale):
        return jax.random.normal(next(ks), shape, jnp.float32) * scale

    def gain(shape):
        return 1.0 + nrm(shape, 0.02)

    return {
        'x_prompt': nrm((BATCH, SEQ, D_MODEL), 1.0),
        'x_sample': nrm((DEC_BATCH, DEC_SEQ, D_MODEL), 1.0),
        'state_gla': nrm((DEC_BATCH, DEPTH, 2, GLA_HEADS, GLA_DK, GLA_DV), 1.0),
        'state_rwkv': nrm((DEC_BATCH, DEPTH, 2, RW_HEADS, RW_N, RW_N), 1.0),
        'c': nrm((DEC_BATCH, D_MODEL), 1.0),
        'c_ctx': nrm((D_MODEL,), 1.0),
        'ada_w': nrm((DEPTH, D_MODEL, N_MOD * D_MODEL), 0.5 * D_MODEL ** -0.5),
        'ada_b': nrm((DEPTH, N_MOD * D_MODEL), 0.02),
        'ffn1_norm': gain((DEPTH, D_MODEL)),
        'ffn1_w_in': nrm((DEPTH, D_MODEL, 2 * FFN_HIDDEN), D_MODEL ** -0.5),
        'ffn1_w_out': nrm((DEPTH, FFN_HIDDEN, D_MODEL), FFN_HIDDEN ** -0.5),
        'mix_norm': gain((DEPTH, D_MODEL)),
        'mix_w_in': nrm((DEPTH, D_MODEL, IN_COLS), D_MODEL ** -0.5),
        'mix_w_out': nrm((DEPTH, MIX_WIDTH, D_MODEL), MIX_WIDTH ** -0.5),
        'gla_alpha_w2': nrm((DEPTH, 2, GLA_RANK, GLA_QK), GLA_RANK ** -0.5),
        'gla_alpha_b': nrm((DEPTH, 2, GLA_QK), 0.1),
        'gla_norm': gain((DEPTH, GLA_DV)),
        'hy_conv_w': nrm((DEPTH, HY_CONV_W, HY_COLS), HY_CONV_W ** -0.5),
        'hy_conv_b': nrm((DEPTH, HY_COLS), 0.02),
        'hy_w1': nrm((DEPTH, HY_EMB, HY_HIDDEN), HY_EMB ** -0.5),
        'hy_b1': nrm((DEPTH, HY_HIDDEN), 0.1),
        'hy_w2': nrm((DEPTH, HY_HIDDEN, HY_HIDDEN), HY_HIDDEN ** -0.5),
        'hy_b2': nrm((DEPTH, HY_HIDDEN), 0.1),
        'hy_freq': 1.0 + nrm((DEPTH, 2, HY_HIDDEN), 0.05),
        'hy_w3': nrm((DEPTH, HY_HIDDEN, 2 * HY_WIDTH), 0.05 * HY_HIDDEN ** -0.5),
        'hy_bias': nrm((DEPTH, HY_WIDTH), 0.5),
        'rw_mu': jax.random.uniform(next(ks), (DEPTH, RW_COLS), jnp.float32),
        'rw_w0': jax.random.uniform(next(ks), (DEPTH, 2, RW_WIDTH), jnp.float32, minval=-5.0, maxval=0.0),
        'rw_w2': nrm((DEPTH, 2, RW_DECAY_RANK, RW_WIDTH), 0.1 * RW_DECAY_RANK ** -0.5),
        'rw_a0': nrm((DEPTH, RW_WIDTH), 0.1),
        'rw_a2': nrm((DEPTH, RW_AAA_RANK, RW_WIDTH), 0.5 * RW_AAA_RANK ** -0.5),
        'rw_g2': nrm((DEPTH, RW_GATE_RANK, RW_WIDTH), RW_GATE_RANK ** -0.5),
        'rw_k_k': 0.85 + nrm((DEPTH, RW_WIDTH), 0.02),
        'rw_k_a': gain((DEPTH, RW_WIDTH)),
        'rw_r_k': nrm((DEPTH, RW_HEADS, RW_N), 0.1),
        'rw_ln_w': gain((DEPTH, RW_WIDTH)),
        'rw_ln_b': nrm((DEPTH, RW_WIDTH), 0.02),
        'ffn2_norm': gain((DEPTH, D_MODEL)),
        'ffn2_w_in': nrm((DEPTH, D_MODEL, 2 * FFN_HIDDEN), D_MODEL ** -0.5),
        'ffn2_w_out': nrm((DEPTH, FFN_HIDDEN, D_MODEL), FFN_HIDDEN ** -0.5),
        'final_norm': gain((D_MODEL,)),
    }


def reference(x_prompt, x_sample, state_gla, state_rwkv, c, c_ctx, ada_w, ada_b,
              ffn1_norm, ffn1_w_in, ffn1_w_out, mix_norm, mix_w_in, mix_w_out,
              gla_alpha_w2, gla_alpha_b, gla_norm,
              hy_conv_w, hy_conv_b, hy_w1, hy_b1, hy_w2, hy_b2, hy_freq, hy_w3, hy_bias,
              rw_mu, rw_w0, rw_w2, rw_a0, rw_a2, rw_g2, rw_k_k, rw_k_a, rw_r_k, rw_ln_w, rw_ln_b,
              ffn2_norm, ffn2_w_in, ffn2_w_out, final_norm):
    per_layer = {
        'ffn1_norm': ffn1_norm, 'ffn1_w_in': ffn1_w_in, 'ffn1_w_out': ffn1_w_out,
        'mix_norm': mix_norm, 'mix_w_in': mix_w_in, 'mix_w_out': mix_w_out,
        'gla_alpha_w2': gla_alpha_w2, 'gla_alpha_b': gla_alpha_b, 'gla_norm': gla_norm,
        'hy_conv_w': hy_conv_w, 'hy_conv_b': hy_conv_b, 'hy_w1': hy_w1, 'hy_b1': hy_b1,
        'hy_w2': hy_w2, 'hy_b2': hy_b2, 'hy_freq': hy_freq, 'hy_w3': hy_w3, 'hy_bias': hy_bias,
        'rw_mu': rw_mu, 'rw_w0': rw_w0, 'rw_w2': rw_w2, 'rw_a0': rw_a0, 'rw_a2': rw_a2,
        'rw_g2': rw_g2, 'rw_k_k': rw_k_k, 'rw_k_a': rw_k_a, 'rw_r_k': rw_r_k,
        'rw_ln_w': rw_ln_w, 'rw_ln_b': rw_ln_b,
        'ffn2_norm': ffn2_norm, 'ffn2_w_in': ffn2_w_in, 'ffn2_w_out': ffn2_w_out,
    }
    n_ctx = x_prompt.shape[0]
    gla_zero = jnp.zeros((n_ctx, 2, GLA_HEADS, GLA_DK, GLA_DV), jnp.float32)
    rw_zero = jnp.zeros((n_ctx, 2, RW_HEADS, RW_N, RW_N), jnp.float32)
    x_ctx, x_lat = x_prompt, x_sample
    new_gla, new_rw = [], []
    for i in range(DEPTH):
        lp = {name: arr[i] for name, arr in per_layer.items()}
        mod_ctx = _adaln(c_ctx[None, :], ada_w[i], ada_b[i])
        mod_lat = _adaln(c, ada_w[i], ada_b[i])
        x_ctx, s_gla, s_rw = _trunk_layer(x_ctx, mod_ctx, lp, gla_zero, rw_zero, False)
        new_gla.append(s_gla)
        new_rw.append(s_rw)
        x_lat, _, _ = _trunk_layer(x_lat, mod_lat, lp, state_gla[:, i], state_rwkv[:, i], True)
    y_prompt = _rmsnorm(x_ctx, final_norm)
    y_sample = _rmsnorm(x_lat, final_norm)
    new_state_gla = jnp.stack(new_gla, axis=1).astype(x_prompt.dtype)
    new_state_rwkv = jnp.stack(new_rw, axis=1).astype(x_prompt.dtype)
    return (y_prompt, y_sample, new_state_gla, new_state_rwkv)
```

```cpp
#include <hip/hip_runtime.h>
#include <hip/hip_bf16.h>
#include <hip/hip_cooperative_groups.h>
#include <cstdio>
namespace cg = cooperative_groups;

typedef __hip_bfloat16 bf16;
typedef __attribute__((ext_vector_type(8))) short bf16x8;
typedef __attribute__((ext_vector_type(4))) float f32x4;
typedef __attribute__((ext_vector_type(2))) float f32x2;

constexpr int D = 1024, NTOK = 12288, NCTX = 4096, DEPTH = 4, FH = 2816;
constexpr int INC = 3264, INCP = 3328;
constexpr int C_HY = 1184, C_RW = 1952;
constexpr int NTHR = 512;

constexpr size_t al256(size_t x) { return (x + 255) & ~(size_t)255; }
constexpr size_t OFF_CNT = 0;
constexpr size_t OFF_MOD = 4096;
constexpr size_t SZ_MOD = (size_t)DEPTH * 9 * 9216 * 4;
constexpr size_t OFF_FT = al256(OFF_MOD + SZ_MOD);
constexpr size_t FT_L0 = 511 * 256, FT_L1 = 2047 * 256;
constexpr size_t FT_LAYER = FT_L0 + FT_L1;
constexpr size_t OFF_X = al256(OFF_FT + DEPTH * FT_LAYER * 4);
constexpr size_t OFF_H = al256(OFF_X + (size_t)NTOK * D * 4);
constexpr size_t OFF_W1I = al256(OFF_H + (size_t)NTOK * D * 2);
constexpr size_t OFF_W1O = al256(OFF_W1I + (size_t)5632 * 1024 * 2);
constexpr size_t OFF_WMI = al256(OFF_W1O + (size_t)1024 * 2816 * 2);
constexpr size_t OFF_WMO = al256(OFF_WMI + (size_t)INCP * 1024 * 2);
constexpr size_t OFF_W2I = al256(OFF_WMO + (size_t)1024 * 1024 * 2);
constexpr size_t OFF_W2O = al256(OFF_W2I + (size_t)5632 * 1024 * 2);
constexpr size_t OFF_P = al256(OFF_W2O + (size_t)1024 * 2816 * 2);
constexpr size_t SZ_P = (size_t)NTOK * INC * 4;
constexpr size_t SZ_GO = (size_t)2 * NTOK * 384 * 4;
constexpr size_t OFF_GO = OFF_P;
constexpr size_t OFF_RO = OFF_P + SZ_GO;
constexpr size_t OFF_REC = al256(OFF_P + SZ_P);
constexpr size_t SZ_REC = (size_t)NTOK * 6 * 512 * 4;
constexpr size_t OFF_HMID = OFF_REC;
constexpr size_t OFF_GREC = al256(OFF_REC + SZ_REC);
constexpr size_t SZ_GREC = (size_t)NTOK * 6 * 256 * 4;
constexpr size_t OFF_HYZ = al256(OFF_GREC + SZ_GREC);
constexpr size_t OFF_HYX = al256(OFF_HYZ + (size_t)NTOK * 256 * 4);
constexpr size_t WS_NEED = al256(OFF_HYX + (size_t)NTOK * 256 * 4);

struct Params {
  const float* in[41];
  float* out;
  char* ws;
};

enum { I_XP = 0, I_XS, I_SG, I_SR, I_C, I_CCTX, I_ADAW, I_ADAB, I_F1N, I_F1WI, I_F1WO, I_MN, I_MWI, I_MWO,
       I_GW2, I_GB, I_GN, I_HCW, I_HCB, I_HW1, I_HB1, I_HW2, I_HB2, I_HFQ, I_HW3, I_HBIAS,
       I_RMU, I_RW0, I_RW2, I_RA0, I_RA2, I_RG2, I_RKK, I_RKA, I_RRK, I_RLW, I_RLB, I_F2N, I_F2WI, I_F2WO, I_FN };

extern __shared__ __attribute__((aligned(16))) char smem[];
constexpr int LDS_BYTES = 131072;

__device__ __forceinline__ int otid() { int t = (int)__builtin_amdgcn_workitem_id_x(); asm volatile("" : "+v"(t)); return t; }
__device__ __forceinline__ int obid() { int b = (int)__builtin_amdgcn_workgroup_id_x(); asm volatile("" : "+s"(b)); return b; }
__device__ __forceinline__ unsigned short f2bf(float f) {
  unsigned u = __float_as_uint(f);
  u += 0x7fffu + ((u >> 16) & 1u);
  return (unsigned short)(u >> 16);
}
__device__ __forceinline__ float wave_sum(float v) {
#pragma unroll
  for (int o = 32; o > 0; o >>= 1) v += __shfl_xor(v, o);
  return v;
}
__device__ __forceinline__ float sigmoidf_(float x) { return 1.f / (1.f + expf(-x)); }
__device__ __forceinline__ float siluf_(float x) { return x / (1.f + expf(-x)); }
__device__ __forceinline__ int modrow(int row) { return row < NCTX ? 0 : 1 + ((row - NCTX) >> 10); }

__device__ __forceinline__ void p0_copy_x(const Params& p) {
  float4* x = (float4*)(p.ws + OFF_X);
  const float4* a = (const float4*)p.in[I_XP];
  const float4* b = (const float4*)p.in[I_XS];
  const size_t n4 = (size_t)NTOK * D / 4, nc4 = (size_t)NCTX * D / 4;
  for (size_t i = (size_t)obid() * NTHR + otid(); i < n4; i += (size_t)gridDim.x * NTHR)
    x[i] = i < nc4 ? a[i] : b[i - nc4];
}

__device__ __forceinline__ void p0_mod(const Params& p) {
  float* scond = (float*)smem;
  float* red = (float*)(smem + 40960);
  for (int i = otid(); i < 9 * 1024; i += NTHR) {
    int r = i >> 10, d = i & 1023;
    float c = r == 0 ? p.in[I_CCTX][d] : p.in[I_C][(r - 1) * 1024 + d];
    scond[i] = siluf_(c);
  }
  __syncthreads();
  float* mod = (float*)(p.ws + OFF_MOD);
  const int col = otid() & 63, ks = otid() >> 6;
  for (int task = obid(); task < DEPTH * 144; task += gridDim.x) {
    int l = task / 144, cg_ = task % 144;
    const float* w = p.in[I_ADAW] + (size_t)l * 1024 * 9216 + cg_ * 64 + col;
    float acc[9];
#pragma unroll
    for (int r = 0; r < 9; ++r) acc[r] = 0.f;
    for (int d0 = ks * 128; d0 < ks * 128 + 128; d0 += 8) {
      float wv[8];
#pragma unroll
      for (int u = 0; u < 8; ++u) wv[u] = w[(size_t)(d0 + u) * 9216];
#pragma unroll
      for (int u = 0; u < 8; ++u)
#pragma unroll
        for (int r = 0; r < 9; ++r) acc[r] += scond[r * 1024 + d0 + u] * wv[u];
    }
#pragma unroll
    for (int r = 0; r < 9; ++r) red[(ks * 9 + r) * 64 + col] = acc[r];
    __syncthreads();
    for (int i = otid(); i < 576; i += NTHR) {
      int r = i >> 6, c = i & 63;
      float s = 0.f;
#pragma unroll
      for (int k = 0; k < 8; ++k) s += red[(k * 9 + r) * 64 + c];
      int j = cg_ * 64 + c;
      mod[((size_t)l * 9 + r) * 9216 + j] = s + p.in[I_ADAB][l * 9216 + j];
    }
    __syncthreads();
  }
}

__device__ __forceinline__ void p0_filters(const Params& p) {
  const int wave = otid() >> 6, lane = otid() & 63;
  float* FT = (float*)(p.ws + OFF_FT);
  for (int task = obid() * 8 + wave; task < DEPTH * 1280; task += gridDim.x * 8) {
    int l = task / 1280, rem = task % 1280;
    int sel = rem >= 256, i = sel ? rem - 256 : rem, L = sel ? 1024 : 256;
    float t = (float)i / (float)(L - 1);
    float w = 6.283185307179586f * (float)i / (float)L;
    float zval = 0.f;
    {
      const float fstep = (15.f - 1e-4f) / 15.f;
      if (lane == 0) zval = t;
      else if (lane <= 16) zval = cosf((1e-4f + (float)(lane - 1) * fstep) * w);
      else if (lane <= 32) zval = -sinf((1e-4f + (float)(lane - 17) * fstep) * w);
    }
    const float* w1 = p.in[I_HW1] + l * 33 * 64;
    const float* w2 = p.in[I_HW2] + l * 64 * 64;
    const float* w3 = p.in[I_HW3] + l * 64 * 512;
    const float* fq = p.in[I_HFQ] + l * 128;
    float h1 = p.in[I_HB1][l * 64 + lane];
    for (int e = 0; e < 33; ++e) h1 += __shfl(zval, e) * w1[e * 64 + lane];
    h1 = sinf(fq[lane] * h1);
    float h2 = p.in[I_HB2][l * 64 + lane];
    for (int e = 0; e < 64; ++e) h2 += __shfl(h1, e) * w2[e * 64 + lane];
    h2 = sinf(fq[64 + lane] * h2);
    float acc[8];
#pragma unroll
    for (int m = 0; m < 8; ++m) acc[m] = 0.f;
    for (int e = 0; e < 64; ++e) {
      float hv = __shfl(h2, e);
#pragma unroll
      for (int m = 0; m < 8; ++m) acc[m] += hv * w3[e * 512 + m * 64 + lane];
    }
    float* ft = FT + (size_t)l * FT_LAYER + (sel ? FT_L0 : 0);
    const float a0 = -3.0701134573253945f, a1 = -15.350567286626973f;
#pragma unroll
    for (int m = 0; m < 8; ++m) {
      int cp = m * 64 + lane, c = cp & 255;
      float delta = fabsf(a0 + (float)c * ((a1 - a0) / 255.f));
      float val = acc[m] * expf(-t * delta);
      if (cp < 256) ft[(size_t)(L - 1 + i) * 256 + c] = val;
      else if (i >= 1) ft[(size_t)(L - 1 - i) * 256 + c] = val;
    }
  }
}

__device__ __forceinline__ void conv_tile(const float* src, int srcN, int k0, int srccol0, bool zero, bf16* dst, int dstK, int n0) {
  float* tile = (float*)smem;
  const int tid = otid();
  {
    int r = tid >> 4, c4 = (tid & 15) * 4;
#pragma unroll
    for (int rr = 0; rr < 2; ++rr) {
      int row = r + rr * 32;
      float4 v = zero ? make_float4(0.f, 0.f, 0.f, 0.f)
                      : *(const float4*)(src + (size_t)(k0 + row) * srcN + srccol0 + c4);
      tile[row * 65 + c4 + 0] = v.x; tile[row * 65 + c4 + 1] = v.y;
      tile[row * 65 + c4 + 2] = v.z; tile[row * 65 + c4 + 3] = v.w;
    }
  }
  __syncthreads();
  {
    int nn = tid >> 3, ks = (tid & 7) * 8;
    unsigned short v[8];
#pragma unroll
    for (int j = 0; j < 8; ++j) v[j] = f2bf(tile[(ks + j) * 65 + nn]);
    uint4 o;
    o.x = v[0] | ((unsigned)v[1] << 16); o.y = v[2] | ((unsigned)v[3] << 16);
    o.z = v[4] | ((unsigned)v[5] << 16); o.w = v[6] | ((unsigned)v[7] << 16);
    *(uint4*)(dst + (size_t)(n0 + nn) * dstK + k0 + ks) = o;
  }
  __syncthreads();
}

__device__ __forceinline__ void phase_wconv(const Params& p, int l) {
  for (int t = obid(); t < 5312; t += gridDim.x) {
    int u = t;
    if (u < 1408 || (u >= 3200 && u < 4608)) {
      bool second = u >= 3200;
      if (second) u -= 3200;
      const float* src = p.in[second ? I_F2WI : I_F1WI] + (size_t)l * 1024 * 5632;
      bf16* dst = (bf16*)(p.ws + (second ? OFF_W2I : OFF_W1I));
      int tn = u % 88, tk = u / 88;
      int n0 = tn * 64, pn = n0 >> 8, within = n0 & 255;
      int srccol = within < 128 ? pn * 128 + within : 2816 + pn * 128 + (within - 128);
      conv_tile(src, 5632, tk * 64, srccol, false, dst, 1024, n0);
    } else if ((u >= 1408 && u < 2112) || u >= 4608) {
      bool second = u >= 4608;
      u -= second ? 4608 : 1408;
      const float* src = p.in[second ? I_F2WO : I_F1WO] + (size_t)l * 2816 * 1024;
      bf16* dst = (bf16*)(p.ws + (second ? OFF_W2O : OFF_W1O));
      int tn = u % 16, tk = u / 16;
      conv_tile(src, 1024, tk * 64, tn * 64, false, dst, 2816, tn * 64);
    } else if (u < 2944) {
      u -= 2112;
      const float* src = p.in[I_MWI] + (size_t)l * 1024 * INC;
      bf16* dst = (bf16*)(p.ws + OFF_WMI);
      int tn = u % 52, tk = u / 52;
      conv_tile(src, INC, tk * 64, tn * 64, tn == 51, dst, 1024, tn * 64);
    } else {
      u -= 2944;
      const float* src = p.in[I_MWO] + (size_t)l * 1024 * 1024;
      bf16* dst = (bf16*)(p.ws + OFF_WMO);
      int tn = u % 16, tk = u / 16;
      conv_tile(src, 1024, tk * 64, tn * 64, false, dst, 1024, tn * 64);
    }
  }
}

__device__ __forceinline__ void phase_norm(const Params& p, const float* gain, const float* modl, int shi, int sci) {
  const int wave = otid() >> 6, lane = otid() & 63;
  const float* x = (const float*)(p.ws + OFF_X);
  bf16* h = (bf16*)(p.ws + OFF_H);
  for (int row = obid() * 8 + wave; row < NTOK; row += gridDim.x * 8) {
    const float4* xr = (const float4*)(x + (size_t)row * D);
    float4 v[4];
    float ss = 0.f;
#pragma unroll
    for (int i = 0; i < 4; ++i) {
      v[i] = xr[i * 64 + lane];
      ss += v[i].x * v[i].x + v[i].y * v[i].y + v[i].z * v[i].z + v[i].w * v[i].w;
    }
    ss = wave_sum(ss);
    float rstd = rsqrtf(ss * (1.f / 1024.f) + 1e-6f);
    const float* mr = modl + (size_t)modrow(row) * 9216;
    const float4* sc = (const float4*)(mr + sci * 1024);
    const float4* sh = (const float4*)(mr + shi * 1024);
    const float4* g4 = (const float4*)gain;
#pragma unroll
    for (int i = 0; i < 4; ++i) {
      float4 g = g4[i * 64 + lane], s = sc[i * 64 + lane], b = sh[i * 64 + lane];
      float y0 = v[i].x * rstd * g.x * (1.f + s.x) + b.x;
      float y1 = v[i].y * rstd * g.y * (1.f + s.y) + b.y;
      float y2 = v[i].z * rstd * g.z * (1.f + s.z) + b.z;
      float y3 = v[i].w * rstd * g.w * (1.f + s.w) + b.w;
      uint2 o;
      o.x = f2bf(y0) | ((unsigned)f2bf(y1) << 16);
      o.y = f2bf(y2) | ((unsigned)f2bf(y3) << 16);
      *(uint2*)(h + (size_t)row * D + (i * 64 + lane) * 4) = o;
    }
  }
}

__device__ __forceinline__ void phase_final_norm(const Params& p) {
  const int wave = otid() >> 6, lane = otid() & 63;
  const float* x = (const float*)(p.ws + OFF_X);
  const float4* g4 = (const float4*)p.in[I_FN];
  for (int row = obid() * 8 + wave; row < NTOK; row += gridDim.x * 8) {
    const float4* xr = (const float4*)(x + (size_t)row * D);
    float4 v[4];
    float ss = 0.f;
#pragma unroll
    for (int i = 0; i < 4; ++i) {
      v[i] = xr[i * 64 + lane];
      ss += v[i].x * v[i].x + v[i].y * v[i].y + v[i].z * v[i].z + v[i].w * v[i].w;
    }
    ss = wave_sum(ss);
    float rstd = rsqrtf(ss * (1.f / 1024.f) + 1e-6f);
    float4* o = (float4*)(p.out + (size_t)row * D);
#pragma unroll
    for (int i = 0; i < 4; ++i) {
      float4 g = g4[i * 64 + lane];
      o[i * 64 + lane] = make_float4(v[i].x * rstd * g.x, v[i].y * rstd * g.y, v[i].z * rstd * g.z, v[i].w * rstd * g.w);
    }
  }
}

namespace pg8 {
#define PG8_LAS __attribute__((address_space(3)))
typedef unsigned short bf16_t;
typedef short bf16x8 __attribute__((ext_vector_type(8)));
typedef float f32x4 __attribute__((ext_vector_type(4)));
typedef unsigned u32x4 __attribute__((ext_vector_type(4)));
constexpr int BM = 256, BK = 64, HALF = 128, HTB = HALF * BK * 2  , STAGE_BYTES = 8 * HTB, NXCD = 8, WGM = 8;

__host__ __device__ __forceinline__ int lds_byte(int r, int c) { const int st = (r >> 4) * 2 + (c >> 5), rr = r & 15, cc = c & 31, ob = rr * 64 + cc * 2; return st * 1024 + (ob ^ (((ob >> 9) & 1) << 5)); }
__host__ __device__ __forceinline__ void stage_rc(int b, int& R, int& C) { const int st = b / 1024, sb = b % 1024, swz = sb ^ (((sb >> 9) & 1) << 5); R = (st >> 1) * 16 + swz / 64; C = (st & 1) * 32 + (swz % 64) / 2; }
__host__ __device__ __forceinline__ int perm32(int rho) { const int n = rho >> 4, i = rho & 15; return 8 * (i >> 2) + 4 * n + (i & 3); }

struct Unit { int pm, pn; };
struct Gemm { const bf16_t* A; const bf16_t* Bt; int M, N, K; };

struct StaticOrder {
    int nM, nN, nwg, G, c;
    __host__ __device__ void init(int M, int N, int G_, int c_) { nM = M / BM; nN = N / BM; nwg = nM * nN; G = G_; c = c_; }
    __host__ __device__ bool next(int i, Unit& u) const {
        const long L = (long)i * G + c; if (L >= nwg) return false;
        int wgid = (int)L; { const int q = nwg / NXCD, r = nwg % NXCD, xcd = wgid % NXCD, off = wgid / NXCD; wgid = (xcd < r ? xcd * (q + 1) : r * (q + 1) + (xcd - r) * q) + off; }
        const int nig = WGM * nN, gid = wgid / nig, fm = gid * WGM, gsz = (nM - fm) < WGM ? (nM - fm) : WGM;
        u.pm = fm + ((wgid % nig) % gsz); u.pn = (wgid % nig) / gsz; return true;
    }
    __device__ __forceinline__ void a_ready(const Unit&) const {}
    __device__ __forceinline__ void done(const Unit&) const {}
};
__device__ __forceinline__ unsigned cvt_pk_bf16(float lo, float hi) { unsigned r; asm volatile("v_cvt_pk_bf16_f32 %0, %1, %2" : "=v"(r) : "v"(lo), "v"(hi)); return r; }

template <class Epi, class Sched, bool STAMP = false>
__device__ __forceinline__ void gemm_phase(PG8_LAS unsigned char* lds, const Gemm g, const Sched& S, const Epi& E, unsigned long long* stamps) {
    const int tid = otid(), wid = __builtin_amdgcn_readfirstlane(tid >> 6), lane = tid & 63, wr = wid >> 2, wc = wid & 3, fr = lane & 15, fq = lane >> 4;
    const int K = g.K, nt = K / BK;
    int ts_lo = 0, ts_hi = 0, nts = 0; const unsigned long long rt_entry = STAMP ? (unsigned long long)wall_clock64() : 0ull;
#define PG8_STAMP() do { if (STAMP && wid == 0 && nts < 64) { const unsigned long long _c = (unsigned long long)clock64(); \
        ts_lo = (lane == nts) ? (int)(unsigned)_c : ts_lo; ts_hi = (lane == nts) ? (int)(unsigned)(_c >> 32) : ts_hi; ++nts; } } while (0)
    PG8_STAMP();
    unsigned voffA[2], voffB[2];
#pragma unroll
    for (int i = 0; i < 2; ++i) { int R, C; stage_rc(tid * 16 + i * 8192, R, C); const int Rb = Epi::PERM ? ((R & ~31) + perm32(R & 31)) : R;
        voffA[i] = (unsigned)(R * K + C) * 2u; voffB[i] = (unsigned)(Rb * K + C) * 2u; }
    const size_t kstep = (size_t)(BK * 2);
    const size_t hstep = (size_t)HALF * K * 2;
    const size_t tstep = 2 * hstep;
    const unsigned ldsw = (unsigned)wid * 1024u;
    const int aoff = lds_byte(wr * 64 + fr, fq * 8), boff = lds_byte(wc * 32 + fr, fq * 8);
#define PG8_SA(b, h) (((b) * 2 + (h)) * HTB)
#define PG8_SB(b, h) ((4 + (b) * 2 + (h)) * HTB)
#define PG8_STAGE(bufoff, gbase, voff) do { _Pragma("unroll") for (int _i = 0; _i < 2; ++_i) \
        __builtin_amdgcn_global_load_lds((const unsigned*)((const char*)(gbase) + (voff)[_i]), (PG8_LAS unsigned*)(lds + (bufoff) + ldsw + _i * 8192), 16, 0, 0); } while (0)
#define PG8_LDA(dst, b, h) do { _Pragma("unroll") for (int m = 0; m < 4; ++m) _Pragma("unroll") for (int k = 0; k < 2; ++k) dst[m][k] = *(const PG8_LAS bf16x8*)(lds + PG8_SA(b, h) + aoff + m * 2048 + k * 1024); } while (0)
#define PG8_LDB(dst, b, h) do { _Pragma("unroll") for (int n = 0; n < 2; ++n) _Pragma("unroll") for (int k = 0; k < 2; ++k) dst[n][k] = *(const PG8_LAS bf16x8*)(lds + PG8_SB(b, h) + boff + n * 2048 + k * 1024); } while (0)
#define PG8_MMA(ai, bj, At, Bt) do { __builtin_amdgcn_s_setprio(1); _Pragma("unroll") for (int m = 0; m < 4; ++m) _Pragma("unroll") for (int n = 0; n < 2; ++n) _Pragma("unroll") for (int k = 0; k < 2; ++k) \
        acc[ai][bj][m][n] = __builtin_amdgcn_mfma_f32_16x16x32_bf16(Bt[n][k], At[m][k], acc[ai][bj][m][n], 0, 0, 0); __builtin_amdgcn_s_setprio(0); } while (0)
#define PG8_WAIT_V(n) asm volatile("s_waitcnt vmcnt(" #n ")" ::: "memory")
#define PG8_WAIT_L(n) asm volatile("s_waitcnt lgkmcnt(" #n ")" ::: "memory")
#define PG8_BAR __builtin_amdgcn_s_barrier()
#define PG8_SCHED __builtin_amdgcn_sched_barrier(0)
    Unit cur, nxt; int ui = 0;
    if (!S.next(0, cur)) return;
    f32x4 acc[2][2][4][2];
#pragma unroll
    for (int a = 0; a < 2; ++a)
#pragma unroll
        for (int b = 0; b < 2; ++b)
#pragma unroll
            for (int m = 0; m < 4; ++m)
#pragma unroll
                for (int n = 0; n < 2; ++n) acc[a][b][m][n] = (f32x4){0.f, 0.f, 0.f, 0.f};
    bf16x8 At[4][2], B0[2][2], B1[2][2];
    const char* cA = (const char*)g.A + (size_t)cur.pm * tstep; const char* cB = (const char*)g.Bt + (size_t)cur.pn * tstep;
    S.a_ready(cur);
    PG8_STAGE(PG8_SB(0, 0), cB, voffB); PG8_STAGE(PG8_SA(0, 0), cA, voffA); PG8_STAGE(PG8_SB(0, 1), cB + hstep, voffB); PG8_STAGE(PG8_SA(0, 1), cA + hstep, voffA);
    if (wr == 1) PG8_BAR;
    PG8_WAIT_V(4); PG8_BAR;
    PG8_STAGE(PG8_SB(1, 0), cB + kstep, voffB); PG8_STAGE(PG8_SA(1, 0), cA + kstep, voffA); PG8_STAGE(PG8_SB(1, 1), cB + hstep + kstep, voffB);
    PG8_WAIT_V(6); PG8_BAR;
    PG8_STAMP();
    for (;;) {
        const bool has_next = S.next(ui + 1, nxt);
        const char* nA = has_next ? (const char*)g.A + (size_t)nxt.pm * tstep : cA; const char* nB = has_next ? (const char*)g.Bt + (size_t)nxt.pn * tstep : cB;
        for (int t = 0; t < nt; t += 2) {
            const bool last = (t == nt - 2);
            const char* a1 = cA + (size_t)(t + 1) * kstep;
            const char* a2 = last ? nA : cA + (size_t)(t + 2) * kstep; const char* b2 = last ? nB : cB + (size_t)(t + 2) * kstep;
            const char* a3 = a2 + kstep; const char* b3 = b2 + kstep;
            if (last && has_next) S.a_ready(nxt);
            PG8_LDB(B0, 0, 0); PG8_SCHED; PG8_LDA(At, 0, 0); PG8_STAGE(PG8_SA(1, 1), a1 + hstep, voffA);
            PG8_WAIT_L(8); PG8_BAR; PG8_WAIT_L(0); PG8_MMA(0, 0, At, B0); PG8_BAR; PG8_SCHED;
            PG8_LDB(B1, 0, 1); PG8_STAGE(PG8_SB(0, 0), b2, voffB);
            PG8_BAR; PG8_WAIT_L(0); PG8_MMA(0, 1, At, B1); PG8_BAR;
            PG8_LDA(At, 0, 1); PG8_STAGE(PG8_SA(0, 0), a2, voffA);
            PG8_BAR; PG8_WAIT_L(0); PG8_MMA(1, 0, At, B0); PG8_BAR; PG8_SCHED;
            PG8_STAGE(PG8_SB(0, 1), b2 + hstep, voffB);
            PG8_WAIT_V(6); PG8_BAR; PG8_MMA(1, 1, At, B1); PG8_BAR;
            PG8_LDB(B0, 1, 0); PG8_SCHED; PG8_LDA(At, 1, 0); PG8_STAGE(PG8_SA(0, 1), a2 + hstep, voffA);
            PG8_WAIT_L(8); PG8_BAR; PG8_WAIT_L(0); PG8_MMA(0, 0, At, B0); PG8_BAR; PG8_SCHED;
            PG8_LDB(B1, 1, 1); PG8_STAGE(PG8_SB(1, 0), b3, voffB);
            PG8_BAR; PG8_WAIT_L(0); PG8_MMA(0, 1, At, B1); PG8_BAR;
            PG8_LDA(At, 1, 1); PG8_STAGE(PG8_SA(1, 0), a3, voffA);
            PG8_BAR; PG8_WAIT_L(0); PG8_MMA(1, 0, At, B0); PG8_BAR; PG8_SCHED;
            PG8_STAGE(PG8_SB(1, 1), b3 + hstep, voffB);
            PG8_WAIT_V(6); PG8_BAR; PG8_MMA(1, 1, At, B1); PG8_BAR;
        }
        PG8_STAMP();
        if constexpr (!Epi::AFTER_DRAIN) { E(acc, cur, wr, wc, fr, fq); S.done(cur); }
        PG8_STAMP();
        if (!has_next) break;
#pragma unroll
        for (int a = 0; a < 2; ++a)
#pragma unroll
            for (int b = 0; b < 2; ++b)
#pragma unroll
                for (int m = 0; m < 4; ++m)
#pragma unroll
                    for (int n = 0; n < 2; ++n) acc[a][b][m][n] = (f32x4){0.f, 0.f, 0.f, 0.f};
        cur = nxt; cA = nA; cB = nB; ++ui;
    }
    PG8_WAIT_V(0);
    if (wr == 0) PG8_BAR;
    PG8_BAR;
    if constexpr (Epi::AFTER_DRAIN) { E.fused(acc, cur, wr, wc, fr, fq, lds, wid, lane); S.done(cur); }
    PG8_STAMP();
    if (STAMP && wid == 0) { stamps[lane] = lane < nts ? (((unsigned long long)(unsigned)ts_hi << 32) | (unsigned)ts_lo) : 0ull;
        if (lane == 62) stamps[62] = rt_entry; if (lane == 63) stamps[63] = (unsigned long long)wall_clock64(); }
#undef PG8_STAMP
#undef PG8_SA
#undef PG8_SB
#undef PG8_STAGE
#undef PG8_LDA
#undef PG8_LDB
#undef PG8_MMA
#undef PG8_WAIT_V
#undef PG8_WAIT_L
#undef PG8_BAR
#undef PG8_SCHED
}
}

struct EpiSwiglu {
  static constexpr bool PERM = true, AFTER_DRAIN = false;
  unsigned short* H;
  __device__ __forceinline__ void operator()(const pg8::f32x4 (&acc)[2][2][4][2], const pg8::Unit& u, int wr, int wc, int fr, int fq) const {
    const int row0 = u.pm * 256 + wr * 64 + fr, hc0 = u.pn * 128 + wc * 32 + 8 * fq;
#pragma unroll
    for (int ai = 0; ai < 2; ++ai)
#pragma unroll
      for (int m = 0; m < 4; ++m) {
        unsigned short* rowp = H + (size_t)(row0 + ai * 128 + m * 16) * FH + hc0;
        float v[8];
#pragma unroll
        for (int n = 0; n < 2; ++n)
#pragma unroll
          for (int i = 0; i < 4; ++i) v[n * 4 + i] = siluf_(acc[ai][0][m][n][i]) * acc[ai][1][m][n][i];
        pg8::u32x4 o;
        o[0] = pg8::cvt_pk_bf16(v[0], v[1]); o[1] = pg8::cvt_pk_bf16(v[2], v[3]);
        o[2] = pg8::cvt_pk_bf16(v[4], v[5]); o[3] = pg8::cvt_pk_bf16(v[6], v[7]);
        *(pg8::u32x4*)rowp = o;
      }
  }
};
struct EpiResid {
  static constexpr bool PERM = false, AFTER_DRAIN = false;
  float* X; const float* modl; int gidx; float scale;
  __device__ __forceinline__ void operator()(const pg8::f32x4 (&acc)[2][2][4][2], const pg8::Unit& u, int wr, int wc, int fr, int fq) const {
    const int row0 = u.pm * 256 + wr * 64 + fr, col0 = u.pn * 256 + wc * 32 + 4 * fq;
#pragma unroll
    for (int ai = 0; ai < 2; ++ai)
#pragma unroll
      for (int m = 0; m < 4; ++m) {
        const int row = row0 + ai * 128 + m * 16;
        const float* gt = modl + (size_t)modrow(row) * 9216 + gidx * 1024 + col0;
        float* xp = X + (size_t)row * D + col0;
#pragma unroll
        for (int bj = 0; bj < 2; ++bj)
#pragma unroll
          for (int n = 0; n < 2; ++n) {
            pg8::f32x4 g = *(const pg8::f32x4*)(gt + bj * 128 + n * 16);
            pg8::f32x4* q = (pg8::f32x4*)(xp + bj * 128 + n * 16);
            *q = *q + (g * scale) * acc[ai][bj][m][n];
          }
      }
  }
};
struct EpiP {
  static constexpr bool PERM = false, AFTER_DRAIN = false;
  float* P;
  __device__ __forceinline__ void operator()(const pg8::f32x4 (&acc)[2][2][4][2], const pg8::Unit& u, int wr, int wc, int fr, int fq) const {
    const int row0 = u.pm * 256 + wr * 64 + fr, col0 = u.pn * 256 + wc * 32 + 4 * fq;
#pragma unroll
    for (int ai = 0; ai < 2; ++ai)
#pragma unroll
      for (int m = 0; m < 4; ++m) {
        float* rp = P + (size_t)(row0 + ai * 128 + m * 16) * INC;
#pragma unroll
        for (int bj = 0; bj < 2; ++bj)
#pragma unroll
          for (int n = 0; n < 2; ++n) {
            const int col = col0 + bj * 128 + n * 16;
            if (col < INC) *(pg8::f32x4*)(rp + col) = acc[ai][bj][m][n];
          }
      }
  }
};

template <class Epi>
__device__ __forceinline__ void phase_gemm(const void* A, const void* Bt, int N, int K, const Epi& E) {
  pg8::Gemm g; g.A = (const pg8::bf16_t*)A; g.Bt = (const pg8::bf16_t*)Bt; g.M = NTOK; g.N = N; g.K = K;
  int c_ = obid(), G_ = (int)gridDim.x;
  asm volatile("" : "+s"(c_), "+s"(G_));
  pg8::StaticOrder S; S.init(NTOK, N, G_, c_);
  pg8::gemm_phase<Epi, pg8::StaticOrder, false>((PG8_LAS unsigned char*)smem, g, S, E, nullptr);
  __syncthreads();
}

__device__ __forceinline__ int scan2tok(int R) {
  if (R < NCTX) return R;
  int q = R - NCTX, b = q >> 10, n = q & 1023;
  return NCTX + b * 1024 + (n & 15) * 64 + (n >> 4);
}

__device__ __forceinline__ float rw_shift(const float* P, int R, int n, int L, int c, float mu) {
  float pc = P[(size_t)scan2tok(R) * INC + C_RW + c];
  float pp = n > 0 ? P[(size_t)scan2tok(R - 1) * INC + C_RW + c] : 0.f;
  float pn = n < L - 1 ? P[(size_t)scan2tok(R + 1) * INC + C_RW + c] : 0.f;
  return pc + (0.5f * (pp + pn) - pc) * mu;
}

__device__ __forceinline__ void prep_rwkv(const Params& p, int l) {
  const int wave = otid() >> 6, lane = otid() & 63;
  const float* P = (const float*)(p.ws + OFF_P);
  float* rec = (float*)(p.ws + OFF_REC);
  float* lw = (float*)smem + wave * 640;
  const float* mu = p.in[I_RMU] + l * 1312;
  const float* w0 = p.in[I_RW0] + l * 768;
  const float* w2 = p.in[I_RW2] + (size_t)l * 64 * 384;
  const float* a0 = p.in[I_RA0] + l * 384;
  const float* a2 = p.in[I_RA2] + (size_t)l * 32 * 384;
  const float* g2 = p.in[I_RG2] + (size_t)l * 64 * 384;
  const float* kkw = p.in[I_RKK] + l * 384;
  const float* kaw = p.in[I_RKA] + l * 384;
  for (int task = obid() * 8 + wave; task < NTOK / 4; task += gridDim.x * 8) {
    const int R0 = task * 4;
    int n0, L;
    if (R0 < NCTX) { n0 = R0 & 255; L = 256; } else { n0 = (R0 - NCTX) & 1023; L = 1024; }
    asm volatile("s_waitcnt lgkmcnt(0)" ::: "memory");
#pragma unroll
    for (int tp = 0; tp < 4; ++tp)
#pragma unroll
      for (int m = 0; m < 3; ++m) {
        int cc = lane + 64 * m;
        if (cc < 160) {
          float v = rw_shift(P, R0 + tp, n0 + tp, L, 1152 + cc, mu[1152 + cc]);
          if (cc < 64) v = tanhf(v);
          else if (cc >= 96) v = sigmoidf_(v);
          lw[tp * 160 + cc] = v;
        }
      }
    asm volatile("s_waitcnt lgkmcnt(0)" ::: "memory");
    for (int h = 0; h < 6; ++h) {
      const int c = h * 64 + lane;
      float aa[4], ag[4], af[4], ab[4];
#pragma unroll
      for (int tp = 0; tp < 4; ++tp) { aa[tp] = 0.f; ag[tp] = 0.f; af[tp] = 0.f; ab[tp] = 0.f; }
      for (int j = 0; j < 32; ++j) {
        float wa = a2[j * 384 + c], wf = w2[j * 384 + c], wb = w2[(32 + j) * 384 + c];
#pragma unroll
        for (int tp = 0; tp < 4; ++tp) {
          aa[tp] += lw[tp * 160 + 64 + j] * wa;
          af[tp] += lw[tp * 160 + j] * wf;
          ab[tp] += lw[tp * 160 + 32 + j] * wb;
        }
      }
      for (int j = 0; j < 64; ++j) {
        float wg = g2[j * 384 + c];
#pragma unroll
        for (int tp = 0; tp < 4; ++tp) ag[tp] += lw[tp * 160 + 96 + j] * wg;
      }
#pragma unroll
      for (int tp = 0; tp < 4; ++tp) {
        const int R = R0 + tp, n = n0 + tp;
        float r = rw_shift(P, R, n, L, c, mu[c]);
        float k = rw_shift(P, R, n, L, 384 + c, mu[384 + c]);
        float v = rw_shift(P, R, n, L, 768 + c, mu[768 + c]);
        float a = sigmoidf_(a0[c] + aa[tp]);
        float kk = k * kkw[c];
        float ss = wave_sum(kk * kk);
        kk = kk * rsqrtf(fmaxf(ss, 1e-24f));
        float k2 = k * (1.f + (a - 1.f) * kaw[c]);
        float uf = w0[c] + af[tp], ub = w0[384 + c] + ab[tp];
        float df = expf(-0.6065306597126334f * sigmoidf_(uf));
        float db = expf(-0.6065306597126334f * sigmoidf_(ub));
        float* o = rec + ((size_t)R * 6 + h) * 512 + lane;
        o[0] = r; o[64] = k2; o[128] = v; o[192] = -kk; o[256] = kk * a; o[320] = df; o[384] = db; o[448] = ag[tp];
      }
    }
  }
}

__device__ __forceinline__ float logsigmoidf_(float x) { return fminf(x, 0.f) - log1pf(expf(-fabsf(x))); }

__device__ __forceinline__ void prep_gla(const Params& p, int l) {
  const int wave = otid() >> 6, lane = otid() & 63;
  const float* P = (const float*)(p.ws + OFF_P);
  float* grec = (float*)(p.ws + OFF_GREC);
  const float* w2 = p.in[I_GW2] + (size_t)l * 2 * 16 * 192;
  const float* ab = p.in[I_GB] + l * 384;
  const int z = lane >> 5, d = lane & 31;
  for (int tok = obid() * 8 + wave; tok < NTOK; tok += gridDim.x * 8) {
    const float* pr = P + (size_t)tok * INC;
    float lr[16];
#pragma unroll
    for (int r = 0; r < 16; ++r) lr[r] = pr[1152 + z * 16 + r];
    for (int h = 0; h < 6; ++h) {
      float acc = ab[z * 192 + h * 32 + d];
#pragma unroll
      for (int r = 0; r < 16; ++r) acc += lr[r] * w2[(z * 16 + r) * 192 + h * 32 + d];
      float alpha = expf(logsigmoidf_(acc) * (1.f / 16.f));
      float qk = lane < 32 ? pr[h * 32 + lane] * 0.17677669529663687f : pr[192 + h * 32 + (lane - 32)];
      float* o = grec + ((size_t)tok * 6 + h) * 256 + lane;
      o[0] = qk; o[64] = alpha; o[128] = pr[384 + h * 64 + lane]; o[192] = pr[768 + h * 64 + lane];
    }
  }
}

__device__ __forceinline__ void prep_hyena(const Params& p, int l) {
  const float* P = (const float*)(p.ws + OFF_P);
  float* hz = (float*)(p.ws + OFF_HYZ);
  float* hx = (float*)(p.ws + OFF_HYX);
  const float* cw = p.in[I_HCW] + l * 3 * 768;
  const float* cb = p.in[I_HCB] + l * 768;
  for (int i = obid() * NTHR + otid(); i < NTOK * 256; i += gridDim.x * NTHR) {
    int row = i >> 8, c = i & 255;
    int t, L;
    if (row < NCTX) { t = row & 255; L = 256; } else { t = (row - NCTX) & 1023; L = 1024; }
    const float* pc = P + (size_t)row * INC + C_HY;
    float u[3];
#pragma unroll
    for (int s = 0; s < 3; ++s) {
      int col = s * 256 + c;
      float v = pc[col] * cw[768 + col] + cb[col];
      if (t > 0) v += pc[col - INC] * cw[col];
      if (t < L - 1) v += pc[col + INC] * cw[1536 + col];
      u[s] = v;
    }
    hx[i] = u[0];
    hz[i] = u[1] * u[2];
  }
}

__device__ __forceinline__ void glds16(const void* g, void* l) {
  __builtin_amdgcn_global_load_lds((const unsigned*)g, (unsigned*)l, 16, 0, 0);
}

__device__ __forceinline__ void rwkv_scan(const Params& p, int l, int task, char* lbuf  ) {
  const int lane = otid() & 63;
  int b, hd, L, rowbase;
  const bool lat = task < 96;
  if (lat) { b = task / 12; hd = task % 12; L = 1024; rowbase = NCTX + b * 1024; }
  else { int t2 = task - 96; b = t2 / 12; hd = t2 % 12; L = 256; rowbase = b * 256; }
  const int h = hd >> 1, dir = hd & 1;
  const float* rec = (const float*)(p.ws + OFF_REC);
  float* RO = (float*)(p.ws + OFF_RO) + (size_t)dir * NTOK * 384;
  f32x2 S[32];
  if (lat) {
    const float4* s0 = (const float4*)(p.in[I_SR] + ((((size_t)b * DEPTH + l) * 2 + dir) * 6 + h) * 4096 + lane * 64);
#pragma unroll
    for (int k = 0; k < 16; ++k) { float4 v = s0[k]; S[2 * k] = f32x2{v.x, v.y}; S[2 * k + 1] = f32x2{v.z, v.w}; }
  } else {
#pragma unroll
    for (int k = 0; k < 32; ++k) S[k] = f32x2{0.f, 0.f};
  }
  const int nch = L / 8;
  {
#pragma unroll
    for (int s = 0; s < 8; ++s) {
      int n = dir ? L - 1 - s : s;
      const char* g = (const char*)(rec + ((size_t)(rowbase + n) * 6 + h) * 512);
      glds16(g + lane * 16, lbuf + s * 2048);
      glds16(g + 1024 + lane * 16, lbuf + s * 2048 + 1024);
    }
  }
  for (int ch = 0; ch < nch; ++ch) {
    asm volatile("s_waitcnt vmcnt(0)" ::: "memory");
    if (ch + 1 < nch) {
      char* nb = lbuf + ((ch + 1) & 1) * 16384;
#pragma unroll
      for (int s = 0; s < 8; ++s) {
        int st = (ch + 1) * 8 + s;
        int n = dir ? L - 1 - st : st;
        const char* g = (const char*)(rec + ((size_t)(rowbase + n) * 6 + h) * 512);
        glds16(g + lane * 16, nb + s * 2048);
        glds16(g + 1024 + lane * 16, nb + s * 2048 + 1024);
      }
    }
    const float* cb = (const float*)(lbuf + (ch & 1) * 16384);
    for (int s = 0; s < 8; ++s) {
      const float* r_ = cb + s * 512;
      const f32x2* Rr = (const f32x2*)(r_);
      const f32x2* Kk = (const f32x2*)(r_ + 64);
      const f32x2* Aa = (const f32x2*)(r_ + 192);
      const f32x2* Bb = (const f32x2*)(r_ + 256);
      const f32x2* Ww = (const f32x2*)(r_ + 320 + dir * 64);
      const float vv = r_[128 + lane];
      f32x2 sa2 = {0.f, 0.f}, sb2 = {0.f, 0.f};
#pragma unroll
      for (int k = 0; k < 32; k += 2) { sa2 += S[k] * Aa[k]; sb2 += S[k + 1] * Aa[k + 1]; }
      sa2 += sb2;
      const float sa = sa2.x + sa2.y;
      const f32x2 sav = {sa, sa}, vvv = {vv, vv};
      f32x2 o2 = {0.f, 0.f}, o3 = {0.f, 0.f};
#pragma unroll
      for (int k = 0; k < 32; k += 2) {
        S[k] = S[k] * Ww[k] + (sav * Bb[k] + vvv * Kk[k]);
        S[k + 1] = S[k + 1] * Ww[k + 1] + (sav * Bb[k + 1] + vvv * Kk[k + 1]);
        o2 += S[k] * Rr[k]; o3 += S[k + 1] * Rr[k + 1];
      }
      o2 += o3;
      const int st = ch * 8 + s;
      const int n = dir ? L - 1 - st : st;
      RO[(size_t)(rowbase + n) * 384 + h * 64 + lane] = o2.x + o2.y;
    }
  }
  if (!lat) {
    float4* so = (float4*)(p.out + (size_t)NTOK * D + (size_t)16 * DEPTH * 2 * 6 * 2048 +
                           ((((size_t)b * DEPTH + l) * 2 + dir) * 6 + h) * 4096 + lane * 64);
#pragma unroll
    for (int k = 0; k < 16; ++k) so[k] = make_float4(S[2 * k].x, S[2 * k].y, S[2 * k + 1].x, S[2 * k + 1].y);
  }
  asm volatile("s_waitcnt vmcnt(0)" ::: "memory");
}

__device__ __forceinline__ void gla_scan(const Params& p, int l, int task, char* lbuf  ) {
  const int lane = otid() & 63;
  int b, hd, L, rowbase;
  const bool lat = task < 96;
  if (lat) { b = task / 12; hd = task % 12; L = 1024; rowbase = NCTX + b * 1024; }
  else { int t2 = task - 96; b = t2 / 12; hd = t2 % 12; L = 256; rowbase = b * 256; }
  const int h = hd >> 1, dir = hd & 1;
  const float* grec = (const float*)(p.ws + OFF_GREC);
  float* GO = (float*)(p.ws + OFF_GO) + (size_t)dir * NTOK * 384;
  float S[32];
  if (lat) {
    const float* s0 = p.in[I_SG] + ((((size_t)b * DEPTH + l) * 2 + dir) * 6 + h) * 2048 + lane;
#pragma unroll
    for (int d = 0; d < 32; ++d) S[d] = s0[d * 64];
  } else {
#pragma unroll
    for (int d = 0; d < 32; ++d) S[d] = 0.f;
  }
  const int nch = L / 8;
#pragma unroll
  for (int s = 0; s < 8; ++s) {
    int n = dir ? L - 1 - s : s;
    const char* g = (const char*)(grec + ((size_t)(rowbase + n) * 6 + h) * 256);
    glds16(g + lane * 16, lbuf + s * 1024);
  }
  for (int ch = 0; ch < nch; ++ch) {
    asm volatile("s_waitcnt vmcnt(0)" ::: "memory");
    if (ch + 1 < nch) {
      char* nb = lbuf + ((ch + 1) & 1) * 8192;
#pragma unroll
      for (int s = 0; s < 8; ++s) {
        int st = (ch + 1) * 8 + s;
        int n = dir ? L - 1 - st : st;
        const char* g = (const char*)(grec + ((size_t)(rowbase + n) * 6 + h) * 256);
        glds16(g + lane * 16, nb + s * 1024);
      }
    }
    const float* cb = (const float*)(lbuf + (ch & 1) * 8192);
    for (int s = 0; s < 8; ++s) {
      const float* r_ = cb + s * 256;
      const float* q = r_;
      const float* k = r_ + 32;
      const float* al = r_ + 64 + dir * 32;
      const float vv = r_[128 + lane];
      float o0 = 0.f, o1 = 0.f;
#pragma unroll
      for (int d = 0; d < 32; d += 2) {
        S[d] = al[d] * S[d] + k[d] * vv;
        S[d + 1] = al[d + 1] * S[d + 1] + k[d + 1] * vv;
        o0 += q[d] * S[d]; o1 += q[d + 1] * S[d + 1];
      }
      const int st = ch * 8 + s;
      const int n = dir ? L - 1 - st : st;
      GO[(size_t)(rowbase + n) * 384 + h * 64 + lane] = o0 + o1;
    }
  }
  if (!lat) {
    float* so = p.out + (size_t)NTOK * D + ((((size_t)b * DEPTH + l) * 2 + dir) * 6 + h) * 2048 + lane;
#pragma unroll
    for (int d = 0; d < 32; ++d) so[d * 64] = S[d];
  }
  asm volatile("s_waitcnt vmcnt(0)" ::: "memory");
}

__device__ __forceinline__ void hyena_task(const Params& p, int l, int task) {
  const int lane = otid() & 63;
  int b, cgp, tb, L, rowbase;
  const float* ft = (const float*)(p.ws + OFF_FT) + (size_t)l * FT_LAYER;
  if (task < 1024) { b = task >> 7; cgp = (task >> 5) & 3; tb = task & 31; L = 1024; rowbase = NCTX + b * 1024; ft += FT_L0; }
  else { int t2 = task - 1024; b = t2 >> 5; cgp = (t2 >> 3) & 3; tb = t2 & 7; L = 256; rowbase = b * 256; }
  const int c = cgp * 64 + lane;
  const int t0 = tb * 32;
  const float* hz = (const float*)(p.ws + OFF_HYZ) + (size_t)rowbase * 256 + c;
  const float* hx = (const float*)(p.ws + OFF_HYX) + (size_t)rowbase * 256 + c;
  const float* fc = ft + c;
  float acc[32];
#pragma unroll
  for (int i = 0; i < 32; ++i) acc[i] = 0.f;
  for (int s0 = 0; s0 < L; s0 += 16) {
    float z[16], f[47];
#pragma unroll
    for (int j = 0; j < 16; ++j) z[j] = hz[(size_t)(s0 + j) * 256];
    const float* fb = fc + (size_t)(t0 - s0 - 15 + L - 1) * 256;
#pragma unroll
    for (int m = 0; m < 47; ++m) f[m] = fb[(size_t)m * 256];
#pragma unroll
    for (int i = 0; i < 32; ++i)
#pragma unroll
      for (int j = 0; j < 16; ++j) acc[i] += f[i - j + 15] * z[j];
  }
  const float bias = p.in[I_HBIAS][l * 256 + c];
  unsigned short* O = (unsigned short*)(p.ws + OFF_H);
#pragma unroll
  for (int i = 0; i < 32; ++i) {
    int t = t0 + i;
    float zz = hz[(size_t)t * 256], xx = hx[(size_t)t * 256];
    O[(size_t)(rowbase + t) * D + 384 + c] = f2bf(xx * (acc[i] + zz * bias));
  }
}

__device__ __forceinline__ void phase_mixers(const Params& p, int l) {
  const int wave = otid() >> 6, lane = otid() & 63;
  if (wave < 2) {
    for (int t = wave * gridDim.x + obid(); t < 288; t += 2 * gridDim.x) rwkv_scan(p, l, t, smem + wave * 32768);
  } else if (wave < 4) {
    for (int t = (wave - 2) * gridDim.x + obid(); t < 288; t += 2 * gridDim.x)
      gla_scan(p, l, t, smem + 65536 + (wave - 2) * 16384);
  }
  int* cnt = (int*)(p.ws + OFF_CNT) + l;
  while (true) {
    int t = 0;
    if (lane == 0) t = atomicAdd(cnt, 1);
    t = __shfl(t, 0);
    if (t >= 1536) break;
    hyena_task(p, l, t);
  }
}

__device__ __forceinline__ void phase_post(const Params& p, int l) {
  const int wave = otid() >> 6, lane = otid() & 63;
  const float* GO = (const float*)(p.ws + OFF_GO);
  const float* RO = (const float*)(p.ws + OFF_RO);
  const float* grec = (const float*)(p.ws + OFF_GREC);
  const float* rec = (const float*)(p.ws + OFF_REC);
  unsigned short* O = (unsigned short*)(p.ws + OFF_H);
  const float gn = p.in[I_GN][l * 64 + lane];
  for (int R = obid() * 8 + wave; R < NTOK; R += gridDim.x * 8) {
    const int tokr = scan2tok(R);
#pragma unroll
    for (int h = 0; h < 6; ++h) {
      float o = GO[(size_t)R * 384 + h * 64 + lane] + GO[(size_t)(NTOK + R) * 384 + h * 64 + lane];
      float ms = wave_sum(o * o) * (1.f / 64.f);
      float y = o * rsqrtf(ms + 1e-6f) * gn;
      float g = grec[((size_t)R * 6 + h) * 256 + 192 + lane];
      O[(size_t)R * D + h * 64 + lane] = f2bf(y * siluf_(g));
    }
#pragma unroll
    for (int h = 0; h < 6; ++h) {
      const int c = h * 64 + lane;
      float o = RO[(size_t)R * 384 + c] + RO[(size_t)(NTOK + R) * 384 + c];
      float mean = wave_sum(o) * (1.f / 64.f);
      float dlt = o - mean;
      float var = wave_sum(dlt * dlt) * (1.f / 64.f);
      float y = dlt * rsqrtf(var + 64e-5f) * p.in[I_RLW][l * 384 + c] + p.in[I_RLB][l * 384 + c];
      const float* rr = rec + ((size_t)R * 6 + h) * 512 + lane;
      float r = rr[0], k2 = rr[64], v = rr[128], g = rr[448];
      float bonus = wave_sum(r * k2 * p.in[I_RRK][l * 384 + c]) * v;
      O[(size_t)tokr * D + 640 + c] = f2bf((y + bonus) * g);
    }
  }
}

__global__ void __launch_bounds__(NTHR) fwd_megakernel(Params p) {
  cg::grid_group grid = cg::this_grid();
  if (obid() == 0 && otid() < 64) ((int*)(p.ws + OFF_CNT))[otid()] = 0;
  p0_copy_x(p);
  p0_filters(p);
  p0_mod(p);
  __syncthreads();
  bf16* hbuf = (bf16*)(p.ws + OFF_H);
  bf16* hmid = (bf16*)(p.ws + OFF_HMID);
  float* xw = (float*)(p.ws + OFF_X);
  float* Pw = (float*)(p.ws + OFF_P);
  for (int l = 0; l < DEPTH; ++l) {
    const float* modl = (const float*)(p.ws + OFF_MOD) + (size_t)l * 9 * 9216;
    phase_wconv(p, l);
    grid.sync();
    phase_norm(p, p.in[I_F1N] + l * D, modl, 0, 1);
    grid.sync();
    phase_gemm(hbuf, p.ws + OFF_W1I, 5632, 1024, EpiSwiglu{(unsigned short*)hmid});
    grid.sync();
    phase_gemm(hmid, p.ws + OFF_W1O, 1024, 2816, EpiResid{xw, modl, 2, 0.5f});
    grid.sync();
    phase_norm(p, p.in[I_MN] + l * D, modl, 3, 4);
    grid.sync();
    phase_gemm(hbuf, p.ws + OFF_WMI, INCP, 1024, EpiP{Pw});
    grid.sync();
    prep_rwkv(p, l);
    prep_gla(p, l);
    prep_hyena(p, l);
    grid.sync();
    phase_mixers(p, l);
    grid.sync();
    phase_post(p, l);
    grid.sync();
    phase_gemm(hbuf, p.ws + OFF_WMO, 1024, 1024, EpiResid{xw, modl, 5, 1.0f});
    grid.sync();
    phase_norm(p, p.in[I_F2N] + l * D, modl, 6, 7);
    grid.sync();
    phase_gemm(hbuf, p.ws + OFF_W2I, 5632, 1024, EpiSwiglu{(unsigned short*)hmid});
    grid.sync();
    phase_gemm(hmid, p.ws + OFF_W2O, 1024, 2816, EpiResid{xw, modl, 8, 0.5f});
    grid.sync();
  }
  phase_final_norm(p);
}

extern "C" void kernel_launch(void* const* d_in, const int* in_sizes, int n_in, void* d_out, int out_size, void* d_ws,
                              size_t ws_size, hipStream_t stream) {
  static int grid_blocks = 0;
  if (!grid_blocks) {
    int dev = 0, cus = 0, per_cu = 0;
    (void)hipGetDevice(&dev);
    (void)hipDeviceGetAttribute(&cus, hipDeviceAttributeMultiprocessorCount, dev);
    (void)hipFuncSetAttribute((const void*)fwd_megakernel, hipFuncAttributeMaxDynamicSharedMemorySize, LDS_BYTES);
    (void)hipOccupancyMaxActiveBlocksPerMultiprocessor(&per_cu, fwd_megakernel, NTHR, LDS_BYTES);
    if (per_cu < 1) per_cu = 1;
    grid_blocks = cus * per_cu;
    if (grid_blocks > 256) grid_blocks = 256;
  }
  if (ws_size < WS_NEED) fprintf(stderr, "workspace too small: %zu < %zu\n", ws_size, (size_t)WS_NEED);
  Params p{};
  for (int i = 0; i < 41; ++i) p.in[i] = (const float*)d_in[i];
  p.out = (float*)d_out;
  p.ws = (char*)d_ws;
  void* args[] = {&p};
  hipError_t e = hipLaunchCooperativeKernel((void*)fwd_megakernel, dim3(grid_blocks), dim3(NTHR), args, LDS_BYTES, stream);
  if (e != hipSuccess) fprintf(stderr, "cooperative launch failed: %s (grid %d)\n", hipGetErrorString(e), grid_blocks);
}
```

```cpp
#include <hip/hip_runtime.h>
#include <hip/hip_bf16.h>
#include <hip/hip_cooperative_groups.h>
#include <cstdio>
namespace cg = cooperative_groups;

typedef __hip_bfloat16 bf16;
typedef __attribute__((ext_vector_type(8))) short bf16x8;
typedef __attribute__((ext_vector_type(4))) float f32x4;
typedef __attribute__((ext_vector_type(2))) float f32x2;

constexpr int D = 1024, NTOK = 12288, NCTX = 4096, DEPTH = 4, FH = 2816;
constexpr int INC = 3264, INCP = 3328;
constexpr int C_HY = 1184, C_RW = 1952;
constexpr int NTHR = 512;

constexpr size_t al256(size_t x) { return (x + 255) & ~(size_t)255; }
constexpr size_t OFF_CNT = 0;
constexpr size_t OFF_BAR = 4096;
constexpr size_t OFF_MOD = 4096 + 16384;
constexpr size_t SZ_MOD = (size_t)DEPTH * 9 * 9216 * 4;
constexpr size_t OFF_FT = al256(OFF_MOD + SZ_MOD);
constexpr size_t FT_L0 = 511 * 256, FT_L1 = 2047 * 256;
constexpr size_t FT_LAYER = FT_L0 + FT_L1;
constexpr size_t OFF_X = al256(OFF_FT + DEPTH * FT_LAYER * 4);
constexpr size_t OFF_H = al256(OFF_X + (size_t)NTOK * D * 4);
constexpr size_t OFF_W1I = al256(OFF_H + (size_t)NTOK * D * 2);
constexpr size_t OFF_W1O = al256(OFF_W1I + (size_t)5632 * 1024 * 2);
constexpr size_t OFF_WMI = al256(OFF_W1O + (size_t)1024 * 2816 * 2);
constexpr size_t OFF_WMO = al256(OFF_WMI + (size_t)INCP * 1024 * 2);
constexpr size_t OFF_W2I = al256(OFF_WMO + (size_t)1024 * 1024 * 2);
constexpr size_t OFF_W2O = al256(OFF_W2I + (size_t)5632 * 1024 * 2);
constexpr size_t WSET = al256(OFF_W2O + (size_t)1024 * 2816 * 2) - OFF_W1I;
constexpr size_t OFF_P = OFF_W1I + 2 * WSET;
constexpr size_t SZ_P = (size_t)NTOK * INC * 4;
constexpr size_t SZ_GO = (size_t)2 * NTOK * 384 * 4;
constexpr size_t OFF_GO = OFF_P;
constexpr size_t OFF_RO = OFF_P + SZ_GO;
constexpr size_t OFF_REC = al256(OFF_P + SZ_P);
constexpr size_t SZ_REC = (size_t)NTOK * 6 * 512 * 4;
constexpr size_t OFF_HMID = OFF_REC;
constexpr size_t OFF_GREC = al256(OFF_REC + SZ_REC);
constexpr size_t SZ_GREC = (size_t)NTOK * 6 * 256 * 4;
constexpr size_t OFF_HYZ = al256(OFF_GREC + SZ_GREC);
constexpr size_t OFF_HYX = al256(OFF_HYZ + (size_t)NTOK * 256 * 4);
constexpr size_t OFF_HZB = al256(OFF_HYX + (size_t)NTOK * 256 * 4);
constexpr size_t OFF_FTB = al256(OFF_HZB + (size_t)NTOK * 256 * 2);
constexpr size_t WS_NEED = al256(OFF_FTB + DEPTH * FT_LAYER * 2);

struct Params {
  const float* in[41];
  float* out;
  char* ws;
};

enum { I_XP = 0, I_XS, I_SG, I_SR, I_C, I_CCTX, I_ADAW, I_ADAB, I_F1N, I_F1WI, I_F1WO, I_MN, I_MWI, I_MWO,
       I_GW2, I_GB, I_GN, I_HCW, I_HCB, I_HW1, I_HB1, I_HW2, I_HB2, I_HFQ, I_HW3, I_HBIAS,
       I_RMU, I_RW0, I_RW2, I_RA0, I_RA2, I_RG2, I_RKK, I_RKA, I_RRK, I_RLW, I_RLB, I_F2N, I_F2WI, I_F2WO, I_FN };

extern __shared__ __attribute__((aligned(16))) char smem[];
constexpr int LDS_BYTES = 147600;

__device__ __forceinline__ int otid() { int t = (int)__builtin_amdgcn_workitem_id_x(); asm volatile("" : "+v"(t)); return t; }
__device__ __forceinline__ int obid() { int b = (int)__builtin_amdgcn_workgroup_id_x(); asm volatile("" : "+s"(b)); return b; }
__device__ __forceinline__ unsigned short f2bf(float f) {
  unsigned u = __float_as_uint(f);
  u += 0x7fffu + ((u >> 16) & 1u);
  return (unsigned short)(u >> 16);
}
__device__ __forceinline__ float dpp_f(float x, const int ctrl_sel) {
  int xi = __float_as_int(x), r;
  if (ctrl_sel == 0) r = __builtin_amdgcn_update_dpp(0, xi, 0xB1, 0xF, 0xF, true);
  else if (ctrl_sel == 1) r = __builtin_amdgcn_update_dpp(0, xi, 0x4E, 0xF, 0xF, true);
  else if (ctrl_sel == 2) r = __builtin_amdgcn_update_dpp(0, xi, 0x141, 0xF, 0xF, true);
  else r = __builtin_amdgcn_update_dpp(0, xi, 0x140, 0xF, 0xF, true);
  return __int_as_float(r);
}
__device__ __forceinline__ float wave_sum(float v) {
  v += dpp_f(v, 0); v += dpp_f(v, 1); v += dpp_f(v, 2); v += dpp_f(v, 3);
  const int vi = __float_as_int(v);
  return __int_as_float(__builtin_amdgcn_readlane(vi, 0)) + __int_as_float(__builtin_amdgcn_readlane(vi, 16)) +
         __int_as_float(__builtin_amdgcn_readlane(vi, 32)) + __int_as_float(__builtin_amdgcn_readlane(vi, 48));
}
__device__ __forceinline__ float sigmoidf_(float x) { return __builtin_amdgcn_rcpf(1.f + __builtin_amdgcn_exp2f(x * -1.4426950408889634f)); }
__device__ __forceinline__ float siluf_(float x) { return x * sigmoidf_(x); }
__device__ __forceinline__ int modrow(int row) { return row < NCTX ? 0 : 1 + ((row - NCTX) >> 10); }

__device__ __forceinline__ void p0_copy_x(const Params& p) {
  float4* x = (float4*)(p.ws + OFF_X);
  const float4* a = (const float4*)p.in[I_XP];
  const float4* b = (const float4*)p.in[I_XS];
  const size_t n4 = (size_t)NTOK * D / 4, nc4 = (size_t)NCTX * D / 4;
  for (size_t i = (size_t)obid() * NTHR + otid(); i < n4; i += (size_t)gridDim.x * NTHR)
    x[i] = i < nc4 ? a[i] : b[i - nc4];
}

__device__ __forceinline__ void p0_mod(const Params& p) {
  float* scond = (float*)smem;
  float* red = (float*)(smem + 40960);
  for (int i = otid(); i < 9 * 1024; i += NTHR) {
    int r = i >> 10, d = i & 1023;
    float c = r == 0 ? p.in[I_CCTX][d] : p.in[I_C][(r - 1) * 1024 + d];
    scond[i] = siluf_(c);
  }
  __syncthreads();
  float* mod = (float*)(p.ws + OFF_MOD);
  const int col = otid() & 63, ks = otid() >> 6;
  for (int task = obid(); task < DEPTH * 144; task += gridDim.x) {
    int l = task / 144, cg_ = task % 144;
    const float* w = p.in[I_ADAW] + (size_t)l * 1024 * 9216 + cg_ * 64 + col;
    float acc[9];
#pragma unroll
    for (int r = 0; r < 9; ++r) acc[r] = 0.f;
    for (int d0 = ks * 128; d0 < ks * 128 + 128; d0 += 8) {
      float wv[8];
#pragma unroll
      for (int u = 0; u < 8; ++u) wv[u] = w[(size_t)(d0 + u) * 9216];
#pragma unroll
      for (int u = 0; u < 8; ++u)
#pragma unroll
        for (int r = 0; r < 9; ++r) acc[r] += scond[r * 1024 + d0 + u] * wv[u];
    }
#pragma unroll
    for (int r = 0; r < 9; ++r) red[(ks * 9 + r) * 64 + col] = acc[r];
    __syncthreads();
    for (int i = otid(); i < 576; i += NTHR) {
      int r = i >> 6, c = i & 63;
      float s = 0.f;
#pragma unroll
      for (int k = 0; k < 8; ++k) s += red[(k * 9 + r) * 64 + c];
      int j = cg_ * 64 + c;
      mod[((size_t)l * 9 + r) * 9216 + j] = s + p.in[I_ADAB][l * 9216 + j];
    }
    __syncthreads();
  }
}

__device__ __forceinline__ void p0_filters(const Params& p) {
  const int wave = otid() >> 6, lane = otid() & 63;
  float* FT = (float*)(p.ws + OFF_FT);
  for (int task = obid() * 8 + wave; task < DEPTH * 1280; task += gridDim.x * 8) {
    int l = task / 1280, rem = task % 1280;
    int sel = rem >= 256, i = sel ? rem - 256 : rem, L = sel ? 1024 : 256;
    float t = (float)i / (float)(L - 1);
    float w = 6.283185307179586f * (float)i / (float)L;
    float zval = 0.f;
    {
      const float fstep = (15.f - 1e-4f) / 15.f;
      if (lane == 0) zval = t;
      else if (lane <= 16) zval = cosf((1e-4f + (float)(lane - 1) * fstep) * w);
      else if (lane <= 32) zval = -sinf((1e-4f + (float)(lane - 17) * fstep) * w);
    }
    const float* w1 = p.in[I_HW1] + l * 33 * 64;
    const float* w2 = p.in[I_HW2] + l * 64 * 64;
    const float* w3 = p.in[I_HW3] + l * 64 * 512;
    const float* fq = p.in[I_HFQ] + l * 128;
    float h1 = p.in[I_HB1][l * 64 + lane];
    for (int e = 0; e < 33; ++e) h1 += __shfl(zval, e) * w1[e * 64 + lane];
    h1 = sinf(fq[lane] * h1);
    float h2 = p.in[I_HB2][l * 64 + lane];
    for (int e = 0; e < 64; ++e) h2 += __shfl(h1, e) * w2[e * 64 + lane];
    h2 = sinf(fq[64 + lane] * h2);
    float acc[8];
#pragma unroll
    for (int m = 0; m < 8; ++m) acc[m] = 0.f;
    for (int e = 0; e < 64; ++e) {
      float hv = __shfl(h2, e);
#pragma unroll
      for (int m = 0; m < 8; ++m) acc[m] += hv * w3[e * 512 + m * 64 + lane];
    }
    float* ft = FT + (size_t)l * FT_LAYER + (sel ? FT_L0 : 0);
    const float a0 = -3.0701134573253945f, a1 = -15.350567286626973f;
#pragma unroll
    for (int m = 0; m < 8; ++m) {
      int cp = m * 64 + lane, c = cp & 255;
      float delta = fabsf(a0 + (float)c * ((a1 - a0) / 255.f));
      float val = acc[m] * expf(-t * delta);
      unsigned short* ftb = (unsigned short*)(p.ws + OFF_FTB) + (size_t)l * FT_LAYER + (sel ? FT_L0 : 0);
      if (cp < 256) { ft[(size_t)(L - 1 + i) * 256 + c] = val; ftb[(size_t)(L - 1 + i) * 256 + c] = f2bf(val); }
      else if (i >= 1) { ft[(size_t)(L - 1 - i) * 256 + c] = val; ftb[(size_t)(L - 1 - i) * 256 + c] = f2bf(val); }
    }
  }
}

__device__ __forceinline__ void conv_tile(const float* src, int srcN, int k0, int srccol0, bool zero, bf16* dst, int dstK, int n0) {
  float* tile = (float*)smem;
  const int tid = otid();
  {
    int r = tid >> 4, c4 = (tid & 15) * 4;
#pragma unroll
    for (int rr = 0; rr < 2; ++rr) {
      int row = r + rr * 32;
      float4 v = zero ? make_float4(0.f, 0.f, 0.f, 0.f)
                      : *(const float4*)(src + (size_t)(k0 + row) * srcN + srccol0 + c4);
      tile[row * 65 + c4 + 0] = v.x; tile[row * 65 + c4 + 1] = v.y;
      tile[row * 65 + c4 + 2] = v.z; tile[row * 65 + c4 + 3] = v.w;
    }
  }
  __syncthreads();
  {
    int nn = tid >> 3, ks = (tid & 7) * 8;
    unsigned short v[8];
#pragma unroll
    for (int j = 0; j < 8; ++j) v[j] = f2bf(tile[(ks + j) * 65 + nn]);
    uint4 o;
    o.x = v[0] | ((unsigned)v[1] << 16); o.y = v[2] | ((unsigned)v[3] << 16);
    o.z = v[4] | ((unsigned)v[5] << 16); o.w = v[6] | ((unsigned)v[7] << 16);
    *(uint4*)(dst + (size_t)(n0 + nn) * dstK + k0 + ks) = o;
  }
  __syncthreads();
}

__device__ __forceinline__ unsigned cvt_pk_bf16_(float lo, float hi) { unsigned r; asm volatile("v_cvt_pk_bf16_f32 %0, %1, %2" : "=v"(r) : "v"(lo), "v"(hi)); return r; }
struct WTile { const float* src; int srcN, k0, srccol, dstK, n0; bool zero; size_t dstoff; };
__device__ __forceinline__ WTile wtile_decode(const Params& p, int l, int u) {
  WTile w;
  w.zero = false;
  if (u < 1408 || (u >= 3200 && u < 4608)) {
    const bool second = u >= 3200;
    if (second) u -= 3200;
    w.src = p.in[second ? I_F2WI : I_F1WI] + (size_t)l * 1024 * 5632;
    w.dstoff = second ? OFF_W2I : OFF_W1I;
    const int tn = u % 88, tk = u / 88;
    const int n0 = tn * 64, pn = n0 >> 8, within = n0 & 255;
    w.srccol = within < 128 ? pn * 128 + within : 2816 + pn * 128 + (within - 128);
    w.srcN = 5632; w.k0 = tk * 64; w.dstK = 1024; w.n0 = n0;
  } else if ((u >= 1408 && u < 2112) || u >= 4608) {
    const bool second = u >= 4608;
    u -= second ? 4608 : 1408;
    w.src = p.in[second ? I_F2WO : I_F1WO] + (size_t)l * 2816 * 1024;
    w.dstoff = second ? OFF_W2O : OFF_W1O;
    const int tn = u % 16, tk = u / 16;
    w.srcN = 1024; w.k0 = tk * 64; w.srccol = tn * 64; w.dstK = 2816; w.n0 = tn * 64;
  } else if (u < 2944) {
    u -= 2112;
    w.src = p.in[I_MWI] + (size_t)l * 1024 * INC;
    w.dstoff = OFF_WMI;
    const int tn = u % 52, tk = u / 52;
    w.srcN = INC; w.k0 = tk * 64; w.srccol = tn * 64; w.dstK = 1024; w.n0 = tn * 64; w.zero = tn == 51;
  } else {
    u -= 2944;
    w.src = p.in[I_MWO] + (size_t)l * 1024 * 1024;
    w.dstoff = OFF_WMO;
    const int tn = u % 16, tk = u / 16;
    w.srcN = 1024; w.k0 = tk * 64; w.srccol = tn * 64; w.dstK = 1024; w.n0 = tn * 64;
  }
  return w;
}
__device__ __forceinline__ void phase_wconv(const Params& p, int l, int set) {
  for (int t = obid(); t < 5312; t += gridDim.x) {
    const WTile w = wtile_decode(p, l, t);
    conv_tile(w.src, w.srcN, w.k0, w.srccol, w.zero, (bf16*)(p.ws + w.dstoff + (size_t)set * WSET), w.dstK, w.n0);
  }
}
__device__ __forceinline__ void wconv_wave(const Params& p, int l, int set, int u) {
  const int lane = otid() & 63;
  const WTile w = wtile_decode(p, l, u);
  unsigned pk[32];
  if (!w.zero) {
    const float* s = w.src + (size_t)w.k0 * w.srcN + w.srccol + lane;
#pragma unroll
    for (int kk = 0; kk < 64; kk += 2) pk[kk >> 1] = cvt_pk_bf16_(s[(size_t)kk * w.srcN], s[(size_t)(kk + 1) * w.srcN]);
  } else {
#pragma unroll
    for (int i = 0; i < 32; ++i) pk[i] = 0u;
  }
  uint4* d = (uint4*)((unsigned short*)(p.ws + w.dstoff + (size_t)set * WSET) + (size_t)(w.n0 + lane) * w.dstK + w.k0);
#pragma unroll
  for (int i = 0; i < 8; ++i) d[i] = make_uint4(pk[4 * i], pk[4 * i + 1], pk[4 * i + 2], pk[4 * i + 3]);
}

__device__ __forceinline__ void phase_norm(const Params& p, const float* gain, const float* modl, int shi, int sci) {
  const int wave = otid() >> 6, lane = otid() & 63;
  const float* x = (const float*)(p.ws + OFF_X);
  bf16* h = (bf16*)(p.ws + OFF_H);
  for (int row = obid() * 8 + wave; row < NTOK; row += gridDim.x * 8) {
    const float4* xr = (const float4*)(x + (size_t)row * D);
    float4 v[4];
    float ss = 0.f;
#pragma unroll
    for (int i = 0; i < 4; ++i) {
      v[i] = xr[i * 64 + lane];
      ss += v[i].x * v[i].x + v[i].y * v[i].y + v[i].z * v[i].z + v[i].w * v[i].w;
    }
    ss = wave_sum(ss);
    float rstd = rsqrtf(ss * (1.f / 1024.f) + 1e-6f);
    const float* mr = modl + (size_t)modrow(row) * 9216;
    const float4* sc = (const float4*)(mr + sci * 1024);
    const float4* sh = (const float4*)(mr + shi * 1024);
    const float4* g4 = (const float4*)gain;
#pragma unroll
    for (int i = 0; i < 4; ++i) {
      float4 g = g4[i * 64 + lane], s = sc[i * 64 + lane], b = sh[i * 64 + lane];
      float y0 = v[i].x * rstd * g.x * (1.f + s.x) + b.x;
      float y1 = v[i].y * rstd * g.y * (1.f + s.y) + b.y;
      float y2 = v[i].z * rstd * g.z * (1.f + s.z) + b.z;
      float y3 = v[i].w * rstd * g.w * (1.f + s.w) + b.w;
      uint2 o;
      o.x = f2bf(y0) | ((unsigned)f2bf(y1) << 16);
      o.y = f2bf(y2) | ((unsigned)f2bf(y3) << 16);
      *(uint2*)(h + (size_t)row * D + (i * 64 + lane) * 4) = o;
    }
  }
}

__device__ __forceinline__ void phase_final_norm(const Params& p) {
  const int wave = otid() >> 6, lane = otid() & 63;
  const float* x = (const float*)(p.ws + OFF_X);
  const float4* g4 = (const float4*)p.in[I_FN];
  for (int row = obid() * 8 + wave; row < NTOK; row += gridDim.x * 8) {
    const float4* xr = (const float4*)(x + (size_t)row * D);
    float4 v[4];
    float ss = 0.f;
#pragma unroll
    for (int i = 0; i < 4; ++i) {
      v[i] = xr[i * 64 + lane];
      ss += v[i].x * v[i].x + v[i].y * v[i].y + v[i].z * v[i].z + v[i].w * v[i].w;
    }
    ss = wave_sum(ss);
    float rstd = rsqrtf(ss * (1.f / 1024.f) + 1e-6f);
    float4* o = (float4*)(p.out + (size_t)row * D);
#pragma unroll
    for (int i = 0; i < 4; ++i) {
      float4 g = g4[i * 64 + lane];
      o[i * 64 + lane] = make_float4(v[i].x * rstd * g.x, v[i].y * rstd * g.y, v[i].z * rstd * g.z, v[i].w * rstd * g.w);
    }
  }
}

namespace pg8 {
#define PG8_LAS __attribute__((address_space(3)))
typedef unsigned short bf16_t;
typedef short bf16x8 __attribute__((ext_vector_type(8)));
typedef float f32x4 __attribute__((ext_vector_type(4)));
typedef unsigned u32x4 __attribute__((ext_vector_type(4)));
constexpr int BM = 256, BK = 64, HALF = 128, HTB = HALF * BK * 2  , STAGE_BYTES = 8 * HTB, NXCD = 8, WGM = 8;

__host__ __device__ __forceinline__ int lds_byte(int r, int c) { const int st = (r >> 4) * 2 + (c >> 5), rr = r & 15, cc = c & 31, ob = rr * 64 + cc * 2; return st * 1024 + (ob ^ (((ob >> 9) & 1) << 5)); }
__host__ __device__ __forceinline__ void stage_rc(int b, int& R, int& C) { const int st = b / 1024, sb = b % 1024, swz = sb ^ (((sb >> 9) & 1) << 5); R = (st >> 1) * 16 + swz / 64; C = (st & 1) * 32 + (swz % 64) / 2; }
__host__ __device__ __forceinline__ int perm32(int rho) { const int n = rho >> 4, i = rho & 15; return 8 * (i >> 2) + 4 * n + (i & 3); }

struct Unit { int pm, pn; };
struct Gemm { const bf16_t* A; const bf16_t* Bt; int M, N, K; };

struct StaticOrder {
    int nM, nN, nwg, G, c;
    __host__ __device__ void init(int M, int N, int G_, int c_) { nM = M / BM; nN = N / BM; nwg = nM * nN; G = G_; c = c_; }
    __host__ __device__ bool next(int i, Unit& u) const {
        const long L = (long)i * G + c; if (L >= nwg) return false;
        int wgid = (int)L; { const int q = nwg / NXCD, r = nwg % NXCD, xcd = wgid % NXCD, off = wgid / NXCD; wgid = (xcd < r ? xcd * (q + 1) : r * (q + 1) + (xcd - r) * q) + off; }
        const int nig = WGM * nN, gid = wgid / nig, fm = gid * WGM, gsz = (nM - fm) < WGM ? (nM - fm) : WGM;
        u.pm = fm + ((wgid % nig) % gsz); u.pn = (wgid % nig) / gsz; return true;
    }
    __device__ __forceinline__ void a_ready(const Unit&) const {}
    __device__ __forceinline__ void done(const Unit&) const {}
};
__device__ __forceinline__ unsigned cvt_pk_bf16(float lo, float hi) { unsigned r; asm volatile("v_cvt_pk_bf16_f32 %0, %1, %2" : "=v"(r) : "v"(lo), "v"(hi)); return r; }

template <class Epi, class Sched, bool STAMP = false>
__device__ __forceinline__ void gemm_phase(PG8_LAS unsigned char* lds, const Gemm g, const Sched& S, const Epi& E, unsigned long long* stamps) {
    const int tid = otid(), wid = __builtin_amdgcn_readfirstlane(tid >> 6), lane = tid & 63, wr = wid >> 2, wc = wid & 3, fr = lane & 15, fq = lane >> 4;
    const int K = g.K, nt = K / BK;
    int ts_lo = 0, ts_hi = 0, nts = 0; const unsigned long long rt_entry = STAMP ? (unsigned long long)wall_clock64() : 0ull;
#define PG8_STAMP() do { if (STAMP && wid == 0 && nts < 64) { const unsigned long long _c = (unsigned long long)clock64(); \
        ts_lo = (lane == nts) ? (int)(unsigned)_c : ts_lo; ts_hi = (lane == nts) ? (int)(unsigned)(_c >> 32) : ts_hi; ++nts; } } while (0)
    PG8_STAMP();
    unsigned voffA[2], voffB[2];
#pragma unroll
    for (int i = 0; i < 2; ++i) { int R, C; stage_rc(tid * 16 + i * 8192, R, C); const int Rb = Epi::PERM ? ((R & ~31) + perm32(R & 31)) : R;
        voffA[i] = (unsigned)(R * K + C) * 2u; voffB[i] = (unsigned)(Rb * K + C) * 2u; }
    const size_t kstep = (size_t)(BK * 2);
    const size_t hstep = (size_t)HALF * K * 2;
    const size_t tstep = 2 * hstep;
    const unsigned ldsw = (unsigned)wid * 1024u;
    const int aoff = lds_byte(wr * 64 + fr, fq * 8), boff = lds_byte(wc * 32 + fr, fq * 8);
#define PG8_SA(b, h) (((b) * 2 + (h)) * HTB)
#define PG8_SB(b, h) ((4 + (b) * 2 + (h)) * HTB)
#define PG8_STAGE(bufoff, gbase, voff) do { _Pragma("unroll") for (int _i = 0; _i < 2; ++_i) \
        __builtin_amdgcn_global_load_lds((const unsigned*)((const char*)(gbase) + (voff)[_i]), (PG8_LAS unsigned*)(lds + (bufoff) + ldsw + _i * 8192), 16, 0, 0); } while (0)
#define PG8_LDA(dst, b, h) do { _Pragma("unroll") for (int m = 0; m < 4; ++m) _Pragma("unroll") for (int k = 0; k < 2; ++k) dst[m][k] = *(const PG8_LAS bf16x8*)(lds + PG8_SA(b, h) + aoff + m * 2048 + k * 1024); } while (0)
#define PG8_LDB(dst, b, h) do { _Pragma("unroll") for (int n = 0; n < 2; ++n) _Pragma("unroll") for (int k = 0; k < 2; ++k) dst[n][k] = *(const PG8_LAS bf16x8*)(lds + PG8_SB(b, h) + boff + n * 2048 + k * 1024); } while (0)
#define PG8_MMA(ai, bj, At, Bt) do { __builtin_amdgcn_s_setprio(1); _Pragma("unroll") for (int m = 0; m < 4; ++m) _Pragma("unroll") for (int n = 0; n < 2; ++n) _Pragma("unroll") for (int k = 0; k < 2; ++k) \
        acc[ai][bj][m][n] = __builtin_amdgcn_mfma_f32_16x16x32_bf16(Bt[n][k], At[m][k], acc[ai][bj][m][n], 0, 0, 0); __builtin_amdgcn_s_setprio(0); } while (0)
#define PG8_WAIT_V(n) asm volatile("s_waitcnt vmcnt(" #n ")" ::: "memory")
#define PG8_WAIT_L(n) asm volatile("s_waitcnt lgkmcnt(" #n ")" ::: "memory")
#define PG8_BAR __builtin_amdgcn_s_barrier()
#define PG8_SCHED __builtin_amdgcn_sched_barrier(0)
    Unit cur, nxt; int ui = 0;
    if (!S.next(0, cur)) return;
    f32x4 acc[2][2][4][2];
#pragma unroll
    for (int a = 0; a < 2; ++a)
#pragma unroll
        for (int b = 0; b < 2; ++b)
#pragma unroll
            for (int m = 0; m < 4; ++m)
#pragma unroll
                for (int n = 0; n < 2; ++n) acc[a][b][m][n] = (f32x4){0.f, 0.f, 0.f, 0.f};
    bf16x8 At[4][2], B0[2][2], B1[2][2];
    const char* cA = (const char*)g.A + (size_t)cur.pm * tstep; const char* cB = (const char*)g.Bt + (size_t)cur.pn * tstep;
    S.a_ready(cur);
    PG8_STAGE(PG8_SB(0, 0), cB, voffB); PG8_STAGE(PG8_SA(0, 0), cA, voffA); PG8_STAGE(PG8_SB(0, 1), cB + hstep, voffB); PG8_STAGE(PG8_SA(0, 1), cA + hstep, voffA);
    if (wr == 1) PG8_BAR;
    PG8_WAIT_V(4); PG8_BAR;
    PG8_STAGE(PG8_SB(1, 0), cB + kstep, voffB); PG8_STAGE(PG8_SA(1, 0), cA + kstep, voffA); PG8_STAGE(PG8_SB(1, 1), cB + hstep + kstep, voffB);
    PG8_WAIT_V(6); PG8_BAR;
    PG8_STAMP();
    for (;;) {
        const bool has_next = S.next(ui + 1, nxt);
        const char* nA = has_next ? (const char*)g.A + (size_t)nxt.pm * tstep : cA; const char* nB = has_next ? (const char*)g.Bt + (size_t)nxt.pn * tstep : cB;
        for (int t = 0; t < nt; t += 2) {
            const bool last = (t == nt - 2);
            const char* a1 = cA + (size_t)(t + 1) * kstep;
            const char* a2 = last ? nA : cA + (size_t)(t + 2) * kstep; const char* b2 = last ? nB : cB + (size_t)(t + 2) * kstep;
            const char* a3 = a2 + kstep; const char* b3 = b2 + kstep;
            if (last && has_next) S.a_ready(nxt);
            PG8_LDB(B0, 0, 0); PG8_SCHED; PG8_LDA(At, 0, 0); PG8_STAGE(PG8_SA(1, 1), a1 + hstep, voffA);
            PG8_WAIT_L(8); PG8_BAR; PG8_WAIT_L(0); PG8_MMA(0, 0, At, B0); PG8_BAR; PG8_SCHED;
            PG8_LDB(B1, 0, 1); PG8_STAGE(PG8_SB(0, 0), b2, voffB);
            PG8_BAR; PG8_WAIT_L(0); PG8_MMA(0, 1, At, B1); PG8_BAR;
            PG8_LDA(At, 0, 1); PG8_STAGE(PG8_SA(0, 0), a2, voffA);
            PG8_BAR; PG8_WAIT_L(0); PG8_MMA(1, 0, At, B0); PG8_BAR; PG8_SCHED;
            PG8_STAGE(PG8_SB(0, 1), b2 + hstep, voffB);
            PG8_WAIT_V(6); PG8_BAR; PG8_MMA(1, 1, At, B1); PG8_BAR;
            PG8_LDB(B0, 1, 0); PG8_SCHED; PG8_LDA(At, 1, 0); PG8_STAGE(PG8_SA(0, 1), a2 + hstep, voffA);
            PG8_WAIT_L(8); PG8_BAR; PG8_WAIT_L(0); PG8_MMA(0, 0, At, B0); PG8_BAR; PG8_SCHED;
            PG8_LDB(B1, 1, 1); PG8_STAGE(PG8_SB(1, 0), b3, voffB);
            PG8_BAR; PG8_WAIT_L(0); PG8_MMA(0, 1, At, B1); PG8_BAR;
            PG8_LDA(At, 1, 1); PG8_STAGE(PG8_SA(1, 0), a3, voffA);
            PG8_BAR; PG8_WAIT_L(0); PG8_MMA(1, 0, At, B0); PG8_BAR; PG8_SCHED;
            PG8_STAGE(PG8_SB(1, 1), b3 + hstep, voffB);
            PG8_WAIT_V(6); PG8_BAR; PG8_MMA(1, 1, At, B1); PG8_BAR;
        }
        PG8_STAMP();
        if constexpr (!Epi::AFTER_DRAIN) { E(acc, cur, wr, wc, fr, fq); S.done(cur); }
        PG8_STAMP();
        if (!has_next) break;
#pragma unroll
        for (int a = 0; a < 2; ++a)
#pragma unroll
            for (int b = 0; b < 2; ++b)
#pragma unroll
                for (int m = 0; m < 4; ++m)
#pragma unroll
                    for (int n = 0; n < 2; ++n) acc[a][b][m][n] = (f32x4){0.f, 0.f, 0.f, 0.f};
        cur = nxt; cA = nA; cB = nB; ++ui;
    }
    PG8_WAIT_V(0);
    if (wr == 0) PG8_BAR;
    PG8_BAR;
    if constexpr (Epi::AFTER_DRAIN) { E.fused(acc, cur, wr, wc, fr, fq, lds, wid, lane); S.done(cur); }
    PG8_STAMP();
    if (STAMP && wid == 0) { stamps[lane] = lane < nts ? (((unsigned long long)(unsigned)ts_hi << 32) | (unsigned)ts_lo) : 0ull;
        if (lane == 62) stamps[62] = rt_entry; if (lane == 63) stamps[63] = (unsigned long long)wall_clock64(); }
#undef PG8_STAMP
#undef PG8_SA
#undef PG8_SB
#undef PG8_STAGE
#undef PG8_LDA
#undef PG8_LDB
#undef PG8_MMA
#undef PG8_WAIT_V
#undef PG8_WAIT_L
#undef PG8_BAR
#undef PG8_SCHED
}
}

struct EpiSwiglu {
  static constexpr bool PERM = true, AFTER_DRAIN = false;
  unsigned short* H;
  __device__ __forceinline__ void operator()(const pg8::f32x4 (&acc)[2][2][4][2], const pg8::Unit& u, int wr, int wc, int fr, int fq) const {
    const int row0 = u.pm * 256 + wr * 64 + fr, hc0 = u.pn * 128 + wc * 32 + 8 * fq;
#pragma unroll
    for (int ai = 0; ai < 2; ++ai)
#pragma unroll
      for (int m = 0; m < 4; ++m) {
        unsigned short* rowp = H + (size_t)(row0 + ai * 128 + m * 16) * FH + hc0;
        float v[8];
#pragma unroll
        for (int n = 0; n < 2; ++n)
#pragma unroll
          for (int i = 0; i < 4; ++i) v[n * 4 + i] = siluf_(acc[ai][0][m][n][i]) * acc[ai][1][m][n][i];
        pg8::u32x4 o;
        o[0] = pg8::cvt_pk_bf16(v[0], v[1]); o[1] = pg8::cvt_pk_bf16(v[2], v[3]);
        o[2] = pg8::cvt_pk_bf16(v[4], v[5]); o[3] = pg8::cvt_pk_bf16(v[6], v[7]);
        *(pg8::u32x4*)rowp = o;
      }
  }
};
struct EpiResid {
  static constexpr bool PERM = false, AFTER_DRAIN = false;
  float* X; const float* modl; int gidx; float scale;
  __device__ __forceinline__ void operator()(const pg8::f32x4 (&acc)[2][2][4][2], const pg8::Unit& u, int wr, int wc, int fr, int fq) const {
    const int row0 = u.pm * 256 + wr * 64 + fr, col0 = u.pn * 256 + wc * 32 + 4 * fq;
#pragma unroll
    for (int ai = 0; ai < 2; ++ai)
#pragma unroll
      for (int m = 0; m < 4; ++m) {
        const int row = row0 + ai * 128 + m * 16;
        const float* gt = modl + (size_t)modrow(row) * 9216 + gidx * 1024 + col0;
        float* xp = X + (size_t)row * D + col0;
#pragma unroll
        for (int bj = 0; bj < 2; ++bj)
#pragma unroll
          for (int n = 0; n < 2; ++n) {
            pg8::f32x4 g = *(const pg8::f32x4*)(gt + bj * 128 + n * 16);
            pg8::f32x4* q = (pg8::f32x4*)(xp + bj * 128 + n * 16);
            *q = *q + (g * scale) * acc[ai][bj][m][n];
          }
      }
  }
};
struct EpiP {
  static constexpr bool PERM = false, AFTER_DRAIN = false;
  float* P;
  __device__ __forceinline__ void operator()(const pg8::f32x4 (&acc)[2][2][4][2], const pg8::Unit& u, int wr, int wc, int fr, int fq) const {
    const int row0 = u.pm * 256 + wr * 64 + fr, col0 = u.pn * 256 + wc * 32 + 4 * fq;
#pragma unroll
    for (int ai = 0; ai < 2; ++ai)
#pragma unroll
      for (int m = 0; m < 4; ++m) {
        float* rp = P + (size_t)(row0 + ai * 128 + m * 16) * INC;
#pragma unroll
        for (int bj = 0; bj < 2; ++bj)
#pragma unroll
          for (int n = 0; n < 2; ++n) {
            const int col = col0 + bj * 128 + n * 16;
            if (col < INC) *(pg8::f32x4*)(rp + col) = acc[ai][bj][m][n];
          }
      }
  }
};

template <class Epi>
__device__ __forceinline__ void phase_gemm(const void* A, const void* Bt, int N, int K, const Epi& E) {
  pg8::Gemm g; g.A = (const pg8::bf16_t*)A; g.Bt = (const pg8::bf16_t*)Bt; g.M = NTOK; g.N = N; g.K = K;
  int c_ = obid(), G_ = (int)gridDim.x;
  asm volatile("" : "+s"(c_), "+s"(G_));
  pg8::StaticOrder S; S.init(NTOK, N, G_, c_);
  pg8::gemm_phase<Epi, pg8::StaticOrder, false>((PG8_LAS unsigned char*)smem, g, S, E, nullptr);
  __syncthreads();
}

__device__ __forceinline__ int scan2tok(int R) {
  if (R < NCTX) return R;
  int q = R - NCTX, b = q >> 10, n = q & 1023;
  return NCTX + b * 1024 + (n & 15) * 64 + (n >> 4);
}

__device__ __forceinline__ float rw_shift(const float* P, int R, int n, int L, int c, float mu) {
  float pc = P[(size_t)scan2tok(R) * INC + C_RW + c];
  float pp = n > 0 ? P[(size_t)scan2tok(R - 1) * INC + C_RW + c] : 0.f;
  float pn = n < L - 1 ? P[(size_t)scan2tok(R + 1) * INC + C_RW + c] : 0.f;
  return pc + (0.5f * (pp + pn) - pc) * mu;
}

__device__ __forceinline__ float rdlane(float v, int l) { return __int_as_float(__builtin_amdgcn_readlane(__float_as_int(v), l)); }

__device__ __forceinline__ void prep_rwkv(const Params& p, int l) {
  const int wave = otid() >> 6, lane = otid() & 63;
  const float* P = (const float*)(p.ws + OFF_P);
  float* rec = (float*)(p.ws + OFF_REC);
  const float* mu = p.in[I_RMU] + l * 1312;
  const float* w0 = p.in[I_RW0] + l * 768;
  const float* w2 = p.in[I_RW2] + (size_t)l * 64 * 384;
  const float* a0 = p.in[I_RA0] + l * 384;
  const float* a2 = p.in[I_RA2] + (size_t)l * 32 * 384;
  const float* g2 = p.in[I_RG2] + (size_t)l * 64 * 384;
  const float* kkw = p.in[I_RKK] + l * 384;
  const float* kaw = p.in[I_RKA] + l * 384;
  float* wl = (float*)smem;
#pragma unroll 1
  for (int hp = 0; hp < 2; ++hp) {
    const int hb = hp * 3;
    __syncthreads();
    for (int i = otid(); i < 160 * 48; i += NTHR) {
      const int r = i / 48, c4 = (i % 48) * 4;
      const float* src = (r < 64 ? w2 + r * 384 : (r < 96 ? a2 + (r - 64) * 384 : g2 + (r - 96) * 384)) + hb * 64 + c4;
      *(float4*)(wl + r * 192 + c4) = *(const float4*)src;
    }
    __syncthreads();
    for (int task = obid() * 8 + wave; task < NTOK / 6; task += gridDim.x * 8) {
      const int R0 = task * 6;
      int nn[6], LL[6];
#pragma unroll
      for (int tp = 0; tp < 6; ++tp) {
        const int R = R0 + tp;
        if (R < NCTX) { nn[tp] = R & 255; LL[tp] = 256; } else { nn[tp] = (R - NCTX) & 1023; LL[tp] = 1024; }
      }
      float x0[6], x1[6], x2[6];
#pragma unroll
      for (int tp = 0; tp < 6; ++tp) {
        x0[tp] = rw_shift(P, R0 + tp, nn[tp], LL[tp], 1152 + lane, mu[1152 + lane]);
        x1[tp] = rw_shift(P, R0 + tp, nn[tp], LL[tp], 1216 + lane, mu[1216 + lane]);
        const int c2 = 1280 + (lane & 31);
        x2[tp] = rw_shift(P, R0 + tp, nn[tp], LL[tp], c2, mu[c2]);
        if (tp & 1) __builtin_amdgcn_sched_barrier(0);
      }
      float kx[3][6];
#pragma unroll
      for (int h = 0; h < 3; ++h) {
        const int c = (hb + h) * 64 + lane;
#pragma unroll
        for (int tp = 0; tp < 6; ++tp) {
          kx[h][tp] = rw_shift(P, R0 + tp, nn[tp], LL[tp], 384 + c, mu[384 + c]);
        }
      }
#pragma unroll
      for (int tp = 0; tp < 6; ++tp) {
        x0[tp] = tanhf(x0[tp]);
        x1[tp] = lane < 32 ? x1[tp] : sigmoidf_(x1[tp]);
        x2[tp] = sigmoidf_(x2[tp]);
      }
      float af[3][6], ab[3][6], aa[3][6], ag[3][6];
#pragma unroll
      for (int h = 0; h < 3; ++h)
#pragma unroll
        for (int tp = 0; tp < 6; ++tp) { af[h][tp] = 0.f; ab[h][tp] = 0.f; aa[h][tp] = 0.f; ag[h][tp] = 0.f; }
      const float* wlp = wl + lane;
      for (int j = 0; j < 32; ++j) {
        float wc[15];
#pragma unroll
        for (int h = 0; h < 3; ++h) {
          wc[h] = wlp[j * 192 + h * 64]; wc[3 + h] = wlp[(32 + j) * 192 + h * 64];
          wc[6 + h] = wlp[(64 + j) * 192 + h * 64]; wc[9 + h] = wlp[(96 + j) * 192 + h * 64]; wc[12 + h] = wlp[(128 + j) * 192 + h * 64];
        }
#pragma unroll
        for (int tp = 0; tp < 6; ++tp) {
          const float sf = rdlane(x0[tp], j), sb = rdlane(x0[tp], 32 + j), sA = rdlane(x1[tp], j), sg = rdlane(x1[tp], 32 + j), sh = rdlane(x2[tp], j);
#pragma unroll
          for (int h = 0; h < 3; ++h) {
            af[h][tp] += sf * wc[h]; ab[h][tp] += sb * wc[3 + h]; aa[h][tp] += sA * wc[6 + h];
            ag[h][tp] += sg * wc[9 + h]; ag[h][tp] += sh * wc[12 + h];
          }
        }
      }
      int R0e = R0;
      asm volatile("" : "+v"(R0e));
#pragma unroll
      for (int h = 0; h < 3; ++h) {
        const int c = (hb + h) * 64 + lane;
#pragma unroll
        for (int tp = 0; tp < 6; ++tp) {
          const int R = R0e + tp;
          const float kxv = kx[h][tp];
          const float aav = aa[h][tp], afv = af[h][tp], abv = ab[h][tp], agv = ag[h][tp];
          float a = sigmoidf_(a0[c] + aav);
          float kk = kxv * kkw[c];
          float ss = wave_sum(kk * kk);
          kk = kk * rsqrtf(fmaxf(ss, 1e-24f));
          float k2 = kxv * (1.f + (a - 1.f) * kaw[c]);
          float uf = w0[c] + afv, ub = w0[384 + c] + abv;
          float df = expf(-0.6065306597126334f * sigmoidf_(uf));
          float db = expf(-0.6065306597126334f * sigmoidf_(ub));
          const float r_ = rw_shift(P, R, nn[tp], LL[tp], c, mu[c]);
          const float v_ = rw_shift(P, R, nn[tp], LL[tp], 768 + c, mu[768 + c]);
          float* o = rec + ((size_t)R * 6 + hb + h) * 512 + lane;
          o[0] = r_; o[128] = v_;
          o[64] = k2; o[192] = -kk; o[256] = kk * a; o[320] = df; o[384] = db; o[448] = agv;
        }
      }
    }
  }
  __syncthreads();
}

__device__ __forceinline__ float logsigmoidf_(float x) { return fminf(x, 0.f) - log1pf(expf(-fabsf(x))); }

__device__ __forceinline__ void prep_gla(const Params& p, int l) {
  const int wave = otid() >> 6, lane = otid() & 63;
  const float* P = (const float*)(p.ws + OFF_P);
  float* grec = (float*)(p.ws + OFF_GREC);
  const float* w2 = p.in[I_GW2] + (size_t)l * 2 * 16 * 192;
  const float* ab = p.in[I_GB] + l * 384;
  const int z = lane >> 5, d = lane & 31;
  float wreg[6][16], breg[6];
#pragma unroll
  for (int h = 0; h < 6; ++h) {
    breg[h] = ab[z * 192 + h * 32 + d];
#pragma unroll
    for (int r = 0; r < 16; ++r) wreg[h][r] = w2[(z * 16 + r) * 192 + h * 32 + d];
  }
  for (int tok = obid() * 8 + wave; tok < NTOK; tok += gridDim.x * 8) {
    const float* pr = P + (size_t)tok * INC;
    float lr[16];
#pragma unroll
    for (int r4 = 0; r4 < 4; ++r4) {
      float4 v = *(const float4*)(pr + 1152 + z * 16 + r4 * 4);
      lr[r4 * 4 + 0] = v.x; lr[r4 * 4 + 1] = v.y; lr[r4 * 4 + 2] = v.z; lr[r4 * 4 + 3] = v.w;
    }
    float qk[6], vv[6], gg[6];
#pragma unroll
    for (int h = 0; h < 6; ++h) {
      qk[h] = lane < 32 ? pr[h * 32 + lane] : pr[192 + h * 32 + (lane - 32)];
      vv[h] = pr[384 + h * 64 + lane];
      gg[h] = pr[768 + h * 64 + lane];
    }
#pragma unroll
    for (int h = 0; h < 6; ++h) {
      float acc = breg[h];
#pragma unroll
      for (int r = 0; r < 16; ++r) acc += lr[r] * wreg[h][r];
      float alpha = expf(logsigmoidf_(acc) * (1.f / 16.f));
      float* o = grec + ((size_t)tok * 6 + h) * 256 + lane;
      o[0] = lane < 32 ? qk[h] * 0.17677669529663687f : qk[h];
      o[64] = alpha; o[128] = vv[h]; o[192] = gg[h];
    }
  }
}

__device__ __forceinline__ void prep_hyena(const Params& p, int l) {
  const float* P = (const float*)(p.ws + OFF_P);
  float* hz = (float*)(p.ws + OFF_HYZ);
  float* hx = (float*)(p.ws + OFF_HYX);
  const float* cw = p.in[I_HCW] + l * 3 * 768;
  const float* cb = p.in[I_HCB] + l * 768;
  const int c = otid() & 255, rsub = otid() >> 8;
  float w_[3][3], b_[3];
#pragma unroll
  for (int s = 0; s < 3; ++s) { b_[s] = cb[s * 256 + c]; for (int t = 0; t < 3; ++t) w_[s][t] = cw[t * 768 + s * 256 + c]; }
  for (int r0 = obid() * 8; r0 < NTOK; r0 += gridDim.x * 8) {
    float pv[4][3][3];
    int rows[4];
#pragma unroll
    for (int q = 0; q < 4; ++q) {
      const int row = r0 + q * 2 + rsub;
      rows[q] = row;
      int t, L;
      if (row < NCTX) { t = row & 255; L = 256; } else { t = (row - NCTX) & 1023; L = 1024; }
      const float* pc = P + (size_t)row * INC + C_HY + c;
#pragma unroll
      for (int s = 0; s < 3; ++s) {
        pv[q][s][1] = pc[s * 256];
        pv[q][s][0] = t > 0 ? pc[s * 256 - INC] : 0.f;
        pv[q][s][2] = t < L - 1 ? pc[s * 256 + INC] : 0.f;
      }
    }
#pragma unroll
    for (int q = 0; q < 4; ++q) {
      float u[3];
#pragma unroll
      for (int s = 0; s < 3; ++s) u[s] = pv[q][s][0] * w_[s][0] + pv[q][s][1] * w_[s][1] + pv[q][s][2] * w_[s][2] + b_[s];
      hx[(size_t)rows[q] * 256 + c] = u[0];
      hz[(size_t)rows[q] * 256 + c] = u[1] * u[2];
      ((unsigned short*)(p.ws + OFF_HZB))[(size_t)rows[q] * 256 + c] = f2bf(u[1] * u[2]);
    }
  }
}

__device__ __forceinline__ void glds16(const void* g, void* l) {
  __builtin_amdgcn_global_load_lds((const unsigned*)g, (unsigned*)l, 16, 0, 0);
}

#define VMW(n) asm volatile("s_waitcnt vmcnt(" #n ")" ::: "memory")
#define LGKM0 __builtin_amdgcn_s_waitcnt(0xC07F)
__device__ __forceinline__ float quad_sum(float x) {
  x += __int_as_float(__builtin_amdgcn_update_dpp(0, __float_as_int(x), 0xB1, 0xF, 0xF, true));
  x += __int_as_float(__builtin_amdgcn_update_dpp(0, __float_as_int(x), 0x4E, 0xF, 0xF, true));
  return x;
}

template <int R> struct RwOps { f32x4 A[2], B[2], K[2], W[2], Rr[2]; float v[R]; };
constexpr int RW_SLOT = 1536;
__device__ __forceinline__ void rw_fill(const float* recg, char* slot, int lane, int dir) {
  glds16((const char*)recg + lane * 16, slot);
  if (lane < 32) {
    const char* g2 = (const char*)recg + (lane < 16 ? 1024 + lane * 16 : (5 + dir) * 256 + (lane - 16) * 16);
    glds16(g2, slot + 1024);
  }
}
template <int R>
__device__ __forceinline__ void rw_load(RwOps<R>& o, const char* rec, int k8, int vrow) {
  const f32x4* q = (const f32x4*)rec + k8 * 2;
#pragma unroll
  for (int i = 0; i < 2; ++i) { o.Rr[i] = q[i]; o.K[i] = q[16 + i]; o.A[i] = q[48 + i]; o.B[i] = q[64 + i]; o.W[i] = q[80 + i]; }
  if (R == 2) { f32x2 t = *(const f32x2*)((const float*)rec + 128 + vrow); o.v[0] = t.x; o.v[R - 1] = t.y; }
  else o.v[0] = ((const float*)rec)[128 + vrow];
}
template <int R>
__device__ __forceinline__ void rw_step(f32x2 (&S)[R][4], const RwOps<R>& o, float (&res)[R]) {
  const f32x2 A0 = {o.A[0][0], o.A[0][1]}, A1 = {o.A[0][2], o.A[0][3]}, A2 = {o.A[1][0], o.A[1][1]}, A3 = {o.A[1][2], o.A[1][3]};
  float sa[R];
#pragma unroll
  for (int r = 0; r < R; ++r) {
    f32x2 p0 = S[r][0] * A0, q0 = S[r][1] * A1;
    p0 += S[r][2] * A2; q0 += S[r][3] * A3;
    p0 += q0;
    sa[r] = p0.x + p0.y;
  }
#pragma unroll
  for (int r = 0; r < R; ++r) sa[r] += dpp_f(sa[r], 0);
#pragma unroll
  for (int r = 0; r < R; ++r) sa[r] += dpp_f(sa[r], 1);
#pragma unroll
  for (int r = 0; r < R; ++r) sa[r] += dpp_f(sa[r], 2);
#pragma unroll
  for (int i = 0; i < 4; ++i) {
    const f32x2 W = {o.W[i >> 1][(i & 1) * 2], o.W[i >> 1][(i & 1) * 2 + 1]};
    const f32x2 B = {o.B[i >> 1][(i & 1) * 2], o.B[i >> 1][(i & 1) * 2 + 1]};
    const f32x2 K = {o.K[i >> 1][(i & 1) * 2], o.K[i >> 1][(i & 1) * 2 + 1]};
#pragma unroll
    for (int r = 0; r < R; ++r) S[r][i] = S[r][i] * W + (f32x2{sa[r], sa[r]} * B + f32x2{o.v[r], o.v[r]} * K);
  }
  const f32x2 R0 = {o.Rr[0][0], o.Rr[0][1]}, R1 = {o.Rr[0][2], o.Rr[0][3]}, R2 = {o.Rr[1][0], o.Rr[1][1]}, R3 = {o.Rr[1][2], o.Rr[1][3]};
#pragma unroll
  for (int r = 0; r < R; ++r) {
    f32x2 u0 = S[r][0] * R0, w0 = S[r][1] * R1;
    u0 += S[r][2] * R2; w0 += S[r][3] * R3;
    u0 += w0;
    res[r] = u0.x + u0.y;
  }
#pragma unroll
  for (int r = 0; r < R; ++r) res[r] += dpp_f(res[r], 0);
#pragma unroll
  for (int r = 0; r < R; ++r) res[r] += dpp_f(res[r], 1);
#pragma unroll
  for (int r = 0; r < R; ++r) res[r] += dpp_f(res[r], 2);
}

template <int NW>
__device__ __forceinline__ void rw_poll(volatile unsigned* f, unsigned target) {
  for (unsigned sp = 0; sp < (1u << 20); ++sp) {
    unsigned m = min(min(f[0], f[1]), min(f[2], f[3]));
    if (NW == 8) m = min(m, min(min(f[4], f[5]), min(f[6], f[7])));
    if ((unsigned)__builtin_amdgcn_readfirstlane((int)m) >= target) break;
    __builtin_amdgcn_s_sleep(1);
  }
  asm volatile("" ::: "memory");
}

constexpr int RQ_STEPS = 64;
template <int NW, int R, int RING>
__device__ __forceinline__ void rwkv_scan(const Params& p, int l, int scan, int w, int rowoff, char* ring, volatile unsigned* fl) {
  constexpr int LPC = 8 / NW;
  constexpr int NCHR = RING / 8;
  static_assert(NW == 4 && (RING == 64 || RING == 32), "vmcnt immediates below are written for these cases");
  const int lane = otid() & 63;
  scan = __builtin_amdgcn_readfirstlane(scan);
  w = __builtin_amdgcn_readfirstlane(w);
  int b, hd, L, rowbase;
  const bool lat = scan < 96;
  if (lat) { b = scan / 12; hd = scan % 12; L = 1024; rowbase = NCTX + b * 1024; }
  else { int t2 = scan - 96; b = t2 / 12; hd = t2 % 12; L = 256; rowbase = b * 256; }
  const int h = hd >> 1, dir = hd & 1;
  const int k8 = lane & 7, vrow = rowoff + w * (8 * R) + (lane >> 3) * R;
  const float* rec = (const float*)(p.ws + OFF_REC);
  float* RO = (float*)(p.ws + OFF_RO) + (size_t)dir * NTOK * 384 + h * 64 + vrow + (R == 2 ? (k8 & 1) : 0);
  f32x2 S[R][4];
  if (lat) {
    const float* sb = p.in[I_SR] + ((((size_t)b * DEPTH + l) * 2 + dir) * 6 + h) * 4096 + vrow * 64 + k8 * 8;
#pragma unroll
    for (int r = 0; r < R; ++r)
#pragma unroll
      for (int i = 0; i < 2; ++i) { float4 v = *(const float4*)(sb + r * 64 + i * 4); S[r][2 * i] = f32x2{v.x, v.y}; S[r][2 * i + 1] = f32x2{v.z, v.w}; }
  } else {
#pragma unroll
    for (int r = 0; r < R; ++r)
#pragma unroll
      for (int i = 0; i < 4; ++i) S[r][i] = f32x2{0.f, 0.f};
  }
  VMW(0);
  const int NCH = L >> 3;
#define RW_REC(st) (rec + ((size_t)(rowbase + (dir ? L - 1 - (st) : (st))) * 6 + h) * 512)
#define RW_SLOTP(st) (ring + ((st) & (RING - 1)) * RW_SLOT)
#pragma unroll
  for (int c = 0; c < NCHR - 1; ++c)
#pragma unroll
    for (int t = 0; t < LPC; ++t) { const int s = 8 * c + NW * t + w; rw_fill(RW_REC(s), RW_SLOTP(s), lane, dir); }
  RwOps<R> oa{};
  float osel = 0.f;
  for (int c = 0; c < NCH; ++c) {
    if (c + NCHR - 2 <= NCH - 1) { if (RING == 64) VMW(20); else VMW(4); } else VMW(0);
    if (lane == 0) fl[w] = (unsigned)(c + 2);
    rw_poll<NW>(fl, (unsigned)(c + 2));
    if (c == 0) rw_load<R>(oa, RW_SLOTP(0), k8, vrow);
    for (int j = 0; j < 8; j += 2) {
      const int s = 8 * c + j;
      RwOps<R> ob;
      LGKM0;
      rw_load<R>(ob, RW_SLOTP(s + 1), k8, vrow);
      __builtin_amdgcn_sched_barrier(0);
      {
        float o[R];
        rw_step<R>(S, oa, o);
        if (R == 2) osel = ((s & 3) == (k8 >> 1)) ? ((k8 & 1) ? o[R - 1] : o[0]) : osel;
        else osel = ((s & 7) == k8) ? o[0] : osel;
      }
      __builtin_amdgcn_sched_barrier(0);
      LGKM0;
      rw_load<R>(oa, RW_SLOTP(s + 2), k8, vrow);
      __builtin_amdgcn_sched_barrier(0);
      {
        float o[R];
        rw_step<R>(S, ob, o);
        if (R == 2) {
          osel = (((s + 1) & 3) == (k8 >> 1)) ? ((k8 & 1) ? o[R - 1] : o[0]) : osel;
          if (((s + 1) & 3) == 3) {
            const int st = s - 2 + (k8 >> 1);
            const int n = dir ? L - 1 - st : st;
            RO[(size_t)(rowbase + n) * 384] = osel;
          }
        } else {
          osel = (((s + 1) & 7) == k8) ? o[0] : osel;
          if (((s + 1) & 7) == 7) {
            const int st = s - 6 + k8;
            const int n = dir ? L - 1 - st : st;
            RO[(size_t)(rowbase + n) * 384] = osel;
          }
        }
      }
      __builtin_amdgcn_sched_barrier(0);
    }
    asm volatile("" ::: "memory");
    if (lane == 0) fl[8 + w] = (unsigned)(c + 1);
    if (c + NCHR - 1 < NCH) {
      rw_poll<NW>(fl + 8, (unsigned)c);
#pragma unroll
      for (int t = 0; t < LPC; ++t) { const int s = 8 * (c + NCHR - 1) + NW * t + w; rw_fill(RW_REC(s), RW_SLOTP(s), lane, dir); }
    }
  }
#undef RW_REC
#undef RW_SLOTP
  if (!lat) {
    float* so = p.out + (size_t)NTOK * D + (size_t)16 * DEPTH * 2 * 6 * 2048 +
                ((((size_t)b * DEPTH + l) * 2 + dir) * 6 + h) * 4096 + vrow * 64 + k8 * 8;
#pragma unroll
    for (int r = 0; r < R; ++r)
#pragma unroll
      for (int i = 0; i < 2; ++i) *(float4*)(so + r * 64 + i * 4) = make_float4(S[r][2 * i].x, S[r][2 * i].y, S[r][2 * i + 1].x, S[r][2 * i + 1].y);
  }
  VMW(0);
}

struct RwOpsLa { f32x4 An[2], B[2], K[2], W[2], Rr[2]; float v; };
__device__ __forceinline__ void rw_load_la(RwOpsLa& o, const char* rec, const char* recn, int k8, int vrow) {
  const f32x4* q = (const f32x4*)rec + k8 * 2;
  const f32x4* qn = (const f32x4*)recn + k8 * 2;
#pragma unroll
  for (int i = 0; i < 2; ++i) { o.Rr[i] = q[i]; o.K[i] = q[16 + i]; o.B[i] = q[64 + i]; o.W[i] = q[80 + i]; o.An[i] = qn[48 + i]; }
  o.v = ((const float*)rec)[128 + vrow];
}
__device__ __forceinline__ float rw_step_la(f32x2 (&S)[4], float& sa, const RwOpsLa& o) {
  f32x2 W2[4], B2[4], K2[4], A2[4], R2[4];
#pragma unroll
  for (int i = 0; i < 4; ++i) {
    const int a = i >> 1, c = (i & 1) * 2;
    W2[i] = f32x2{o.W[a][c], o.W[a][c + 1]}; B2[i] = f32x2{o.B[a][c], o.B[a][c + 1]}; K2[i] = f32x2{o.K[a][c], o.K[a][c + 1]};
    A2[i] = f32x2{o.An[a][c], o.An[a][c + 1]}; R2[i] = f32x2{o.Rr[a][c], o.Rr[a][c + 1]};
  }
  const f32x2 vv = {o.v, o.v};
  f32x2 T[4];
#pragma unroll
  for (int i = 0; i < 4; ++i) T[i] = S[i] * W2[i] + vv * K2[i];
  f32x2 g0 = T[0] * A2[0], g1 = T[1] * A2[1];
  g0 += T[2] * A2[2]; g1 += T[3] * A2[3]; g0 += g1;
  f32x2 b0 = B2[0] * A2[0], b1 = B2[1] * A2[1];
  b0 += B2[2] * A2[2]; b1 += B2[3] * A2[3]; b0 += b1;
  float gp = g0.x + g0.y, bp = b0.x + b0.y;
  gp += dpp_f(gp, 0); bp += dpp_f(bp, 0);
  gp += dpp_f(gp, 1); bp += dpp_f(bp, 1);
  gp += dpp_f(gp, 2); bp += dpp_f(bp, 2);
  const f32x2 sav = {sa, sa};
#pragma unroll
  for (int i = 0; i < 4; ++i) S[i] = sav * B2[i] + T[i];
  f32x2 u0 = S[0] * R2[0], u1 = S[1] * R2[1];
  u0 += S[2] * R2[2]; u1 += S[3] * R2[3]; u0 += u1;
  float ov = u0.x + u0.y;
  ov += dpp_f(ov, 0); ov += dpp_f(ov, 1); ov += dpp_f(ov, 2);
  sa = sa * bp + gp;
  return ov;
}

__device__ __forceinline__ void rwkv_scan_la(const Params& p, int l, int scan, int w, int rowoff, char* ring, volatile unsigned* fl) {
  constexpr int NW = 4, R = 1, RING = 64;
  constexpr int LPC = 8 / NW;
  constexpr int NCHR = RING / 8;
  static_assert(NW == 4 && (RING == 64 || RING == 32), "vmcnt immediates below are written for these cases");
  const int lane = otid() & 63;
  scan = __builtin_amdgcn_readfirstlane(scan);
  w = __builtin_amdgcn_readfirstlane(w);
  int b, hd, L, rowbase;
  const bool lat = scan < 96;
  if (lat) { b = scan / 12; hd = scan % 12; L = 1024; rowbase = NCTX + b * 1024; }
  else { int t2 = scan - 96; b = t2 / 12; hd = t2 % 12; L = 256; rowbase = b * 256; }
  const int h = hd >> 1, dir = hd & 1;
  const int k8 = lane & 7, vrow = rowoff + w * (8 * R) + (lane >> 3) * R;
  const float* rec = (const float*)(p.ws + OFF_REC);
  float* RO = (float*)(p.ws + OFF_RO) + (size_t)dir * NTOK * 384 + h * 64 + vrow + (R == 2 ? (k8 & 1) : 0);
  f32x2 S[R][4];
  if (lat) {
    const float* sb = p.in[I_SR] + ((((size_t)b * DEPTH + l) * 2 + dir) * 6 + h) * 4096 + vrow * 64 + k8 * 8;
#pragma unroll
    for (int r = 0; r < R; ++r)
#pragma unroll
      for (int i = 0; i < 2; ++i) { float4 v = *(const float4*)(sb + r * 64 + i * 4); S[r][2 * i] = f32x2{v.x, v.y}; S[r][2 * i + 1] = f32x2{v.z, v.w}; }
  } else {
#pragma unroll
    for (int r = 0; r < R; ++r)
#pragma unroll
      for (int i = 0; i < 4; ++i) S[r][i] = f32x2{0.f, 0.f};
  }
  VMW(0);
  const int NCH = L >> 3;
#define RW_REC(st) (rec + ((size_t)(rowbase + (dir ? L - 1 - (st) : (st))) * 6 + h) * 512)
#define RW_SLOTP(st) (ring + ((st) & (RING - 1)) * RW_SLOT)
#pragma unroll
  for (int c = 0; c < NCHR - 1; ++c)
#pragma unroll
    for (int t = 0; t < LPC; ++t) { const int s = 8 * c + NW * t + w; rw_fill(RW_REC(s), RW_SLOTP(s), lane, dir); }
  RwOpsLa oa{};
  float sa = 0.f;
  float osel = 0.f;
  for (int c = 0; c < NCH; ++c) {
    if (c + NCHR - 2 <= NCH - 1) { if (RING == 64) VMW(20); else VMW(4); } else VMW(0);
    if (lane == 0) fl[w] = (unsigned)(c + 2);
    rw_poll<NW>(fl, (unsigned)(c + 2));
    if (c == 0) {
      const f32x4* q0 = (const f32x4*)RW_SLOTP(0) + k8 * 2;
      const f32x4 a0 = q0[48], a1 = q0[49];
      f32x2 d0 = S[0][0] * f32x2{a0[0], a0[1]}, d1 = S[0][1] * f32x2{a0[2], a0[3]};
      d0 += S[0][2] * f32x2{a1[0], a1[1]}; d1 += S[0][3] * f32x2{a1[2], a1[3]};
      d0 += d1;
      sa = d0.x + d0.y;
      sa += dpp_f(sa, 0); sa += dpp_f(sa, 1); sa += dpp_f(sa, 2);
      rw_load_la(oa, RW_SLOTP(0), RW_SLOTP(1), k8, vrow);
    }
    for (int j = 0; j < 8; j += 2) {
      const int s = 8 * c + j;
      RwOpsLa ob;
      LGKM0;
      rw_load_la(ob, RW_SLOTP(s + 1), RW_SLOTP(s + 2), k8, vrow);
      __builtin_amdgcn_sched_barrier(0);
      {
        float o[R];
        o[0] = rw_step_la(S[0], sa, oa);
        if (R == 2) osel = ((s & 3) == (k8 >> 1)) ? ((k8 & 1) ? o[R - 1] : o[0]) : osel;
        else osel = ((s & 7) == k8) ? o[0] : osel;
      }
      __builtin_amdgcn_sched_barrier(0);
      LGKM0;
      rw_load_la(oa, RW_SLOTP(s + 2), RW_SLOTP(s + 3), k8, vrow);
      __builtin_amdgcn_sched_barrier(0);
      {
        float o[R];
        o[0] = rw_step_la(S[0], sa, ob);
        if (R == 2) {
          osel = (((s + 1) & 3) == (k8 >> 1)) ? ((k8 & 1) ? o[R - 1] : o[0]) : osel;
          if (((s + 1) & 3) == 3) {
            const int st = s - 2 + (k8 >> 1);
            const int n = dir ? L - 1 - st : st;
            RO[(size_t)(rowbase + n) * 384] = osel;
          }
        } else {
          osel = (((s + 1) & 7) == k8) ? o[0] : osel;
          if (((s + 1) & 7) == 7) {
            const int st = s - 6 + k8;
            const int n = dir ? L - 1 - st : st;
            RO[(size_t)(rowbase + n) * 384] = osel;
          }
        }
      }
      __builtin_amdgcn_sched_barrier(0);
    }
    asm volatile("" ::: "memory");
    if (lane == 0) fl[8 + w] = (unsigned)(c + 1);
    if (c + NCHR - 1 < NCH) {
      rw_poll<NW>(fl + 8, (unsigned)c);
#pragma unroll
      for (int t = 0; t < LPC; ++t) { const int s = 8 * (c + NCHR - 1) + NW * t + w; rw_fill(RW_REC(s), RW_SLOTP(s), lane, dir); }
    }
  }
#undef RW_REC
#undef RW_SLOTP
  if (!lat) {
    float* so = p.out + (size_t)NTOK * D + (size_t)16 * DEPTH * 2 * 6 * 2048 +
                ((((size_t)b * DEPTH + l) * 2 + dir) * 6 + h) * 4096 + vrow * 64 + k8 * 8;
#pragma unroll
    for (int r = 0; r < R; ++r)
#pragma unroll
      for (int i = 0; i < 2; ++i) *(float4*)(so + r * 64 + i * 4) = make_float4(S[r][2 * i].x, S[r][2 * i].y, S[r][2 * i + 1].x, S[r][2 * i + 1].y);
  }
  VMW(0);
}

template <int NE> struct GlOps { f32x4 Q[2], K[2], A[2]; float v[NE]; };
constexpr int GL_RING = 32, GL_SLOT = 768;
template <int NE>
__device__ __forceinline__ void gl_load(GlOps<NE>& o, const char* rec, int dir, int dq, int ecol) {
  const f32x4* q = (const f32x4*)rec;
#pragma unroll
  for (int i = 0; i < 2; ++i) { o.Q[i] = q[dq * 2 + i]; o.K[i] = q[8 + dq * 2 + i]; o.A[i] = q[16 + dir * 8 + dq * 2 + i]; }
  if (NE == 4) { f32x4 t = *(const f32x4*)((const float*)rec + 128 + ecol); o.v[0] = t[0]; o.v[1] = t[1]; o.v[NE - 2] = t[2]; o.v[NE - 1] = t[3]; }
  else { f32x2 t = *(const f32x2*)((const float*)rec + 128 + ecol); o.v[0] = t.x; o.v[1] = t.y; }
}
template <int NE>
__device__ __forceinline__ float gl_step(f32x2 (&S)[8][NE / 2], const GlOps<NE>& o, int dq) {
  f32x2 vv[NE / 2], acc[NE / 2];
#pragma unroll
  for (int e = 0; e < NE / 2; ++e) { vv[e] = f32x2{o.v[2 * e], o.v[2 * e + 1]}; acc[e] = f32x2{0.f, 0.f}; }
#pragma unroll
  for (int d = 0; d < 8; ++d) {
    const float a = o.A[d >> 2][d & 3], kk = o.K[d >> 2][d & 3], qq = o.Q[d >> 2][d & 3];
    const f32x2 av = {a, a}, kv = {kk, kk}, qv = {qq, qq};
#pragma unroll
    for (int e = 0; e < NE / 2; ++e) { S[d][e] = av * S[d][e] + kv * vv[e]; acc[e] += qv * S[d][e]; }
  }
  if (NE == 4) {
    const float r0 = quad_sum(acc[0].x), r1 = quad_sum(acc[0].y), r2 = quad_sum(acc[NE / 2 - 1].x), r3 = quad_sum(acc[NE / 2 - 1].y);
    return dq == 0 ? r0 : (dq == 1 ? r1 : (dq == 2 ? r2 : r3));
  } else {
    const float r0 = quad_sum(acc[0].x), r1 = quad_sum(acc[0].y);
    return (dq & 1) ? r1 : r0;
  }
}
template <int NE>
__device__ __forceinline__ void gla_scan(const Params& p, int l, int task, int eh, char* ring  ) {
  const int lane = otid() & 63;
  task = __builtin_amdgcn_readfirstlane(task);
  int b, hd, L, rowbase;
  const bool lat = task < 96;
  if (lat) { b = task / 12; hd = task % 12; L = 1024; rowbase = NCTX + b * 1024; }
  else { int t2 = task - 96; b = t2 / 12; hd = t2 % 12; L = 256; rowbase = b * 256; }
  const int h = hd >> 1, dir = hd & 1;
  const int dq = lane & 3, eg = lane >> 2;
  const int ecol = (NE == 4) ? eg * 4 : eh * 32 + eg * 2;
  const bool owner = (NE == 4) || dq < 2;
  const float* grec = (const float*)(p.ws + OFF_GREC);
  float* GO = (float*)(p.ws + OFF_GO) + (size_t)dir * NTOK * 384 + h * 64 + ecol + (NE == 4 ? dq : (dq & 1));
  f32x2 S[8][NE / 2];
  if (lat) {
    const float* s0 = p.in[I_SG] + ((((size_t)b * DEPTH + l) * 2 + dir) * 6 + h) * 2048 + (dq * 8) * 64 + ecol;
#pragma unroll
    for (int d = 0; d < 8; ++d)
#pragma unroll
      for (int e = 0; e < NE / 2; ++e) { f32x2 v = *(const f32x2*)(s0 + d * 64 + 2 * e); S[d][e] = v; }
  } else {
#pragma unroll
    for (int d = 0; d < 8; ++d)
#pragma unroll
      for (int e = 0; e < NE / 2; ++e) S[d][e] = f32x2{0.f, 0.f};
  }
  VMW(0);
#define GL_REC(st) ((const char*)(grec + ((size_t)(rowbase + (dir ? L - 1 - (st) : (st))) * 6 + h) * 256))
#pragma unroll
  for (int s = 0; s < GL_RING; ++s) { if (lane < 48) glds16(GL_REC(s) + lane * 16, ring + s * GL_SLOT); }
  GlOps<NE> oa{};
  VMW(31);
  gl_load<NE>(oa, ring, dir, dq, ecol);
  for (int s = 0; s < L; s += 2) {
    GlOps<NE> ob;
    LGKM0; if (s + GL_RING >= L) VMW(0); else VMW(30);
    gl_load<NE>(ob, ring + ((s + 1) & (GL_RING - 1)) * GL_SLOT, dir, dq, ecol);
    __builtin_amdgcn_sched_barrier(0);
    {
      float o = gl_step<NE>(S, oa, dq);
      const int n = dir ? L - 1 - s : s;
      if (owner) GO[(size_t)(rowbase + n) * 384] = o;
    }
    asm volatile("" ::: "memory");
    if (s + GL_RING < L && lane < 48) glds16(GL_REC(s + GL_RING) + lane * 16, ring + (s & (GL_RING - 1)) * GL_SLOT);
    __builtin_amdgcn_sched_barrier(0);
    LGKM0; if (s + 1 + GL_RING >= L) VMW(0); else VMW(30);
    gl_load<NE>(oa, ring + ((s + 2) & (GL_RING - 1)) * GL_SLOT, dir, dq, ecol);
    __builtin_amdgcn_sched_barrier(0);
    {
      float o = gl_step<NE>(S, ob, dq);
      const int n = dir ? L - 2 - s : s + 1;
      if (owner) GO[(size_t)(rowbase + n) * 384] = o;
    }
    asm volatile("" ::: "memory");
    if (s + 1 + GL_RING < L && lane < 48) glds16(GL_REC(s + 1 + GL_RING) + lane * 16, ring + ((s + 1) & (GL_RING - 1)) * GL_SLOT);
    __builtin_amdgcn_sched_barrier(0);
  }
#undef GL_REC
  if (!lat) {
    float* so = p.out + (size_t)NTOK * D + ((((size_t)b * DEPTH + l) * 2 + dir) * 6 + h) * 2048 + (dq * 8) * 64 + ecol;
#pragma unroll
    for (int d = 0; d < 8; ++d)
#pragma unroll
      for (int e = 0; e < NE / 2; ++e) *(f32x2*)(so + d * 64 + 2 * e) = S[d][e];
  }
  VMW(0);
}

constexpr int HY_TASKS = 768;
__device__ __forceinline__ void hyena_task(const Params& p, int l, int task) {
  const int lane = otid() & 63;
  int b, cgp, tb, L, rowbase;
  const float* ft = (const float*)(p.ws + OFF_FT) + (size_t)l * FT_LAYER;
  if (task < 512) { b = task >> 6; cgp = (task >> 5) & 1; tb = task & 31; L = 1024; rowbase = NCTX + b * 1024; ft += FT_L0; }
  else { int t2 = task - 512; b = t2 >> 4; cgp = (t2 >> 3) & 1; tb = t2 & 7; L = 256; rowbase = b * 256; }
  const int c = cgp * 128 + lane * 2;
  const int t0 = tb * 32;
  const float* hz = (const float*)(p.ws + OFF_HYZ) + (size_t)rowbase * 256 + c;
  const float* hx = (const float*)(p.ws + OFF_HYX) + (size_t)rowbase * 256 + c;
  const float* fc = ft + c;
  const unsigned short* hzb = (const unsigned short*)(p.ws + OFF_HZB) + (size_t)rowbase * 256 + c;
  const unsigned short* fcb = (const unsigned short*)(p.ws + OFF_FTB) + (size_t)(ft - (const float*)(p.ws + OFF_FT)) + c;
  f32x2 acc[32];
#pragma unroll
  for (int i = 0; i < 32; ++i) acc[i] = f32x2{0.f, 0.f};
  for (int s0 = 0; s0 < L; s0 += 16) {
    f32x2 z[16], f[47];
#pragma unroll
    for (int j = 0; j < 16; ++j) { const unsigned u = *(const unsigned*)(hzb + (size_t)(s0 + j) * 256); z[j] = f32x2{__uint_as_float(u << 16), __uint_as_float(u & 0xffff0000u)}; }
    const unsigned short* fb = fcb + (size_t)(t0 - s0 - 15 + L - 1) * 256;
#pragma unroll
    for (int m = 0; m < 47; ++m) { const unsigned u = *(const unsigned*)(fb + (size_t)m * 256); f[m] = f32x2{__uint_as_float(u << 16), __uint_as_float(u & 0xffff0000u)}; }
#pragma unroll
    for (int i = 0; i < 32; ++i)
#pragma unroll
      for (int j = 0; j < 16; ++j) acc[i] += f[i - j + 15] * z[j];
  }
  const f32x2 bias = *(const f32x2*)(p.in[I_HBIAS] + l * 256 + c);
  unsigned* O = (unsigned*)(p.ws + OFF_H);
#pragma unroll
  for (int i = 0; i < 32; ++i) {
    int t = t0 + i;
    f32x2 zz = *(const f32x2*)(hz + (size_t)t * 256), xx = *(const f32x2*)(hx + (size_t)t * 256);
    f32x2 y = xx * (acc[i] + zz * bias);
    O[((size_t)(rowbase + t) * D + 384 + c) >> 1] = (unsigned)f2bf(y.x) | ((unsigned)f2bf(y.y) << 16);
  }
}

constexpr int LDS_GLA = 98304, LDS_FLAGS = 147456, LDS_XB = 147584;
__device__ __forceinline__ void phase_mixers(const Params& p, int l, int cidx) {
  const int wave = otid() >> 6, lane = otid() & 63;
  const int bid = obid();
  volatile unsigned* fl = (volatile unsigned*)(smem + LDS_FLAGS);
  if (otid() < 32) fl[otid()] = 0u;
  __syncthreads();
  __builtin_amdgcn_s_setprio(3);
  if (bid < 192) {
    if (wave < 4) rwkv_scan_la(p, l, bid >> 1, wave, (bid & 1) * 32, smem, fl);
    else rwkv_scan<4, 2, 32>(p, l, 96 + bid, wave - 4, 0, smem + 98304, fl + 16);
  } else if (wave < 3) {
    const int g = (bid - 192) * 3 + wave;
    gla_scan<2>(p, l, g >> 1, g & 1, smem + wave * 24576);
  } else if (wave < 6) {
    gla_scan<4>(p, l, 96 + (bid - 192) * 3 + (wave - 3), 0, smem + wave * 24576);
  }
  __builtin_amdgcn_s_setprio(0);
  int* cnt = (int*)(p.ws + OFF_CNT) + cidx;
  const int ntask = HY_TASKS + (l < DEPTH - 1 ? 5312 : 0);
  while (true) {
    int t = 0;
    if (lane == 0) t = atomicAdd(cnt, 1);
    t = __shfl(t, 0);
    if (t >= ntask) break;
    if (t < HY_TASKS) hyena_task(p, l, t);
    else wconv_wave(p, l + 1, (l + 1) & 1, t - HY_TASKS);
  }
}

__device__ __forceinline__ void phase_post(const Params& p, int l) {
  const int wave = otid() >> 6, lane = otid() & 63;
  const float* GO = (const float*)(p.ws + OFF_GO);
  const float* RO = (const float*)(p.ws + OFF_RO);
  const float* grec = (const float*)(p.ws + OFF_GREC);
  const float* rec = (const float*)(p.ws + OFF_REC);
  unsigned short* O = (unsigned short*)(p.ws + OFF_H);
  const float gn = p.in[I_GN][l * 64 + lane];
  for (int R = obid() * 8 + wave; R < NTOK; R += gridDim.x * 8) {
    const int tokr = scan2tok(R);
#pragma unroll
    for (int h = 0; h < 6; ++h) {
      float o = GO[(size_t)R * 384 + h * 64 + lane] + GO[(size_t)(NTOK + R) * 384 + h * 64 + lane];
      float ms = wave_sum(o * o) * (1.f / 64.f);
      float y = o * rsqrtf(ms + 1e-6f) * gn;
      float g = grec[((size_t)R * 6 + h) * 256 + 192 + lane];
      O[(size_t)R * D + h * 64 + lane] = f2bf(y * siluf_(g));
    }
#pragma unroll
    for (int h = 0; h < 6; ++h) {
      const int c = h * 64 + lane;
      float o = RO[(size_t)R * 384 + c] + RO[(size_t)(NTOK + R) * 384 + c];
      float mean = wave_sum(o) * (1.f / 64.f);
      float dlt = o - mean;
      float var = wave_sum(dlt * dlt) * (1.f / 64.f);
      float y = dlt * rsqrtf(var + 64e-5f) * p.in[I_RLW][l * 384 + c] + p.in[I_RLB][l * 384 + c];
      const float* rr = rec + ((size_t)R * 6 + h) * 512 + lane;
      float r = rr[0], k2 = rr[64], v = rr[128], g = rr[448];
      float bonus = wave_sum(r * k2 * p.in[I_RRK][l * 384 + c]) * v;
      O[(size_t)tokr * D + 640 + c] = f2bf((y + bonus) * g);
    }
  }
}

#define XB_TMO      128
#define XB_XCNT(j)  (256  + 64 * (j))
#define XB_XSUB(j)  (1280 + 64 * (j))
#define XB_XGEN(j)  (2304 + 64 * (j))
#define XB_TOP      3328
#define XB_TOPGEN   3392
#define XCD_BAR_WORDS 3456
#define XB_SPIN_CAP (1u << 18)
#define LAS __attribute__((address_space(3)))

__device__ __forceinline__ unsigned xb_ld(unsigned* p)              { return __hip_atomic_load(p, __ATOMIC_RELAXED, __HIP_MEMORY_SCOPE_AGENT); }
__device__ __forceinline__ unsigned xb_add(unsigned* p, unsigned v) { return __hip_atomic_fetch_add(p, v, __ATOMIC_RELAXED, __HIP_MEMORY_SCOPE_AGENT); }
__device__ __forceinline__ unsigned xb_xcc_id() { return (unsigned)__builtin_amdgcn_s_getreg((3 << 11) | 20) & 0xFu; }
#define XB_SPIN(cond, bar) do { unsigned _sp = 0; while (cond) { __builtin_amdgcn_s_sleep(1); \
    if ((++_sp & 255u) == 0u) { if (xb_ld(&(bar)[XB_TMO])) break; if (_sp > XB_SPIN_CAP) { atomicAdd(&(bar)[XB_TMO], 1u); break; } } } } while (0)

struct XcdBarrier {
    unsigned* bar; unsigned x;
    volatile LAS unsigned* st;
};

__device__ __forceinline__ XcdBarrier xcd_barrier_post(unsigned* bar, volatile LAS unsigned* st) {
    XcdBarrier b; b.bar = bar; b.x = xb_xcc_id(); b.st = st;
    if (threadIdx.x == 0) (void)xb_add(&bar[XB_XCNT(b.x)], 1u);
    return b;
}
__device__ __forceinline__ void xcd_barrier_complete(unsigned* bar, unsigned x, unsigned& nloc, unsigned& nx) {
    const unsigned G = gridDim.x * gridDim.y * gridDim.z;
    unsigned sum, cnt, mine, sp = 0u;
    for (;;) {
        sum = 0u; cnt = 0u; mine = 0u;
#pragma unroll
        for (unsigned j = 0; j < 16; ++j) { const unsigned c = xb_ld(&bar[XB_XCNT(j)]); sum += c; cnt += (c > 0u) ? 1u : 0u; mine = (j == x) ? c : mine; }
        if (sum == G) break;
        __builtin_amdgcn_s_sleep(1);
        if ((++sp & 255u) == 0u) { if (xb_ld(&bar[XB_TMO])) break; if (sp > XB_SPIN_CAP) { atomicAdd(&bar[XB_TMO], 1u); break; } }
    }
    nloc = mine > 0u ? mine : 1u; nx = cnt > 0u ? cnt : 1u;
}

__device__ __forceinline__ void xcd_barrier(const XcdBarrier& b) {
    asm volatile("s_waitcnt vmcnt(0)" ::: "memory");
    __syncthreads();
    if (threadIdx.x == 0) {
        unsigned* bar = b.bar;
        __builtin_amdgcn_s_waitcnt(0);
        unsigned nloc = b.st[0], nx = b.st[1];
        if (nloc == 0u) { xcd_barrier_complete(bar, b.x, nloc, nx); b.st[0] = nloc; b.st[1] = nx; }
        const unsigned old = xb_add(&bar[XB_XSUB(b.x)], 1u);
        const unsigned gen = old / nloc;
        if (old + 1u == (gen + 1u) * nloc) {
            __builtin_amdgcn_fence(__ATOMIC_RELEASE, "agent");
            asm volatile("s_waitcnt vmcnt(0)" ::: "memory");
            const unsigned og = xb_add(&bar[XB_TOP], 1u);
            const unsigned tg = og / nx;
            if (og + 1u == (tg + 1u) * nx) xb_add(&bar[XB_TOPGEN], 1u);
            else XB_SPIN(xb_ld(&bar[XB_TOPGEN]) == tg, bar);
            __builtin_amdgcn_fence(__ATOMIC_ACQUIRE, "agent");
            xb_add(&bar[XB_XGEN(b.x)], 1u);
            asm volatile("s_waitcnt vmcnt(0)" ::: "memory");
        } else {
            XB_SPIN(xb_ld(&bar[XB_XGEN(b.x)]) == gen, bar);
            __builtin_amdgcn_fence(__ATOMIC_ACQUIRE, "agent");
            asm volatile("s_waitcnt vmcnt(0)" ::: "memory");
        }
    }
    __syncthreads();
}

__global__ void __launch_bounds__(NTHR) fwd_megakernel(Params p) {
  cg::grid_group grid = cg::this_grid();
  if (threadIdx.x == 0) *(uint4*)(smem + 147584) = make_uint4(0u, 0u, 0u, 0u);
  __syncthreads();
  XcdBarrier xb = xcd_barrier_post((unsigned*)(p.ws + OFF_BAR), (volatile LAS unsigned*)(smem + 147584));
  if (obid() == 0 && otid() < 64) ((int*)(p.ws + OFF_CNT))[otid()] = 0;
  p0_copy_x(p);
  p0_filters(p);
  p0_mod(p);
  __syncthreads();
  phase_wconv(p, 0, 0);
  bf16* hbuf = (bf16*)(p.ws + OFF_H);
  bf16* hmid = (bf16*)(p.ws + OFF_HMID);
  float* xw = (float*)(p.ws + OFF_X);
  float* Pw = (float*)(p.ws + OFF_P);
  for (int l = 0; l < DEPTH; ++l) {
    const float* modl = (const float*)(p.ws + OFF_MOD) + (size_t)l * 9 * 9216;
    const size_t wset = (size_t)(l & 1) * WSET;
    if (l == 0) grid.sync();
    phase_norm(p, p.in[I_F1N] + l * D, modl, 0, 1);
    xcd_barrier(xb);
    phase_gemm(hbuf, p.ws + OFF_W1I + wset, 5632, 1024, EpiSwiglu{(unsigned short*)hmid});
    xcd_barrier(xb);
    phase_gemm(hmid, p.ws + OFF_W1O + wset, 1024, 2816, EpiResid{xw, modl, 2, 0.5f});
    xcd_barrier(xb);
    phase_norm(p, p.in[I_MN] + l * D, modl, 3, 4);
    xcd_barrier(xb);
    phase_gemm(hbuf, p.ws + OFF_WMI + wset, INCP, 1024, EpiP{Pw});
    xcd_barrier(xb);
    prep_rwkv(p, l);
    prep_gla(p, l);
    prep_hyena(p, l);
    xcd_barrier(xb);
    phase_mixers(p, l, l);
    xcd_barrier(xb);
    phase_post(p, l);
    xcd_barrier(xb);
    phase_gemm(hbuf, p.ws + OFF_WMO + wset, 1024, 1024, EpiResid{xw, modl, 5, 1.0f});
    xcd_barrier(xb);
    phase_norm(p, p.in[I_F2N] + l * D, modl, 6, 7);
    xcd_barrier(xb);
    phase_gemm(hbuf, p.ws + OFF_W2I + wset, 5632, 1024, EpiSwiglu{(unsigned short*)hmid});
    xcd_barrier(xb);
    phase_gemm(hmid, p.ws + OFF_W2O + wset, 1024, 2816, EpiResid{xw, modl, 8, 0.5f});
    xcd_barrier(xb);
  }
  phase_final_norm(p);
}

extern "C" void kernel_launch(void* const* d_in, const int* in_sizes, int n_in, void* d_out, int out_size, void* d_ws,
                              size_t ws_size, hipStream_t stream) {
  static int grid_blocks = 0;
  if (!grid_blocks) {
    int dev = 0, cus = 0, per_cu = 0;
    (void)hipGetDevice(&dev);
    (void)hipDeviceGetAttribute(&cus, hipDeviceAttributeMultiprocessorCount, dev);
    (void)hipFuncSetAttribute((const void*)fwd_megakernel, hipFuncAttributeMaxDynamicSharedMemorySize, LDS_BYTES);
    (void)hipOccupancyMaxActiveBlocksPerMultiprocessor(&per_cu, fwd_megakernel, NTHR, LDS_BYTES);
    if (per_cu < 1) per_cu = 1;
    grid_blocks = cus * per_cu;
    if (grid_blocks > 256) grid_blocks = 256;
  }
  if (ws_size < WS_NEED) fprintf(stderr, "workspace too small: %zu < %zu\n", ws_size, (size_t)WS_NEED);
  (void)hipMemsetAsync((char*)d_ws + OFF_BAR, 0, 16384, stream);
  Params p{};
  for (int i = 0; i < 41; ++i) p.in[i] = (const float*)d_in[i];
  p.out = (float*)d_out;
  p.ws = (char*)d_ws;
  void* args[] = {&p};
  hipError_t e = hipLaunchCooperativeKernel((void*)fwd_megakernel, dim3(grid_blocks), dim3(NTHR), args, LDS_BYTES, stream);
  if (e != hipSuccess) fprintf(stderr, "cooperative launch failed: %s (grid %d)\n", hipGetErrorString(e), grid_blocks);
}
```

```cpp
#include <hip/hip_runtime.h>
#include <hip/hip_bf16.h>
#include <hip/hip_cooperative_groups.h>
#include <cstdio>
namespace cg = cooperative_groups;

typedef __hip_bfloat16 bf16;
typedef __attribute__((ext_vector_type(8))) short bf16x8;
typedef __attribute__((ext_vector_type(4))) float f32x4;
typedef __attribute__((ext_vector_type(2))) float f32x2;

constexpr int D = 1024, NTOK = 12288, NCTX = 4096, DEPTH = 4, FH = 2816;
constexpr int INC = 3264, INCP = 3328;
constexpr int C_HY = 1184, C_RW = 1952;
constexpr int NTHR = 512;

constexpr size_t al256(size_t x) { return (x + 255) & ~(size_t)255; }
constexpr size_t OFF_CNT = 0;
constexpr size_t OFF_BAR = 4096;
constexpr size_t OFF_MOD = 4096 + 16384;
constexpr size_t SZ_MOD = (size_t)DEPTH * 9 * 9216 * 4;
constexpr size_t OFF_FT = al256(OFF_MOD + SZ_MOD);
constexpr size_t FT_L0 = 511 * 256, FT_L1 = 2047 * 256;
constexpr size_t FT_LAYER = FT_L0 + FT_L1;
constexpr size_t OFF_X = al256(OFF_FT + DEPTH * FT_LAYER * 4);
constexpr size_t OFF_H = al256(OFF_X + (size_t)NTOK * D * 4);
constexpr size_t OFF_W1I = al256(OFF_H + (size_t)NTOK * D * 2);
constexpr size_t OFF_W1O = al256(OFF_W1I + (size_t)5632 * 1024 * 2);
constexpr size_t OFF_WMI = al256(OFF_W1O + (size_t)1024 * 2816 * 2);
constexpr size_t OFF_WMO = al256(OFF_WMI + (size_t)INCP * 1024 * 2);
constexpr size_t OFF_W2I = al256(OFF_WMO + (size_t)1024 * 1024 * 2);
constexpr size_t OFF_W2O = al256(OFF_W2I + (size_t)5632 * 1024 * 2);
constexpr size_t WSET = al256(OFF_W2O + (size_t)1024 * 2816 * 2) - OFF_W1I;
constexpr size_t OFF_P = OFF_W1I + 2 * WSET;
constexpr size_t SZ_P = (size_t)NTOK * INC * 4;
constexpr size_t SZ_GO = (size_t)2 * NTOK * 384 * 4;
constexpr size_t OFF_GO = OFF_P;
constexpr size_t OFF_RO = OFF_P + SZ_GO;
constexpr size_t OFF_REC = al256(OFF_P + SZ_P);
constexpr size_t SZ_REC = (size_t)NTOK * 6 * 512 * 4;
constexpr size_t OFF_HMID = OFF_REC;
constexpr size_t OFF_GREC = al256(OFF_REC + SZ_REC);
constexpr size_t SZ_GREC = (size_t)NTOK * 6 * 256 * 4;
constexpr size_t OFF_HYZ = al256(OFF_GREC + SZ_GREC);
constexpr size_t OFF_HYX = al256(OFF_HYZ + (size_t)NTOK * 256 * 4);
constexpr size_t OFF_HZB = al256(OFF_HYX + (size_t)NTOK * 256 * 4);
constexpr size_t OFF_FTB = al256(OFF_HZB + (size_t)NTOK * 256 * 2);
constexpr size_t WS_NEED = al256(OFF_FTB + DEPTH * FT_LAYER * 2);

struct Params {
  const float* in[41];
  float* out;
  char* ws;
};

enum { I_XP = 0, I_XS, I_SG, I_SR, I_C, I_CCTX, I_ADAW, I_ADAB, I_F1N, I_F1WI, I_F1WO, I_MN, I_MWI, I_MWO,
       I_GW2, I_GB, I_GN, I_HCW, I_HCB, I_HW1, I_HB1, I_HW2, I_HB2, I_HFQ, I_HW3, I_HBIAS,
       I_RMU, I_RW0, I_RW2, I_RA0, I_RA2, I_RG2, I_RKK, I_RKA, I_RRK, I_RLW, I_RLB, I_F2N, I_F2WI, I_F2WO, I_FN };

extern __shared__ __attribute__((aligned(16))) char smem[];
constexpr int LDS_BYTES = 147600;

__device__ __forceinline__ int otid() { int t = (int)__builtin_amdgcn_workitem_id_x(); asm volatile("" : "+v"(t)); return t; }
__device__ __forceinline__ int obid() { int b = (int)__builtin_amdgcn_workgroup_id_x(); asm volatile("" : "+s"(b)); return b; }
__device__ __forceinline__ unsigned short f2bf(float f) {
  unsigned u = __float_as_uint(f);
  u += 0x7fffu + ((u >> 16) & 1u);
  return (unsigned short)(u >> 16);
}
__device__ __forceinline__ float dpp_f(float x, const int ctrl_sel) {
  int xi = __float_as_int(x), r;
  if (ctrl_sel == 0) r = __builtin_amdgcn_update_dpp(0, xi, 0xB1, 0xF, 0xF, true);
  else if (ctrl_sel == 1) r = __builtin_amdgcn_update_dpp(0, xi, 0x4E, 0xF, 0xF, true);
  else if (ctrl_sel == 2) r = __builtin_amdgcn_update_dpp(0, xi, 0x141, 0xF, 0xF, true);
  else r = __builtin_amdgcn_update_dpp(0, xi, 0x140, 0xF, 0xF, true);
  return __int_as_float(r);
}
__device__ __forceinline__ float wave_sum(float v) {
  v += dpp_f(v, 0); v += dpp_f(v, 1); v += dpp_f(v, 2); v += dpp_f(v, 3);
  const int vi = __float_as_int(v);
  return __int_as_float(__builtin_amdgcn_readlane(vi, 0)) + __int_as_float(__builtin_amdgcn_readlane(vi, 16)) +
         __int_as_float(__builtin_amdgcn_readlane(vi, 32)) + __int_as_float(__builtin_amdgcn_readlane(vi, 48));
}
__device__ __forceinline__ float sigmoidf_(float x) { return __builtin_amdgcn_rcpf(1.f + __builtin_amdgcn_exp2f(x * -1.4426950408889634f)); }
__device__ __forceinline__ float siluf_(float x) { return x * sigmoidf_(x); }
__device__ __forceinline__ int modrow(int row) { return row < NCTX ? 0 : 1 + ((row - NCTX) >> 10); }

__device__ __forceinline__ void p0_copy_x(const Params& p) {
  float4* x = (float4*)(p.ws + OFF_X);
  const float4* a = (const float4*)p.in[I_XP];
  const float4* b = (const float4*)p.in[I_XS];
  const size_t n4 = (size_t)NTOK * D / 4, nc4 = (size_t)NCTX * D / 4;
  for (size_t i = (size_t)obid() * NTHR + otid(); i < n4; i += (size_t)gridDim.x * NTHR)
    x[i] = i < nc4 ? a[i] : b[i - nc4];
}

__device__ __forceinline__ void p0_mod(const Params& p) {
  float* scond = (float*)smem;
  float* red = (float*)(smem + 40960);
  for (int i = otid(); i < 9 * 1024; i += NTHR) {
    int r = i >> 10, d = i & 1023;
    float c = r == 0 ? p.in[I_CCTX][d] : p.in[I_C][(r - 1) * 1024 + d];
    scond[i] = siluf_(c);
  }
  __syncthreads();
  float* mod = (float*)(p.ws + OFF_MOD);
  const int col = otid() & 63, ks = otid() >> 6;
  for (int task = obid(); task < DEPTH * 144; task += gridDim.x) {
    int l = task / 144, cg_ = task % 144;
    const float* w = p.in[I_ADAW] + (size_t)l * 1024 * 9216 + cg_ * 64 + col;
    float acc[9];
#pragma unroll
    for (int r = 0; r < 9; ++r) acc[r] = 0.f;
    for (int d0 = ks * 128; d0 < ks * 128 + 128; d0 += 8) {
      float wv[8];
#pragma unroll
      for (int u = 0; u < 8; ++u) wv[u] = w[(size_t)(d0 + u) * 9216];
#pragma unroll
      for (int u = 0; u < 8; ++u)
#pragma unroll
        for (int r = 0; r < 9; ++r) acc[r] += scond[r * 1024 + d0 + u] * wv[u];
    }
#pragma unroll
    for (int r = 0; r < 9; ++r) red[(ks * 9 + r) * 64 + col] = acc[r];
    __syncthreads();
    for (int i = otid(); i < 576; i += NTHR) {
      int r = i >> 6, c = i & 63;
      float s = 0.f;
#pragma unroll
      for (int k = 0; k < 8; ++k) s += red[(k * 9 + r) * 64 + c];
      int j = cg_ * 64 + c;
      mod[((size_t)l * 9 + r) * 9216 + j] = s + p.in[I_ADAB][l * 9216 + j];
    }
    __syncthreads();
  }
}

__device__ __forceinline__ void p0_filters(const Params& p) {
  const int wave = otid() >> 6, lane = otid() & 63;
  float* FT = (float*)(p.ws + OFF_FT);
  for (int task = obid() * 8 + wave; task < DEPTH * 1280; task += gridDim.x * 8) {
    int l = task / 1280, rem = task % 1280;
    int sel = rem >= 256, i = sel ? rem - 256 : rem, L = sel ? 1024 : 256;
    float t = (float)i / (float)(L - 1);
    float w = 6.283185307179586f * (float)i / (float)L;
    float zval = 0.f;
    {
      const float fstep = (15.f - 1e-4f) / 15.f;
      if (lane == 0) zval = t;
      else if (lane <= 16) zval = cosf((1e-4f + (float)(lane - 1) * fstep) * w);
      else if (lane <= 32) zval = -sinf((1e-4f + (float)(lane - 17) * fstep) * w);
    }
    const float* w1 = p.in[I_HW1] + l * 33 * 64;
    const float* w2 = p.in[I_HW2] + l * 64 * 64;
    const float* w3 = p.in[I_HW3] + l * 64 * 512;
    const float* fq = p.in[I_HFQ] + l * 128;
    float h1 = p.in[I_HB1][l * 64 + lane];
    for (int e = 0; e < 33; ++e) h1 += __shfl(zval, e) * w1[e * 64 + lane];
    h1 = sinf(fq[lane] * h1);
    float h2 = p.in[I_HB2][l * 64 + lane];
    for (int e = 0; e < 64; ++e) h2 += __shfl(h1, e) * w2[e * 64 + lane];
    h2 = sinf(fq[64 + lane] * h2);
    float acc[8];
#pragma unroll
    for (int m = 0; m < 8; ++m) acc[m] = 0.f;
    for (int e = 0; e < 64; ++e) {
      float hv = __shfl(h2, e);
#pragma unroll
      for (int m = 0; m < 8; ++m) acc[m] += hv * w3[e * 512 + m * 64 + lane];
    }
    float* ft = FT + (size_t)l * FT_LAYER + (sel ? FT_L0 : 0);
    const float a0 = -3.0701134573253945f, a1 = -15.350567286626973f;
#pragma unroll
    for (int m = 0; m < 8; ++m) {
      int cp = m * 64 + lane, c = cp & 255;
      float delta = fabsf(a0 + (float)c * ((a1 - a0) / 255.f));
      float val = acc[m] * expf(-t * delta);
      unsigned short* ftb = (unsigned short*)(p.ws + OFF_FTB) + (size_t)l * FT_LAYER + (sel ? FT_L0 : 0);
      if (cp < 256) { ft[(size_t)(L - 1 + i) * 256 + c] = val; ftb[(size_t)(L - 1 + i) * 256 + c] = f2bf(val); }
      else if (i >= 1) { ft[(size_t)(L - 1 - i) * 256 + c] = val; ftb[(size_t)(L - 1 - i) * 256 + c] = f2bf(val); }
    }
  }
}

__device__ __forceinline__ void conv_tile(const float* src, int srcN, int k0, int srccol0, bool zero, bf16* dst, int dstK, int n0) {
  float* tile = (float*)smem;
  const int tid = otid();
  {
    int r = tid >> 4, c4 = (tid & 15) * 4;
#pragma unroll
    for (int rr = 0; rr < 2; ++rr) {
      int row = r + rr * 32;
      float4 v = zero ? make_float4(0.f, 0.f, 0.f, 0.f)
                      : *(const float4*)(src + (size_t)(k0 + row) * srcN + srccol0 + c4);
      tile[row * 65 + c4 + 0] = v.x; tile[row * 65 + c4 + 1] = v.y;
      tile[row * 65 + c4 + 2] = v.z; tile[row * 65 + c4 + 3] = v.w;
    }
  }
  __syncthreads();
  {
    int nn = tid >> 3, ks = (tid & 7) * 8;
    unsigned short v[8];
#pragma unroll
    for (int j = 0; j < 8; ++j) v[j] = f2bf(tile[(ks + j) * 65 + nn]);
    uint4 o;
    o.x = v[0] | ((unsigned)v[1] << 16); o.y = v[2] | ((unsigned)v[3] << 16);
    o.z = v[4] | ((unsigned)v[5] << 16); o.w = v[6] | ((unsigned)v[7] << 16);
    *(uint4*)(dst + (size_t)(n0 + nn) * dstK + k0 + ks) = o;
  }
  __syncthreads();
}

__device__ __forceinline__ unsigned cvt_pk_bf16_(float lo, float hi) { unsigned r; asm volatile("v_cvt_pk_bf16_f32 %0, %1, %2" : "=v"(r) : "v"(lo), "v"(hi)); return r; }
struct WTile { const float* src; int srcN, k0, srccol, dstK, n0; bool zero; size_t dstoff; };
__device__ __forceinline__ WTile wtile_decode(const Params& p, int l, int u) {
  WTile w;
  w.zero = false;
  if (u < 1408 || (u >= 3200 && u < 4608)) {
    const bool second = u >= 3200;
    if (second) u -= 3200;
    w.src = p.in[second ? I_F2WI : I_F1WI] + (size_t)l * 1024 * 5632;
    w.dstoff = second ? OFF_W2I : OFF_W1I;
    const int tn = u % 88, tk = u / 88;
    const int n0 = tn * 64, pn = n0 >> 8, within = n0 & 255;
    w.srccol = within < 128 ? pn * 128 + within : 2816 + pn * 128 + (within - 128);
    w.srcN = 5632; w.k0 = tk * 64; w.dstK = 1024; w.n0 = n0;
  } else if ((u >= 1408 && u < 2112) || u >= 4608) {
    const bool second = u >= 4608;
    u -= second ? 4608 : 1408;
    w.src = p.in[second ? I_F2WO : I_F1WO] + (size_t)l * 2816 * 1024;
    w.dstoff = second ? OFF_W2O : OFF_W1O;
    const int tn = u % 16, tk = u / 16;
    w.srcN = 1024; w.k0 = tk * 64; w.srccol = tn * 64; w.dstK = 2816; w.n0 = tn * 64;
  } else if (u < 2944) {
    u -= 2112;
    w.src = p.in[I_MWI] + (size_t)l * 1024 * INC;
    w.dstoff = OFF_WMI;
    const int tn = u % 52, tk = u / 52;
    w.srcN = INC; w.k0 = tk * 64; w.srccol = tn * 64; w.dstK = 1024; w.n0 = tn * 64; w.zero = tn == 51;
  } else {
    u -= 2944;
    w.src = p.in[I_MWO] + (size_t)l * 1024 * 1024;
    w.dstoff = OFF_WMO;
    const int tn = u % 16, tk = u / 16;
    w.srcN = 1024; w.k0 = tk * 64; w.srccol = tn * 64; w.dstK = 1024; w.n0 = tn * 64;
  }
  return w;
}
__device__ __forceinline__ void phase_wconv(const Params& p, int l, int set) {
  for (int t = obid(); t < 5312; t += gridDim.x) {
    const WTile w = wtile_decode(p, l, t);
    conv_tile(w.src, w.srcN, w.k0, w.srccol, w.zero, (bf16*)(p.ws + w.dstoff + (size_t)set * WSET), w.dstK, w.n0);
  }
}
__device__ __forceinline__ void wconv_wave(const Params& p, int l, int set, int u) {
  const int lane = otid() & 63;
  const WTile w = wtile_decode(p, l, u);
  unsigned pk[32];
  if (!w.zero) {
    const float* s = w.src + (size_t)w.k0 * w.srcN + w.srccol + lane;
#pragma unroll
    for (int kk = 0; kk < 64; kk += 2) pk[kk >> 1] = cvt_pk_bf16_(s[(size_t)kk * w.srcN], s[(size_t)(kk + 1) * w.srcN]);
  } else {
#pragma unroll
    for (int i = 0; i < 32; ++i) pk[i] = 0u;
  }
  uint4* d = (uint4*)((unsigned short*)(p.ws + w.dstoff + (size_t)set * WSET) + (size_t)(w.n0 + lane) * w.dstK + w.k0);
#pragma unroll
  for (int i = 0; i < 8; ++i) d[i] = make_uint4(pk[4 * i], pk[4 * i + 1], pk[4 * i + 2], pk[4 * i + 3]);
}

__device__ __forceinline__ void phase_norm(const Params& p, const float* gain, const float* modl, int shi, int sci) {
  const int wave = otid() >> 6, lane = otid() & 63;
  const float* x = (const float*)(p.ws + OFF_X);
  bf16* h = (bf16*)(p.ws + OFF_H);
  for (int row = obid() * 8 + wave; row < NTOK; row += gridDim.x * 8) {
    const float4* xr = (const float4*)(x + (size_t)row * D);
    float4 v[4];
    float ss = 0.f;
#pragma unroll
    for (int i = 0; i < 4; ++i) {
      v[i] = xr[i * 64 + lane];
      ss += v[i].x * v[i].x + v[i].y * v[i].y + v[i].z * v[i].z + v[i].w * v[i].w;
    }
    ss = wave_sum(ss);
    float rstd = rsqrtf(ss * (1.f / 1024.f) + 1e-6f);
    const float* mr = modl + (size_t)modrow(row) * 9216;
    const float4* sc = (const float4*)(mr + sci * 1024);
    const float4* sh = (const float4*)(mr + shi * 1024);
    const float4* g4 = (const float4*)gain;
#pragma unroll
    for (int i = 0; i < 4; ++i) {
      float4 g = g4[i * 64 + lane], s = sc[i * 64 + lane], b = sh[i * 64 + lane];
      float y0 = v[i].x * rstd * g.x * (1.f + s.x) + b.x;
      float y1 = v[i].y * rstd * g.y * (1.f + s.y) + b.y;
      float y2 = v[i].z * rstd * g.z * (1.f + s.z) + b.z;
      float y3 = v[i].w * rstd * g.w * (1.f + s.w) + b.w;
      uint2 o;
      o.x = f2bf(y0) | ((unsigned)f2bf(y1) << 16);
      o.y = f2bf(y2) | ((unsigned)f2bf(y3) << 16);
      *(uint2*)(h + (size_t)row * D + (i * 64 + lane) * 4) = o;
    }
  }
}

__device__ __forceinline__ void phase_final_norm(const Params& p) {
  const int wave = otid() >> 6, lane = otid() & 63;
  const float* x = (const float*)(p.ws + OFF_X);
  const float4* g4 = (const float4*)p.in[I_FN];
  for (int row = obid() * 8 + wave; row < NTOK; row += gridDim.x * 8) {
    const float4* xr = (const float4*)(x + (size_t)row * D);
    float4 v[4];
    float ss = 0.f;
#pragma unroll
    for (int i = 0; i < 4; ++i) {
      v[i] = xr[i * 64 + lane];
      ss += v[i].x * v[i].x + v[i].y * v[i].y + v[i].z * v[i].z + v[i].w * v[i].w;
    }
    ss = wave_sum(ss);
    float rstd = rsqrtf(ss * (1.f / 1024.f) + 1e-6f);
    float4* o = (float4*)(p.out + (size_t)row * D);
#pragma unroll
    for (int i = 0; i < 4; ++i) {
      float4 g = g4[i * 64 + lane];
      o[i * 64 + lane] = make_float4(v[i].x * rstd * g.x, v[i].y * rstd * g.y, v[i].z * rstd * g.z, v[i].w * rstd * g.w);
    }
  }
}

namespace pg8 {
#define PG8_LAS __attribute__((address_space(3)))
typedef unsigned short bf16_t;
typedef short bf16x8 __attribute__((ext_vector_type(8)));
typedef float f32x4 __attribute__((ext_vector_type(4)));
typedef unsigned u32x4 __attribute__((ext_vector_type(4)));
constexpr int BM = 256, BK = 64, HALF = 128, HTB = HALF * BK * 2  , STAGE_BYTES = 8 * HTB, NXCD = 8, WGM = 8;

__host__ __device__ __forceinline__ int lds_byte(int r, int c) { const int st = (r >> 4) * 2 + (c >> 5), rr = r & 15, cc = c & 31, ob = rr * 64 + cc * 2; return st * 1024 + (ob ^ (((ob >> 9) & 1) << 5)); }
__host__ __device__ __forceinline__ void stage_rc(int b, int& R, int& C) { const int st = b / 1024, sb = b % 1024, swz = sb ^ (((sb >> 9) & 1) << 5); R = (st >> 1) * 16 + swz / 64; C = (st & 1) * 32 + (swz % 64) / 2; }
__host__ __device__ __forceinline__ int perm32(int rho) { const int n = rho >> 4, i = rho & 15; return 8 * (i >> 2) + 4 * n + (i & 3); }

struct Unit { int pm, pn; };
struct Gemm { const bf16_t* A; const bf16_t* Bt; int M, N, K; };

struct StaticOrder {
    int nM, nN, nwg, G, c;
    __host__ __device__ void init(int M, int N, int G_, int c_) { nM = M / BM; nN = N / BM; nwg = nM * nN; G = G_; c = c_; }
    __host__ __device__ bool next(int i, Unit& u) const {
        const long L = (long)i * G + c; if (L >= nwg) return false;
        int wgid = (int)L; { const int q = nwg / NXCD, r = nwg % NXCD, xcd = wgid % NXCD, off = wgid / NXCD; wgid = (xcd < r ? xcd * (q + 1) : r * (q + 1) + (xcd - r) * q) + off; }
        const int nig = WGM * nN, gid = wgid / nig, fm = gid * WGM, gsz = (nM - fm) < WGM ? (nM - fm) : WGM;
        u.pm = fm + ((wgid % nig) % gsz); u.pn = (wgid % nig) / gsz; return true;
    }
    __device__ __forceinline__ void a_ready(const Unit&) const {}
    __device__ __forceinline__ void done(const Unit&) const {}
};
__device__ __forceinline__ unsigned cvt_pk_bf16(float lo, float hi) { unsigned r; asm volatile("v_cvt_pk_bf16_f32 %0, %1, %2" : "=v"(r) : "v"(lo), "v"(hi)); return r; }

template <class Epi, class Sched, bool STAMP = false>
__device__ __forceinline__ void gemm_phase(PG8_LAS unsigned char* lds, const Gemm g, const Sched& S, const Epi& E, unsigned long long* stamps) {
    const int tid = otid(), wid = __builtin_amdgcn_readfirstlane(tid >> 6), lane = tid & 63, wr = wid >> 2, wc = wid & 3, fr = lane & 15, fq = lane >> 4;
    const int K = g.K, nt = K / BK;
    int ts_lo = 0, ts_hi = 0, nts = 0; const unsigned long long rt_entry = STAMP ? (unsigned long long)wall_clock64() : 0ull;
#define PG8_STAMP() do { if (STAMP && wid == 0 && nts < 64) { const unsigned long long _c = (unsigned long long)clock64(); \
        ts_lo = (lane == nts) ? (int)(unsigned)_c : ts_lo; ts_hi = (lane == nts) ? (int)(unsigned)(_c >> 32) : ts_hi; ++nts; } } while (0)
    PG8_STAMP();
    unsigned voffA[2], voffB[2];
#pragma unroll
    for (int i = 0; i < 2; ++i) { int R, C; stage_rc(tid * 16 + i * 8192, R, C); const int Rb = Epi::PERM ? ((R & ~31) + perm32(R & 31)) : R;
        voffA[i] = (unsigned)(R * K + C) * 2u; voffB[i] = (unsigned)(Rb * K + C) * 2u; }
    const size_t kstep = (size_t)(BK * 2);
    const size_t hstep = (size_t)HALF * K * 2;
    const size_t tstep = 2 * hstep;
    const unsigned ldsw = (unsigned)wid * 1024u;
    const int aoff = lds_byte(wr * 64 + fr, fq * 8), boff = lds_byte(wc * 32 + fr, fq * 8);
#define PG8_SA(b, h) (((b) * 2 + (h)) * HTB)
#define PG8_SB(b, h) ((4 + (b) * 2 + (h)) * HTB)
#define PG8_STAGE(bufoff, gbase, voff) do { _Pragma("unroll") for (int _i = 0; _i < 2; ++_i) \
        __builtin_amdgcn_global_load_lds((const unsigned*)((const char*)(gbase) + (voff)[_i]), (PG8_LAS unsigned*)(lds + (bufoff) + ldsw + _i * 8192), 16, 0, 0); } while (0)
#define PG8_LDA(dst, b, h) do { _Pragma("unroll") for (int m = 0; m < 4; ++m) _Pragma("unroll") for (int k = 0; k < 2; ++k) dst[m][k] = *(const PG8_LAS bf16x8*)(lds + PG8_SA(b, h) + aoff + m * 2048 + k * 1024); } while (0)
#define PG8_LDB(dst, b, h) do { _Pragma("unroll") for (int n = 0; n < 2; ++n) _Pragma("unroll") for (int k = 0; k < 2; ++k) dst[n][k] = *(const PG8_LAS bf16x8*)(lds + PG8_SB(b, h) + boff + n * 2048 + k * 1024); } while (0)
#define PG8_MMA(ai, bj, At, Bt) do { __builtin_amdgcn_s_setprio(1); _Pragma("unroll") for (int m = 0; m < 4; ++m) _Pragma("unroll") for (int n = 0; n < 2; ++n) _Pragma("unroll") for (int k = 0; k < 2; ++k) \
        acc[ai][bj][m][n] = __builtin_amdgcn_mfma_f32_16x16x32_bf16(Bt[n][k], At[m][k], acc[ai][bj][m][n], 0, 0, 0); __builtin_amdgcn_s_setprio(0); } while (0)
#define PG8_WAIT_V(n) asm volatile("s_waitcnt vmcnt(" #n ")" ::: "memory")
#define PG8_WAIT_L(n) asm volatile("s_waitcnt lgkmcnt(" #n ")" ::: "memory")
#define PG8_BAR __builtin_amdgcn_s_barrier()
#define PG8_SCHED __builtin_amdgcn_sched_barrier(0)
    Unit cur, nxt; int ui = 0;
    if (!S.next(0, cur)) return;
    f32x4 acc[2][2][4][2];
#pragma unroll
    for (int a = 0; a < 2; ++a)
#pragma unroll
        for (int b = 0; b < 2; ++b)
#pragma unroll
            for (int m = 0; m < 4; ++m)
#pragma unroll
                for (int n = 0; n < 2; ++n) acc[a][b][m][n] = (f32x4){0.f, 0.f, 0.f, 0.f};
    bf16x8 At[4][2], B0[2][2], B1[2][2];
    const char* cA = (const char*)g.A + (size_t)cur.pm * tstep; const char* cB = (const char*)g.Bt + (size_t)cur.pn * tstep;
    S.a_ready(cur);
    PG8_STAGE(PG8_SB(0, 0), cB, voffB); PG8_STAGE(PG8_SA(0, 0), cA, voffA); PG8_STAGE(PG8_SB(0, 1), cB + hstep, voffB); PG8_STAGE(PG8_SA(0, 1), cA + hstep, voffA);
    if (wr == 1) PG8_BAR;
    PG8_WAIT_V(4); PG8_BAR;
    PG8_STAGE(PG8_SB(1, 0), cB + kstep, voffB); PG8_STAGE(PG8_SA(1, 0), cA + kstep, voffA); PG8_STAGE(PG8_SB(1, 1), cB + hstep + kstep, voffB);
    PG8_WAIT_V(6); PG8_BAR;
    PG8_STAMP();
    for (;;) {
        const bool has_next = S.next(ui + 1, nxt);
        const char* nA = has_next ? (const char*)g.A + (size_t)nxt.pm * tstep : cA; const char* nB = has_next ? (const char*)g.Bt + (size_t)nxt.pn * tstep : cB;
        for (int t = 0; t < nt; t += 2) {
            const bool last = (t == nt - 2);
            const char* a1 = cA + (size_t)(t + 1) * kstep;
            const char* a2 = last ? nA : cA + (size_t)(t + 2) * kstep; const char* b2 = last ? nB : cB + (size_t)(t + 2) * kstep;
            const char* a3 = a2 + kstep; const char* b3 = b2 + kstep;
            if (last && has_next) S.a_ready(nxt);
            PG8_LDB(B0, 0, 0); PG8_SCHED; PG8_LDA(At, 0, 0); PG8_STAGE(PG8_SA(1, 1), a1 + hstep, voffA);
            PG8_WAIT_L(8); PG8_BAR; PG8_WAIT_L(0); PG8_MMA(0, 0, At, B0); PG8_BAR; PG8_SCHED;
            PG8_LDB(B1, 0, 1); PG8_STAGE(PG8_SB(0, 0), b2, voffB);
            PG8_BAR; PG8_WAIT_L(0); PG8_MMA(0, 1, At, B1); PG8_BAR;
            PG8_LDA(At, 0, 1); PG8_STAGE(PG8_SA(0, 0), a2, voffA);
            PG8_BAR; PG8_WAIT_L(0); PG8_MMA(1, 0, At, B0); PG8_BAR; PG8_SCHED;
            PG8_STAGE(PG8_SB(0, 1), b2 + hstep, voffB);
            PG8_WAIT_V(6); PG8_BAR; PG8_MMA(1, 1, At, B1); PG8_BAR;
            PG8_LDB(B0, 1, 0); PG8_SCHED; PG8_LDA(At, 1, 0); PG8_STAGE(PG8_SA(0, 1), a2 + hstep, voffA);
            PG8_WAIT_L(8); PG8_BAR; PG8_WAIT_L(0); PG8_MMA(0, 0, At, B0); PG8_BAR; PG8_SCHED;
            PG8_LDB(B1, 1, 1); PG8_STAGE(PG8_SB(1, 0), b3, voffB);
            PG8_BAR; PG8_WAIT_L(0); PG8_MMA(0, 1, At, B1); PG8_BAR;
            PG8_LDA(At, 1, 1); PG8_STAGE(PG8_SA(1, 0), a3, voffA);
            PG8_BAR; PG8_WAIT_L(0); PG8_MMA(1, 0, At, B0); PG8_BAR; PG8_SCHED;
            PG8_STAGE(PG8_SB(1, 1), b3 + hstep, voffB);
            PG8_WAIT_V(6); PG8_BAR; PG8_MMA(1, 1, At, B1); PG8_BAR;
        }
        PG8_STAMP();
        if constexpr (!Epi::AFTER_DRAIN) { E(acc, cur, wr, wc, fr, fq); S.done(cur); }
        PG8_STAMP();
        if (!has_next) break;
#pragma unroll
        for (int a = 0; a < 2; ++a)
#pragma unroll
            for (int b = 0; b < 2; ++b)
#pragma unroll
                for (int m = 0; m < 4; ++m)
#pragma unroll
                    for (int n = 0; n < 2; ++n) acc[a][b][m][n] = (f32x4){0.f, 0.f, 0.f, 0.f};
        cur = nxt; cA = nA; cB = nB; ++ui;
    }
    PG8_WAIT_V(0);
    if (wr == 0) PG8_BAR;
    PG8_BAR;
    if constexpr (Epi::AFTER_DRAIN) { E.fused(acc, cur, wr, wc, fr, fq, lds, wid, lane); S.done(cur); }
    PG8_STAMP();
    if (STAMP && wid == 0) { stamps[lane] = lane < nts ? (((unsigned long long)(unsigned)ts_hi << 32) | (unsigned)ts_lo) : 0ull;
        if (lane == 62) stamps[62] = rt_entry; if (lane == 63) stamps[63] = (unsigned long long)wall_clock64(); }
#undef PG8_STAMP
#undef PG8_SA
#undef PG8_SB
#undef PG8_STAGE
#undef PG8_LDA
#undef PG8_LDB
#undef PG8_MMA
#undef PG8_WAIT_V
#undef PG8_WAIT_L
#undef PG8_BAR
#undef PG8_SCHED
}
}

struct EpiSwiglu {
  static constexpr bool PERM = true, AFTER_DRAIN = false;
  unsigned short* H;
  __device__ __forceinline__ void operator()(const pg8::f32x4 (&acc)[2][2][4][2], const pg8::Unit& u, int wr, int wc, int fr, int fq) const {
    const int row0 = u.pm * 256 + wr * 64 + fr, hc0 = u.pn * 128 + wc * 32 + 8 * fq;
#pragma unroll
    for (int ai = 0; ai < 2; ++ai)
#pragma unroll
      for (int m = 0; m < 4; ++m) {
        unsigned short* rowp = H + (size_t)(row0 + ai * 128 + m * 16) * FH + hc0;
        float v[8];
#pragma unroll
        for (int n = 0; n < 2; ++n)
#pragma unroll
          for (int i = 0; i < 4; ++i) v[n * 4 + i] = siluf_(acc[ai][0][m][n][i]) * acc[ai][1][m][n][i];
        pg8::u32x4 o;
        o[0] = pg8::cvt_pk_bf16(v[0], v[1]); o[1] = pg8::cvt_pk_bf16(v[2], v[3]);
        o[2] = pg8::cvt_pk_bf16(v[4], v[5]); o[3] = pg8::cvt_pk_bf16(v[6], v[7]);
        *(pg8::u32x4*)rowp = o;
      }
  }
};
struct EpiResid {
  static constexpr bool PERM = false, AFTER_DRAIN = false;
  float* X; const float* modl; int gidx; float scale;
  __device__ __forceinline__ void operator()(const pg8::f32x4 (&acc)[2][2][4][2], const pg8::Unit& u, int wr, int wc, int fr, int fq) const {
    const int row0 = u.pm * 256 + wr * 64 + fr, col0 = u.pn * 256 + wc * 32 + 4 * fq;
#pragma unroll
    for (int ai = 0; ai < 2; ++ai)
#pragma unroll
      for (int m = 0; m < 4; ++m) {
        const int row = row0 + ai * 128 + m * 16;
        const float* gt = modl + (size_t)modrow(row) * 9216 + gidx * 1024 + col0;
        float* xp = X + (size_t)row * D + col0;
#pragma unroll
        for (int bj = 0; bj < 2; ++bj)
#pragma unroll
          for (int n = 0; n < 2; ++n) {
            pg8::f32x4 g = *(const pg8::f32x4*)(gt + bj * 128 + n * 16);
            pg8::f32x4* q = (pg8::f32x4*)(xp + bj * 128 + n * 16);
            *q = *q + (g * scale) * acc[ai][bj][m][n];
          }
      }
  }
};
struct EpiP {
  static constexpr bool PERM = false, AFTER_DRAIN = false;
  float* P;
  __device__ __forceinline__ void operator()(const pg8::f32x4 (&acc)[2][2][4][2], const pg8::Unit& u, int wr, int wc, int fr, int fq) const {
    const int row0 = u.pm * 256 + wr * 64 + fr, col0 = u.pn * 256 + wc * 32 + 4 * fq;
#pragma unroll
    for (int ai = 0; ai < 2; ++ai)
#pragma unroll
      for (int m = 0; m < 4; ++m) {
        float* rp = P + (size_t)(row0 + ai * 128 + m * 16) * INC;
#pragma unroll
        for (int bj = 0; bj < 2; ++bj)
#pragma unroll
          for (int n = 0; n < 2; ++n) {
            const int col = col0 + bj * 128 + n * 16;
            if (col < INC) *(pg8::f32x4*)(rp + col) = acc[ai][bj][m][n];
          }
      }
  }
};

template <class Epi>
__device__ __forceinline__ void phase_gemm(const void* A, const void* Bt, int N, int K, const Epi& E) {
  pg8::Gemm g; g.A = (const pg8::bf16_t*)A; g.Bt = (const pg8::bf16_t*)Bt; g.M = NTOK; g.N = N; g.K = K;
  int c_ = obid(), G_ = (int)gridDim.x;
  asm volatile("" : "+s"(c_), "+s"(G_));
  pg8::StaticOrder S; S.init(NTOK, N, G_, c_);
  pg8::gemm_phase<Epi, pg8::StaticOrder, false>((PG8_LAS unsigned char*)smem, g, S, E, nullptr);
  __syncthreads();
}

__device__ __forceinline__ int scan2tok(int R) {
  if (R < NCTX) return R;
  int q = R - NCTX, b = q >> 10, n = q & 1023;
  return NCTX + b * 1024 + (n & 15) * 64 + (n >> 4);
}

__device__ __forceinline__ float rw_shift(const float* P, int R, int n, int L, int c, float mu) {
  float pc = P[(size_t)scan2tok(R) * INC + C_RW + c];
  float pp = n > 0 ? P[(size_t)scan2tok(R - 1) * INC + C_RW + c] : 0.f;
  float pn = n < L - 1 ? P[(size_t)scan2tok(R + 1) * INC + C_RW + c] : 0.f;
  return pc + (0.5f * (pp + pn) - pc) * mu;
}

__device__ __forceinline__ float rdlane(float v, int l) { return __int_as_float(__builtin_amdgcn_readlane(__float_as_int(v), l)); }

__device__ __forceinline__ void prep_rwkv(const Params& p, int l) {
  const int wave = otid() >> 6, lane = otid() & 63;
  const float* P = (const float*)(p.ws + OFF_P);
  float* rec = (float*)(p.ws + OFF_REC);
  const float* mu = p.in[I_RMU] + l * 1312;
  const float* w0 = p.in[I_RW0] + l * 768;
  const float* w2 = p.in[I_RW2] + (size_t)l * 64 * 384;
  const float* a0 = p.in[I_RA0] + l * 384;
  const float* a2 = p.in[I_RA2] + (size_t)l * 32 * 384;
  const float* g2 = p.in[I_RG2] + (size_t)l * 64 * 384;
  const float* kkw = p.in[I_RKK] + l * 384;
  const float* kaw = p.in[I_RKA] + l * 384;
  float* wl = (float*)smem;
#pragma unroll 1
  for (int hp = 0; hp < 2; ++hp) {
    const int hb = hp * 3;
    __syncthreads();
    for (int i = otid(); i < 160 * 48; i += NTHR) {
      const int r = i / 48, c4 = (i % 48) * 4;
      const float* src = (r < 64 ? w2 + r * 384 : (r < 96 ? a2 + (r - 64) * 384 : g2 + (r - 96) * 384)) + hb * 64 + c4;
      *(float4*)(wl + r * 192 + c4) = *(const float4*)src;
    }
    __syncthreads();
    for (int task = obid() * 8 + wave; task < NTOK / 6; task += gridDim.x * 8) {
      const int R0 = task * 6;
      int nn[6], LL[6];
#pragma unroll
      for (int tp = 0; tp < 6; ++tp) {
        const int R = R0 + tp;
        if (R < NCTX) { nn[tp] = R & 255; LL[tp] = 256; } else { nn[tp] = (R - NCTX) & 1023; LL[tp] = 1024; }
      }
      float x0[6], x1[6], x2[6];
#pragma unroll
      for (int tp = 0; tp < 6; ++tp) {
        x0[tp] = rw_shift(P, R0 + tp, nn[tp], LL[tp], 1152 + lane, mu[1152 + lane]);
        x1[tp] = rw_shift(P, R0 + tp, nn[tp], LL[tp], 1216 + lane, mu[1216 + lane]);
        const int c2 = 1280 + (lane & 31);
        x2[tp] = rw_shift(P, R0 + tp, nn[tp], LL[tp], c2, mu[c2]);
        if (tp & 1) __builtin_amdgcn_sched_barrier(0);
      }
      float kx[3][6];
#pragma unroll
      for (int h = 0; h < 3; ++h) {
        const int c = (hb + h) * 64 + lane;
#pragma unroll
        for (int tp = 0; tp < 6; ++tp) {
          kx[h][tp] = rw_shift(P, R0 + tp, nn[tp], LL[tp], 384 + c, mu[384 + c]);
        }
      }
#pragma unroll
      for (int tp = 0; tp < 6; ++tp) {
        x0[tp] = tanhf(x0[tp]);
        x1[tp] = lane < 32 ? x1[tp] : sigmoidf_(x1[tp]);
        x2[tp] = sigmoidf_(x2[tp]);
      }
      float af[3][6], ab[3][6], aa[3][6], ag[3][6];
#pragma unroll
      for (int h = 0; h < 3; ++h)
#pragma unroll
        for (int tp = 0; tp < 6; ++tp) { af[h][tp] = 0.f; ab[h][tp] = 0.f; aa[h][tp] = 0.f; ag[h][tp] = 0.f; }
      const float* wlp = wl + lane;
      for (int j = 0; j < 32; ++j) {
        float wc[15];
#pragma unroll
        for (int h = 0; h < 3; ++h) {
          wc[h] = wlp[j * 192 + h * 64]; wc[3 + h] = wlp[(32 + j) * 192 + h * 64];
          wc[6 + h] = wlp[(64 + j) * 192 + h * 64]; wc[9 + h] = wlp[(96 + j) * 192 + h * 64]; wc[12 + h] = wlp[(128 + j) * 192 + h * 64];
        }
#pragma unroll
        for (int tp = 0; tp < 6; ++tp) {
          const float sf = rdlane(x0[tp], j), sb = rdlane(x0[tp], 32 + j), sA = rdlane(x1[tp], j), sg = rdlane(x1[tp], 32 + j), sh = rdlane(x2[tp], j);
#pragma unroll
          for (int h = 0; h < 3; ++h) {
            af[h][tp] += sf * wc[h]; ab[h][tp] += sb * wc[3 + h]; aa[h][tp] += sA * wc[6 + h];
            ag[h][tp] += sg * wc[9 + h]; ag[h][tp] += sh * wc[12 + h];
          }
        }
      }
      int R0e = R0;
      asm volatile("" : "+v"(R0e));
#pragma unroll
      for (int h = 0; h < 3; ++h) {
        const int c = (hb + h) * 64 + lane;
#pragma unroll
        for (int tp = 0; tp < 6; ++tp) {
          const int R = R0e + tp;
          const float kxv = kx[h][tp];
          const float aav = aa[h][tp], afv = af[h][tp], abv = ab[h][tp], agv = ag[h][tp];
          float a = sigmoidf_(a0[c] + aav);
          float kk = kxv * kkw[c];
          float ss = wave_sum(kk * kk);
          kk = kk * rsqrtf(fmaxf(ss, 1e-24f));
          float k2 = kxv * (1.f + (a - 1.f) * kaw[c]);
          float uf = w0[c] + afv, ub = w0[384 + c] + abv;
          float df = expf(-0.6065306597126334f * sigmoidf_(uf));
          float db = expf(-0.6065306597126334f * sigmoidf_(ub));
          const float r_ = rw_shift(P, R, nn[tp], LL[tp], c, mu[c]);
          const float v_ = rw_shift(P, R, nn[tp], LL[tp], 768 + c, mu[768 + c]);
          float* o = rec + ((size_t)R * 6 + hb + h) * 512 + lane;
          o[0] = r_; o[128] = v_;
          o[64] = k2; o[192] = -kk; o[256] = kk * a; o[320] = df; o[384] = db; o[448] = agv;
        }
      }
    }
  }
  __syncthreads();
}

__device__ __forceinline__ float logsigmoidf_(float x) { return fminf(x, 0.f) - log1pf(expf(-fabsf(x))); }

__device__ __forceinline__ void prep_gla(const Params& p, int l) {
  const int wave = otid() >> 6, lane = otid() & 63;
  const float* P = (const float*)(p.ws + OFF_P);
  float* grec = (float*)(p.ws + OFF_GREC);
  const float* w2 = p.in[I_GW2] + (size_t)l * 2 * 16 * 192;
  const float* ab = p.in[I_GB] + l * 384;
  const int z = lane >> 5, d = lane & 31;
  float wreg[6][16], breg[6];
#pragma unroll
  for (int h = 0; h < 6; ++h) {
    breg[h] = ab[z * 192 + h * 32 + d];
#pragma unroll
    for (int r = 0; r < 16; ++r) wreg[h][r] = w2[(z * 16 + r) * 192 + h * 32 + d];
  }
  for (int tok = obid() * 8 + wave; tok < NTOK; tok += gridDim.x * 8) {
    const float* pr = P + (size_t)tok * INC;
    float lr[16];
#pragma unroll
    for (int r4 = 0; r4 < 4; ++r4) {
      float4 v = *(const float4*)(pr + 1152 + z * 16 + r4 * 4);
      lr[r4 * 4 + 0] = v.x; lr[r4 * 4 + 1] = v.y; lr[r4 * 4 + 2] = v.z; lr[r4 * 4 + 3] = v.w;
    }
    float qk[6], vv[6], gg[6];
#pragma unroll
    for (int h = 0; h < 6; ++h) {
      qk[h] = lane < 32 ? pr[h * 32 + lane] : pr[192 + h * 32 + (lane - 32)];
      vv[h] = pr[384 + h * 64 + lane];
      gg[h] = pr[768 + h * 64 + lane];
    }
#pragma unroll
    for (int h = 0; h < 6; ++h) {
      float acc = breg[h];
#pragma unroll
      for (int r = 0; r < 16; ++r) acc += lr[r] * wreg[h][r];
      float alpha = expf(logsigmoidf_(acc) * (1.f / 16.f));
      float* o = grec + ((size_t)tok * 6 + h) * 256 + lane;
      o[0] = lane < 32 ? qk[h] * 0.17677669529663687f : qk[h];
      o[64] = alpha; o[128] = vv[h]; o[192] = gg[h];
    }
  }
}

__device__ __forceinline__ void prep_hyena(const Params& p, int l) {
  const float* P = (const float*)(p.ws + OFF_P);
  float* hz = (float*)(p.ws + OFF_HYZ);
  float* hx = (float*)(p.ws + OFF_HYX);
  const float* cw = p.in[I_HCW] + l * 3 * 768;
  const float* cb = p.in[I_HCB] + l * 768;
  const int c = otid() & 255, rsub = otid() >> 8;
  float w_[3][3], b_[3];
#pragma unroll
  for (int s = 0; s < 3; ++s) { b_[s] = cb[s * 256 + c]; for (int t = 0; t < 3; ++t) w_[s][t] = cw[t * 768 + s * 256 + c]; }
  for (int r0 = obid() * 8; r0 < NTOK; r0 += gridDim.x * 8) {
    float pv[4][3][3];
    int rows[4];
#pragma unroll
    for (int q = 0; q < 4; ++q) {
      const int row = r0 + q * 2 + rsub;
      rows[q] = row;
      int t, L;
      if (row < NCTX) { t = row & 255; L = 256; } else { t = (row - NCTX) & 1023; L = 1024; }
      const float* pc = P + (size_t)row * INC + C_HY + c;
#pragma unroll
      for (int s = 0; s < 3; ++s) {
        pv[q][s][1] = pc[s * 256];
        pv[q][s][0] = t > 0 ? pc[s * 256 - INC] : 0.f;
        pv[q][s][2] = t < L - 1 ? pc[s * 256 + INC] : 0.f;
      }
    }
#pragma unroll
    for (int q = 0; q < 4; ++q) {
      float u[3];
#pragma unroll
      for (int s = 0; s < 3; ++s) u[s] = pv[q][s][0] * w_[s][0] + pv[q][s][1] * w_[s][1] + pv[q][s][2] * w_[s][2] + b_[s];
      hx[(size_t)rows[q] * 256 + c] = u[0];
      hz[(size_t)rows[q] * 256 + c] = u[1] * u[2];
      ((unsigned short*)(p.ws + OFF_HZB))[(size_t)rows[q] * 256 + c] = f2bf(u[1] * u[2]);
    }
  }
}

__device__ __forceinline__ void glds16(const void* g, void* l) {
  __builtin_amdgcn_global_load_lds((const unsigned*)g, (unsigned*)l, 16, 0, 0);
}

#define VMW(n) asm volatile("s_waitcnt vmcnt(" #n ")" ::: "memory")
#define LGKM0 __builtin_amdgcn_s_waitcnt(0xC07F)
__device__ __forceinline__ float quad_sum(float x) {
  x += __int_as_float(__builtin_amdgcn_update_dpp(0, __float_as_int(x), 0xB1, 0xF, 0xF, true));
  x += __int_as_float(__builtin_amdgcn_update_dpp(0, __float_as_int(x), 0x4E, 0xF, 0xF, true));
  return x;
}

template <int R> struct RwOps { f32x4 A[2], B[2], K[2], W[2], Rr[2]; float v[R]; };
constexpr int RW_SLOT = 1536;
__device__ __forceinline__ void rw_fill(const float* recg, char* slot, int lane, int dir) {
  glds16((const char*)recg + lane * 16, slot);
  if (lane < 32) {
    const char* g2 = (const char*)recg + (lane < 16 ? 1024 + lane * 16 : (5 + dir) * 256 + (lane - 16) * 16);
    glds16(g2, slot + 1024);
  }
}
template <int R>
__device__ __forceinline__ void rw_load(RwOps<R>& o, const char* rec, int k8, int vrow) {
  const f32x4* q = (const f32x4*)rec + k8 * 2;
#pragma unroll
  for (int i = 0; i < 2; ++i) { o.Rr[i] = q[i]; o.K[i] = q[16 + i]; o.A[i] = q[48 + i]; o.B[i] = q[64 + i]; o.W[i] = q[80 + i]; }
  if (R == 2) { f32x2 t = *(const f32x2*)((const float*)rec + 128 + vrow); o.v[0] = t.x; o.v[R - 1] = t.y; }
  else o.v[0] = ((const float*)rec)[128 + vrow];
}
template <int R>
__device__ __forceinline__ void rw_step(f32x2 (&S)[R][4], const RwOps<R>& o, float (&res)[R]) {
  const f32x2 A0 = {o.A[0][0], o.A[0][1]}, A1 = {o.A[0][2], o.A[0][3]}, A2 = {o.A[1][0], o.A[1][1]}, A3 = {o.A[1][2], o.A[1][3]};
  float sa[R];
#pragma unroll
  for (int r = 0; r < R; ++r) {
    f32x2 p0 = S[r][0] * A0, q0 = S[r][1] * A1;
    p0 += S[r][2] * A2; q0 += S[r][3] * A3;
    p0 += q0;
    sa[r] = p0.x + p0.y;
  }
#pragma unroll
  for (int r = 0; r < R; ++r) sa[r] += dpp_f(sa[r], 0);
#pragma unroll
  for (int r = 0; r < R; ++r) sa[r] += dpp_f(sa[r], 1);
#pragma unroll
  for (int r = 0; r < R; ++r) sa[r] += dpp_f(sa[r], 2);
#pragma unroll
  for (int i = 0; i < 4; ++i) {
    const f32x2 W = {o.W[i >> 1][(i & 1) * 2], o.W[i >> 1][(i & 1) * 2 + 1]};
    const f32x2 B = {o.B[i >> 1][(i & 1) * 2], o.B[i >> 1][(i & 1) * 2 + 1]};
    const f32x2 K = {o.K[i >> 1][(i & 1) * 2], o.K[i >> 1][(i & 1) * 2 + 1]};
#pragma unroll
    for (int r = 0; r < R; ++r) S[r][i] = S[r][i] * W + (f32x2{sa[r], sa[r]} * B + f32x2{o.v[r], o.v[r]} * K);
  }
  const f32x2 R0 = {o.Rr[0][0], o.Rr[0][1]}, R1 = {o.Rr[0][2], o.Rr[0][3]}, R2 = {o.Rr[1][0], o.Rr[1][1]}, R3 = {o.Rr[1][2], o.Rr[1][3]};
#pragma unroll
  for (int r = 0; r < R; ++r) {
    f32x2 u0 = S[r][0] * R0, w0 = S[r][1] * R1;
    u0 += S[r][2] * R2; w0 += S[r][3] * R3;
    u0 += w0;
    res[r] = u0.x + u0.y;
  }
#pragma unroll
  for (int r = 0; r < R; ++r) res[r] += dpp_f(res[r], 0);
#pragma unroll
  for (int r = 0; r < R; ++r) res[r] += dpp_f(res[r], 1);
#pragma unroll
  for (int r = 0; r < R; ++r) res[r] += dpp_f(res[r], 2);
}

template <int NW>
__device__ __forceinline__ void rw_poll(volatile unsigned* f, unsigned target) {
  for (unsigned sp = 0; sp < (1u << 20); ++sp) {
    unsigned m = min(min(f[0], f[1]), min(f[2], f[3]));
    if (NW == 8) m = min(m, min(min(f[4], f[5]), min(f[6], f[7])));
    if ((unsigned)__builtin_amdgcn_readfirstlane((int)m) >= target) break;
    __builtin_amdgcn_s_sleep(1);
  }
  asm volatile("" ::: "memory");
}

constexpr int RQ_STEPS = 64;
template <int NW, int R, int RING>
__device__ __forceinline__ void rwkv_scan(const Params& p, int l, int scan, int w, int rowoff, char* ring, volatile unsigned* fl) {
  constexpr int LPC = 8 / NW;
  constexpr int NCHR = RING / 8;
  static_assert(NW == 4 && (RING == 64 || RING == 32), "vmcnt immediates below are written for these cases");
  const int lane = otid() & 63;
  scan = __builtin_amdgcn_readfirstlane(scan);
  w = __builtin_amdgcn_readfirstlane(w);
  int b, hd, L, rowbase;
  const bool lat = scan < 96;
  if (lat) { b = scan / 12; hd = scan % 12; L = 1024; rowbase = NCTX + b * 1024; }
  else { int t2 = scan - 96; b = t2 / 12; hd = t2 % 12; L = 256; rowbase = b * 256; }
  const int h = hd >> 1, dir = hd & 1;
  const int k8 = lane & 7, vrow = rowoff + w * (8 * R) + (lane >> 3) * R;
  const float* rec = (const float*)(p.ws + OFF_REC);
  float* RO = (float*)(p.ws + OFF_RO) + (size_t)dir * NTOK * 384 + h * 64 + vrow + (R == 2 ? (k8 & 1) : 0);
  f32x2 S[R][4];
  if (lat) {
    const float* sb = p.in[I_SR] + ((((size_t)b * DEPTH + l) * 2 + dir) * 6 + h) * 4096 + vrow * 64 + k8 * 8;
#pragma unroll
    for (int r = 0; r < R; ++r)
#pragma unroll
      for (int i = 0; i < 2; ++i) { float4 v = *(const float4*)(sb + r * 64 + i * 4); S[r][2 * i] = f32x2{v.x, v.y}; S[r][2 * i + 1] = f32x2{v.z, v.w}; }
  } else {
#pragma unroll
    for (int r = 0; r < R; ++r)
#pragma unroll
      for (int i = 0; i < 4; ++i) S[r][i] = f32x2{0.f, 0.f};
  }
  VMW(0);
  const int NCH = L >> 3;
#define RW_REC(st) (rec + ((size_t)(rowbase + (dir ? L - 1 - (st) : (st))) * 6 + h) * 512)
#define RW_SLOTP(st) (ring + ((st) & (RING - 1)) * RW_SLOT)
#pragma unroll
  for (int c = 0; c < NCHR - 1; ++c)
#pragma unroll
    for (int t = 0; t < LPC; ++t) { const int s = 8 * c + NW * t + w; rw_fill(RW_REC(s), RW_SLOTP(s), lane, dir); }
  RwOps<R> oa{};
  float osel = 0.f;
  for (int c = 0; c < NCH; ++c) {
    if (c + NCHR - 2 <= NCH - 1) { if (RING == 64) VMW(20); else VMW(4); } else VMW(0);
    if (lane == 0) fl[w] = (unsigned)(c + 2);
    rw_poll<NW>(fl, (unsigned)(c + 2));
    if (c == 0) rw_load<R>(oa, RW_SLOTP(0), k8, vrow);
    for (int j = 0; j < 8; j += 2) {
      const int s = 8 * c + j;
      RwOps<R> ob;
      LGKM0;
      rw_load<R>(ob, RW_SLOTP(s + 1), k8, vrow);
      __builtin_amdgcn_sched_barrier(0);
      {
        float o[R];
        rw_step<R>(S, oa, o);
        if (R == 2) osel = ((s & 3) == (k8 >> 1)) ? ((k8 & 1) ? o[R - 1] : o[0]) : osel;
        else osel = ((s & 7) == k8) ? o[0] : osel;
      }
      __builtin_amdgcn_sched_barrier(0);
      LGKM0;
      rw_load<R>(oa, RW_SLOTP(s + 2), k8, vrow);
      __builtin_amdgcn_sched_barrier(0);
      {
        float o[R];
        rw_step<R>(S, ob, o);
        if (R == 2) {
          osel = (((s + 1) & 3) == (k8 >> 1)) ? ((k8 & 1) ? o[R - 1] : o[0]) : osel;
          if (((s + 1) & 3) == 3) {
            const int st = s - 2 + (k8 >> 1);
            const int n = dir ? L - 1 - st : st;
            RO[(size_t)(rowbase + n) * 384] = osel;
          }
        } else {
          osel = (((s + 1) & 7) == k8) ? o[0] : osel;
          if (((s + 1) & 7) == 7) {
            const int st = s - 6 + k8;
            const int n = dir ? L - 1 - st : st;
            RO[(size_t)(rowbase + n) * 384] = osel;
          }
        }
      }
      __builtin_amdgcn_sched_barrier(0);
    }
    asm volatile("" ::: "memory");
    if (lane == 0) fl[8 + w] = (unsigned)(c + 1);
    if (c + NCHR - 1 < NCH) {
      rw_poll<NW>(fl + 8, (unsigned)c);
#pragma unroll
      for (int t = 0; t < LPC; ++t) { const int s = 8 * (c + NCHR - 1) + NW * t + w; rw_fill(RW_REC(s), RW_SLOTP(s), lane, dir); }
    }
  }
#undef RW_REC
#undef RW_SLOTP
  if (!lat) {
    float* so = p.out + (size_t)NTOK * D + (size_t)16 * DEPTH * 2 * 6 * 2048 +
                ((((size_t)b * DEPTH + l) * 2 + dir) * 6 + h) * 4096 + vrow * 64 + k8 * 8;
#pragma unroll
    for (int r = 0; r < R; ++r)
#pragma unroll
      for (int i = 0; i < 2; ++i) *(float4*)(so + r * 64 + i * 4) = make_float4(S[r][2 * i].x, S[r][2 * i].y, S[r][2 * i + 1].x, S[r][2 * i + 1].y);
  }
  VMW(0);
}

struct RwOpsLa { f32x4 An[2], B[2], K[2], W[2], Rr[2]; float v; };
__device__ __forceinline__ void rw_load_la(RwOpsLa& o, const char* rec, const char* recn, int k8, int vrow) {
  const f32x4* q = (const f32x4*)rec + k8 * 2;
  const f32x4* qn = (const f32x4*)recn + k8 * 2;
#pragma unroll
  for (int i = 0; i < 2; ++i) { o.Rr[i] = q[i]; o.K[i] = q[16 + i]; o.B[i] = q[64 + i]; o.W[i] = q[80 + i]; o.An[i] = qn[48 + i]; }
  o.v = ((const float*)rec)[128 + vrow];
}
__device__ __forceinline__ float rw_step_la(f32x2 (&S)[4], float& sa, const RwOpsLa& o) {
  f32x2 W2[4], B2[4], K2[4], A2[4], R2[4];
#pragma unroll
  for (int i = 0; i < 4; ++i) {
    const int a = i >> 1, c = (i & 1) * 2;
    W2[i] = f32x2{o.W[a][c], o.W[a][c + 1]}; B2[i] = f32x2{o.B[a][c], o.B[a][c + 1]}; K2[i] = f32x2{o.K[a][c], o.K[a][c + 1]};
    A2[i] = f32x2{o.An[a][c], o.An[a][c + 1]}; R2[i] = f32x2{o.Rr[a][c], o.Rr[a][c + 1]};
  }
  const f32x2 vv = {o.v, o.v};
  f32x2 T[4];
#pragma unroll
  for (int i = 0; i < 4; ++i) T[i] = S[i] * W2[i] + vv * K2[i];
  f32x2 g0 = T[0] * A2[0], g1 = T[1] * A2[1];
  g0 += T[2] * A2[2]; g1 += T[3] * A2[3]; g0 += g1;
  f32x2 b0 = B2[0] * A2[0], b1 = B2[1] * A2[1];
  b0 += B2[2] * A2[2]; b1 += B2[3] * A2[3]; b0 += b1;
  float gp = g0.x + g0.y, bp = b0.x + b0.y;
  gp += dpp_f(gp, 0); bp += dpp_f(bp, 0);
  gp += dpp_f(gp, 1); bp += dpp_f(bp, 1);
  gp += dpp_f(gp, 2); bp += dpp_f(bp, 2);
  const f32x2 sav = {sa, sa};
#pragma unroll
  for (int i = 0; i < 4; ++i) S[i] = sav * B2[i] + T[i];
  f32x2 u0 = S[0] * R2[0], u1 = S[1] * R2[1];
  u0 += S[2] * R2[2]; u1 += S[3] * R2[3]; u0 += u1;
  float ov = u0.x + u0.y;
  ov += dpp_f(ov, 0); ov += dpp_f(ov, 1); ov += dpp_f(ov, 2);
  sa = sa * bp + gp;
  return ov;
}

__device__ __forceinline__ void rwkv_scan_la(const Params& p, int l, int scan, int w, int rowoff, char* ring, volatile unsigned* fl) {
  constexpr int NW = 4, R = 1, RING = 64;
  constexpr int LPC = 8 / NW;
  constexpr int NCHR = RING / 8;
  static_assert(NW == 4 && (RING == 64 || RING == 32), "vmcnt immediates below are written for these cases");
  const int lane = otid() & 63;
  scan = __builtin_amdgcn_readfirstlane(scan);
  w = __builtin_amdgcn_readfirstlane(w);
  int b, hd, L, rowbase;
  const bool lat = scan < 96;
  if (lat) { b = scan / 12; hd = scan % 12; L = 1024; rowbase = NCTX + b * 1024; }
  else { int t2 = scan - 96; b = t2 / 12; hd = t2 % 12; L = 256; rowbase = b * 256; }
  const int h = hd >> 1, dir = hd & 1;
  const int k8 = lane & 7, vrow = rowoff + w * (8 * R) + (lane >> 3) * R;
  const float* rec = (const float*)(p.ws + OFF_REC);
  float* RO = (float*)(p.ws + OFF_RO) + (size_t)dir * NTOK * 384 + h * 64 + vrow + (R == 2 ? (k8 & 1) : 0);
  f32x2 S[R][4];
  if (lat) {
    const float* sb = p.in[I_SR] + ((((size_t)b * DEPTH + l) * 2 + dir) * 6 + h) * 4096 + vrow * 64 + k8 * 8;
#pragma unroll
    for (int r = 0; r < R; ++r)
#pragma unroll
      for (int i = 0; i < 2; ++i) { float4 v = *(const float4*)(sb + r * 64 + i * 4); S[r][2 * i] = f32x2{v.x, v.y}; S[r][2 * i + 1] = f32x2{v.z, v.w}; }
  } else {
#pragma unroll
    for (int r = 0; r < R; ++r)
#pragma unroll
      for (int i = 0; i < 4; ++i) S[r][i] = f32x2{0.f, 0.f};
  }
  VMW(0);
  const int NCH = L >> 3;
#define RW_REC(st) (rec + ((size_t)(rowbase + (dir ? L - 1 - (st) : (st))) * 6 + h) * 512)
#define RW_SLOTP(st) (ring + ((st) & (RING - 1)) * RW_SLOT)
#pragma unroll
  for (int c = 0; c < NCHR - 1; ++c)
#pragma unroll
    for (int t = 0; t < LPC; ++t) { const int s = 8 * c + NW * t + w; rw_fill(RW_REC(s), RW_SLOTP(s), lane, dir); }
  RwOpsLa oa{};
  float sa = 0.f;
  float osel = 0.f;
  for (int c = 0; c < NCH; ++c) {
    if (c + NCHR - 2 <= NCH - 1) { if (RING == 64) VMW(20); else VMW(4); } else VMW(0);
    if (lane == 0) fl[w] = (unsigned)(c + 2);
    rw_poll<NW>(fl, (unsigned)(c + 2));
    if (c == 0) {
      const f32x4* q0 = (const f32x4*)RW_SLOTP(0) + k8 * 2;
      const f32x4 a0 = q0[48], a1 = q0[49];
      f32x2 d0 = S[0][0] * f32x2{a0[0], a0[1]}, d1 = S[0][1] * f32x2{a0[2], a0[3]};
      d0 += S[0][2] * f32x2{a1[0], a1[1]}; d1 += S[0][3] * f32x2{a1[2], a1[3]};
      d0 += d1;
      sa = d0.x + d0.y;
      sa += dpp_f(sa, 0); sa += dpp_f(sa, 1); sa += dpp_f(sa, 2);
      rw_load_la(oa, RW_SLOTP(0), RW_SLOTP(1), k8, vrow);
    }
    for (int j = 0; j < 8; j += 2) {
      const int s = 8 * c + j;
      RwOpsLa ob;
      LGKM0;
      rw_load_la(ob, RW_SLOTP(s + 1), RW_SLOTP(s + 2), k8, vrow);
      __builtin_amdgcn_sched_barrier(0);
      {
        float o[R];
        o[0] = rw_step_la(S[0], sa, oa);
        if (R == 2) osel = ((s & 3) == (k8 >> 1)) ? ((k8 & 1) ? o[R - 1] : o[0]) : osel;
        else osel = ((s & 7) == k8) ? o[0] : osel;
      }
      __builtin_amdgcn_sched_barrier(0);
      LGKM0;
      rw_load_la(oa, RW_SLOTP(s + 2), RW_SLOTP(s + 3), k8, vrow);
      __builtin_amdgcn_sched_barrier(0);
      {
        float o[R];
        o[0] = rw_step_la(S[0], sa, ob);
        if (R == 2) {
          osel = (((s + 1) & 3) == (k8 >> 1)) ? ((k8 & 1) ? o[R - 1] : o[0]) : osel;
          if (((s + 1) & 3) == 3) {
            const int st = s - 2 + (k8 >> 1);
            const int n = dir ? L - 1 - st : st;
            RO[(size_t)(rowbase + n) * 384] = osel;
          }
        } else {
          osel = (((s + 1) & 7) == k8) ? o[0] : osel;
          if (((s + 1) & 7) == 7) {
            const int st = s - 6 + k8;
            const int n = dir ? L - 1 - st : st;
            RO[(size_t)(rowbase + n) * 384] = osel;
          }
        }
      }
      __builtin_amdgcn_sched_barrier(0);
    }
    asm volatile("" ::: "memory");
    if (lane == 0) fl[8 + w] = (unsigned)(c + 1);
    if (c + NCHR - 1 < NCH) {
      rw_poll<NW>(fl + 8, (unsigned)c);
#pragma unroll
      for (int t = 0; t < LPC; ++t) { const int s = 8 * (c + NCHR - 1) + NW * t + w; rw_fill(RW_REC(s), RW_SLOTP(s), lane, dir); }
    }
  }
#undef RW_REC
#undef RW_SLOTP
  if (!lat) {
    float* so = p.out + (size_t)NTOK * D + (size_t)16 * DEPTH * 2 * 6 * 2048 +
                ((((size_t)b * DEPTH + l) * 2 + dir) * 6 + h) * 4096 + vrow * 64 + k8 * 8;
#pragma unroll
    for (int r = 0; r < R; ++r)
#pragma unroll
      for (int i = 0; i < 2; ++i) *(float4*)(so + r * 64 + i * 4) = make_float4(S[r][2 * i].x, S[r][2 * i].y, S[r][2 * i + 1].x, S[r][2 * i + 1].y);
  }
  VMW(0);
}

template <int NE> struct GlOps { f32x4 Q[2], K[2], A[2]; float v[NE]; };
constexpr int GL_RING = 32, GL_SLOT = 768;
template <int NE>
__device__ __forceinline__ void gl_load(GlOps<NE>& o, const char* rec, int dir, int dq, int ecol) {
  const f32x4* q = (const f32x4*)rec;
#pragma unroll
  for (int i = 0; i < 2; ++i) { o.Q[i] = q[dq * 2 + i]; o.K[i] = q[8 + dq * 2 + i]; o.A[i] = q[16 + dir * 8 + dq * 2 + i]; }
  if (NE == 4) { f32x4 t = *(const f32x4*)((const float*)rec + 128 + ecol); o.v[0] = t[0]; o.v[1] = t[1]; o.v[NE - 2] = t[2]; o.v[NE - 1] = t[3]; }
  else { f32x2 t = *(const f32x2*)((const float*)rec + 128 + ecol); o.v[0] = t.x; o.v[1] = t.y; }
}
template <int NE>
__device__ __forceinline__ float gl_step(f32x2 (&S)[8][NE / 2], const GlOps<NE>& o, int dq) {
  f32x2 vv[NE / 2], acc[NE / 2];
#pragma unroll
  for (int e = 0; e < NE / 2; ++e) { vv[e] = f32x2{o.v[2 * e], o.v[2 * e + 1]}; acc[e] = f32x2{0.f, 0.f}; }
#pragma unroll
  for (int d = 0; d < 8; ++d) {
    const float a = o.A[d >> 2][d & 3], kk = o.K[d >> 2][d & 3], qq = o.Q[d >> 2][d & 3];
    const f32x2 av = {a, a}, kv = {kk, kk}, qv = {qq, qq};
#pragma unroll
    for (int e = 0; e < NE / 2; ++e) { S[d][e] = av * S[d][e] + kv * vv[e]; acc[e] += qv * S[d][e]; }
  }
  if (NE == 4) {
    const float r0 = quad_sum(acc[0].x), r1 = quad_sum(acc[0].y), r2 = quad_sum(acc[NE / 2 - 1].x), r3 = quad_sum(acc[NE / 2 - 1].y);
    return dq == 0 ? r0 : (dq == 1 ? r1 : (dq == 2 ? r2 : r3));
  } else {
    const float r0 = quad_sum(acc[0].x), r1 = quad_sum(acc[0].y);
    return (dq & 1) ? r1 : r0;
  }
}
template <int NE>
__device__ __forceinline__ void gla_scan(const Params& p, int l, int task, int eh, char* ring  ) {
  const int lane = otid() & 63;
  task = __builtin_amdgcn_readfirstlane(task);
  int b, hd, L, rowbase;
  const bool lat = task < 96;
  if (lat) { b = task / 12; hd = task % 12; L = 1024; rowbase = NCTX + b * 1024; }
  else { int t2 = task - 96; b = t2 / 12; hd = t2 % 12; L = 256; rowbase = b * 256; }
  const int h = hd >> 1, dir = hd & 1;
  const int dq = lane & 3, eg = lane >> 2;
  const int ecol = (NE == 4) ? eg * 4 : eh * 32 + eg * 2;
  const bool owner = (NE == 4) || dq < 2;
  const float* grec = (const float*)(p.ws + OFF_GREC);
  float* GO = (float*)(p.ws + OFF_GO) + (size_t)dir * NTOK * 384 + h * 64 + ecol + (NE == 4 ? dq : (dq & 1));
  f32x2 S[8][NE / 2];
  if (lat) {
    const float* s0 = p.in[I_SG] + ((((size_t)b * DEPTH + l) * 2 + dir) * 6 + h) * 2048 + (dq * 8) * 64 + ecol;
#pragma unroll
    for (int d = 0; d < 8; ++d)
#pragma unroll
      for (int e = 0; e < NE / 2; ++e) { f32x2 v = *(const f32x2*)(s0 + d * 64 + 2 * e); S[d][e] = v; }
  } else {
#pragma unroll
    for (int d = 0; d < 8; ++d)
#pragma unroll
      for (int e = 0; e < NE / 2; ++e) S[d][e] = f32x2{0.f, 0.f};
  }
  VMW(0);
#define GL_REC(st) ((const char*)(grec + ((size_t)(rowbase + (dir ? L - 1 - (st) : (st))) * 6 + h) * 256))
#pragma unroll
  for (int s = 0; s < GL_RING; ++s) { if (lane < 48) glds16(GL_REC(s) + lane * 16, ring + s * GL_SLOT); }
  GlOps<NE> oa{};
  VMW(31);
  gl_load<NE>(oa, ring, dir, dq, ecol);
  for (int s = 0; s < L; s += 2) {
    GlOps<NE> ob;
    LGKM0; if (s + GL_RING >= L) VMW(0); else VMW(30);
    gl_load<NE>(ob, ring + ((s + 1) & (GL_RING - 1)) * GL_SLOT, dir, dq, ecol);
    __builtin_amdgcn_sched_barrier(0);
    {
      float o = gl_step<NE>(S, oa, dq);
      const int n = dir ? L - 1 - s : s;
      if (owner) GO[(size_t)(rowbase + n) * 384] = o;
    }
    asm volatile("" ::: "memory");
    if (s + GL_RING < L && lane < 48) glds16(GL_REC(s + GL_RING) + lane * 16, ring + (s & (GL_RING - 1)) * GL_SLOT);
    __builtin_amdgcn_sched_barrier(0);
    LGKM0; if (s + 1 + GL_RING >= L) VMW(0); else VMW(30);
    gl_load<NE>(oa, ring + ((s + 2) & (GL_RING - 1)) * GL_SLOT, dir, dq, ecol);
    __builtin_amdgcn_sched_barrier(0);
    {
      float o = gl_step<NE>(S, ob, dq);
      const int n = dir ? L - 2 - s : s + 1;
      if (owner) GO[(size_t)(rowbase + n) * 384] = o;
    }
    asm volatile("" ::: "memory");
    if (s + 1 + GL_RING < L && lane < 48) glds16(GL_REC(s + 1 + GL_RING) + lane * 16, ring + ((s + 1) & (GL_RING - 1)) * GL_SLOT);
    __builtin_amdgcn_sched_barrier(0);
  }
#undef GL_REC
  if (!lat) {
    float* so = p.out + (size_t)NTOK * D + ((((size_t)b * DEPTH + l) * 2 + dir) * 6 + h) * 2048 + (dq * 8) * 64 + ecol;
#pragma unroll
    for (int d = 0; d < 8; ++d)
#pragma unroll
      for (int e = 0; e < NE / 2; ++e) *(f32x2*)(so + d * 64 + 2 * e) = S[d][e];
  }
  VMW(0);
}

constexpr int HY_TASKS = 768;
__device__ __forceinline__ void hyena_task(const Params& p, int l, int task) {
  const int lane = otid() & 63;
  int b, cgp, tb, L, rowbase;
  const float* ft = (const float*)(p.ws + OFF_FT) + (size_t)l * FT_LAYER;
  if (task < 512) { b = task >> 6; cgp = (task >> 5) & 1; tb = task & 31; L = 1024; rowbase = NCTX + b * 1024; ft += FT_L0; }
  else { int t2 = task - 512; b = t2 >> 4; cgp = (t2 >> 3) & 1; tb = t2 & 7; L = 256; rowbase = b * 256; }
  const int c = cgp * 128 + lane * 2;
  const int t0 = tb * 32;
  const float* hz = (const float*)(p.ws + OFF_HYZ) + (size_t)rowbase * 256 + c;
  const float* hx = (const float*)(p.ws + OFF_HYX) + (size_t)rowbase * 256 + c;
  const float* fc = ft + c;
  const unsigned short* hzb = (const unsigned short*)(p.ws + OFF_HZB) + (size_t)rowbase * 256 + c;
  const unsigned short* fcb = (const unsigned short*)(p.ws + OFF_FTB) + (size_t)(ft - (const float*)(p.ws + OFF_FT)) + c;
  f32x2 acc[32];
#pragma unroll
  for (int i = 0; i < 32; ++i) acc[i] = f32x2{0.f, 0.f};
  for (int s0 = 0; s0 < L; s0 += 16) {
    f32x2 z[16], f[47];
#pragma unroll
    for (int j = 0; j < 16; ++j) { const unsigned u = *(const unsigned*)(hzb + (size_t)(s0 + j) * 256); z[j] = f32x2{__uint_as_float(u << 16), __uint_as_float(u & 0xffff0000u)}; }
    const unsigned short* fb = fcb + (size_t)(t0 - s0 - 15 + L - 1) * 256;
#pragma unroll
    for (int m = 0; m < 47; ++m) { const unsigned u = *(const unsigned*)(fb + (size_t)m * 256); f[m] = f32x2{__uint_as_float(u << 16), __uint_as_float(u & 0xffff0000u)}; }
#pragma unroll
    for (int i = 0; i < 32; ++i)
#pragma unroll
      for (int j = 0; j < 16; ++j) acc[i] += f[i - j + 15] * z[j];
  }
  const f32x2 bias = *(const f32x2*)(p.in[I_HBIAS] + l * 256 + c);
  unsigned* O = (unsigned*)(p.ws + OFF_H);
#pragma unroll
  for (int i = 0; i < 32; ++i) {
    int t = t0 + i;
    f32x2 zz = *(const f32x2*)(hz + (size_t)t * 256), xx = *(const f32x2*)(hx + (size_t)t * 256);
    f32x2 y = xx * (acc[i] + zz * bias);
    O[((size_t)(rowbase + t) * D + 384 + c) >> 1] = (unsigned)f2bf(y.x) | ((unsigned)f2bf(y.y) << 16);
  }
}

constexpr int LDS_GLA = 98304, LDS_FLAGS = 147456, LDS_XB = 147584;
__device__ __forceinline__ void phase_mixers(const Params& p, int l, int cidx) {
  const int wave = otid() >> 6, lane = otid() & 63;
  const int bid = obid();
  volatile unsigned* fl = (volatile unsigned*)(smem + LDS_FLAGS);
  if (otid() < 32) fl[otid()] = 0u;
  __syncthreads();
  __builtin_amdgcn_s_setprio(3);
  if (bid < 192) {
    if (wave < 4) rwkv_scan_la(p, l, bid >> 1, wave, (bid & 1) * 32, smem, fl);
    else rwkv_scan<4, 2, 32>(p, l, 96 + bid, wave - 4, 0, smem + 98304, fl + 16);
  } else if (wave < 3) {
    const int g = (bid - 192) * 3 + wave;
    gla_scan<2>(p, l, g >> 1, g & 1, smem + wave * 24576);
  } else if (wave < 6) {
    gla_scan<4>(p, l, 96 + (bid - 192) * 3 + (wave - 3), 0, smem + wave * 24576);
  }
  __builtin_amdgcn_s_setprio(0);
  int* cnt = (int*)(p.ws + OFF_CNT) + cidx;
  const int ntask = HY_TASKS + (l < DEPTH - 1 ? 5312 : 0);
  while (true) {
    int t = 0;
    if (lane == 0) t = atomicAdd(cnt, 1);
    t = __shfl(t, 0);
    if (t >= ntask) break;
    if (t < HY_TASKS) hyena_task(p, l, t);
    else wconv_wave(p, l + 1, (l + 1) & 1, t - HY_TASKS);
  }
}

__device__ __forceinline__ void phase_post(const Params& p, int l) {
  const int wave = otid() >> 6, lane = otid() & 63;
  const float* GO = (const float*)(p.ws + OFF_GO);
  const float* RO = (const float*)(p.ws + OFF_RO);
  const float* grec = (const float*)(p.ws + OFF_GREC);
  const float* rec = (const float*)(p.ws + OFF_REC);
  unsigned short* O = (unsigned short*)(p.ws + OFF_H);
  const float gn = p.in[I_GN][l * 64 + lane];
  float lw[6], lb[6], rk[6];
#pragma unroll
  for (int h = 0; h < 6; ++h) { lw[h] = p.in[I_RLW][l * 384 + h * 64 + lane]; lb[h] = p.in[I_RLB][l * 384 + h * 64 + lane]; rk[h] = p.in[I_RRK][l * 384 + h * 64 + lane]; }
  for (int R = obid() * 8 + wave; R < NTOK; R += gridDim.x * 8) {
    const int tokr = scan2tok(R);
    float go[6], gg[6], ro[6], r_[6], k_[6], v_[6], g_[6];
#pragma unroll
    for (int h = 0; h < 6; ++h) {
      go[h] = GO[(size_t)R * 384 + h * 64 + lane] + GO[(size_t)(NTOK + R) * 384 + h * 64 + lane];
      gg[h] = grec[((size_t)R * 6 + h) * 256 + 192 + lane];
      ro[h] = RO[(size_t)R * 384 + h * 64 + lane] + RO[(size_t)(NTOK + R) * 384 + h * 64 + lane];
      const float* rr = rec + ((size_t)R * 6 + h) * 512 + lane;
      r_[h] = rr[0]; k_[h] = rr[64]; v_[h] = rr[128]; g_[h] = rr[448];
    }
    __builtin_amdgcn_sched_barrier(0);
#pragma unroll
    for (int h = 0; h < 6; ++h) {
      const float o = go[h];
      float ms = wave_sum(o * o) * (1.f / 64.f);
      float y = o * rsqrtf(ms + 1e-6f) * gn;
      O[(size_t)R * D + h * 64 + lane] = f2bf(y * siluf_(gg[h]));
    }
#pragma unroll
    for (int h = 0; h < 6; ++h) {
      const int c = h * 64 + lane;
      const float o = ro[h];
      float mean = wave_sum(o) * (1.f / 64.f);
      float dlt = o - mean;
      float var = wave_sum(dlt * dlt) * (1.f / 64.f);
      float y = dlt * rsqrtf(var + 64e-5f) * lw[h] + lb[h];
      float bonus = wave_sum(r_[h] * k_[h] * rk[h]) * v_[h];
      O[(size_t)tokr * D + 640 + c] = f2bf((y + bonus) * g_[h]);
    }
  }
}

#define XB_TMO      128
#define XB_XCNT(j)  (256  + 64 * (j))
#define XB_XSUB(j)  (1280 + 64 * (j))
#define XB_XGEN(j)  (2304 + 64 * (j))
#define XB_TOP      3328
#define XB_TOPGEN   3392
#define XCD_BAR_WORDS 3456
#define XB_SPIN_CAP (1u << 18)
#define LAS __attribute__((address_space(3)))

__device__ __forceinline__ unsigned xb_ld(unsigned* p)              { return __hip_atomic_load(p, __ATOMIC_RELAXED, __HIP_MEMORY_SCOPE_AGENT); }
__device__ __forceinline__ unsigned xb_add(unsigned* p, unsigned v) { return __hip_atomic_fetch_add(p, v, __ATOMIC_RELAXED, __HIP_MEMORY_SCOPE_AGENT); }
__device__ __forceinline__ unsigned xb_xcc_id() { return (unsigned)__builtin_amdgcn_s_getreg((3 << 11) | 20) & 0xFu; }
#define XB_SPIN(cond, bar) do { unsigned _sp = 0; while (cond) { __builtin_amdgcn_s_sleep(1); \
    if ((++_sp & 255u) == 0u) { if (xb_ld(&(bar)[XB_TMO])) break; if (_sp > XB_SPIN_CAP) { atomicAdd(&(bar)[XB_TMO], 1u); break; } } } } while (0)

struct XcdBarrier {
    unsigned* bar; unsigned x;
    volatile LAS unsigned* st;
};

__device__ __forceinline__ XcdBarrier xcd_barrier_post(unsigned* bar, volatile LAS unsigned* st) {
    XcdBarrier b; b.bar = bar; b.x = xb_xcc_id(); b.st = st;
    if (threadIdx.x == 0) (void)xb_add(&bar[XB_XCNT(b.x)], 1u);
    return b;
}
__device__ __forceinline__ void xcd_barrier_complete(unsigned* bar, unsigned x, unsigned& nloc, unsigned& nx) {
    const unsigned G = gridDim.x * gridDim.y * gridDim.z;
    unsigned sum, cnt, mine, sp = 0u;
    for (;;) {
        sum = 0u; cnt = 0u; mine = 0u;
#pragma unroll
        for (unsigned j = 0; j < 16; ++j) { const unsigned c = xb_ld(&bar[XB_XCNT(j)]); sum += c; cnt += (c > 0u) ? 1u : 0u; mine = (j == x) ? c : mine; }
        if (sum == G) break;
        __builtin_amdgcn_s_sleep(1);
        if ((++sp & 255u) == 0u) { if (xb_ld(&bar[XB_TMO])) break; if (sp > XB_SPIN_CAP) { atomicAdd(&bar[XB_TMO], 1u); break; } }
    }
    nloc = mine > 0u ? mine : 1u; nx = cnt > 0u ? cnt : 1u;
}

__device__ __forceinline__ void xcd_barrier(const XcdBarrier& b) {
    asm volatile("s_waitcnt vmcnt(0)" ::: "memory");
    __syncthreads();
    if (threadIdx.x == 0) {
        unsigned* bar = b.bar;
        __builtin_amdgcn_s_waitcnt(0);
        unsigned nloc = b.st[0], nx = b.st[1];
        if (nloc == 0u) { xcd_barrier_complete(bar, b.x, nloc, nx); b.st[0] = nloc; b.st[1] = nx; }
        const unsigned old = xb_add(&bar[XB_XSUB(b.x)], 1u);
        const unsigned gen = old / nloc;
        if (old + 1u == (gen + 1u) * nloc) {
            __builtin_amdgcn_fence(__ATOMIC_RELEASE, "agent");
            asm volatile("s_waitcnt vmcnt(0)" ::: "memory");
            const unsigned og = xb_add(&bar[XB_TOP], 1u);
            const unsigned tg = og / nx;
            if (og + 1u == (tg + 1u) * nx) xb_add(&bar[XB_TOPGEN], 1u);
            else XB_SPIN(xb_ld(&bar[XB_TOPGEN]) == tg, bar);
            __builtin_amdgcn_fence(__ATOMIC_ACQUIRE, "agent");
            xb_add(&bar[XB_XGEN(b.x)], 1u);
            asm volatile("s_waitcnt vmcnt(0)" ::: "memory");
        } else {
            XB_SPIN(xb_ld(&bar[XB_XGEN(b.x)]) == gen, bar);
            __builtin_amdgcn_fence(__ATOMIC_ACQUIRE, "agent");
            asm volatile("s_waitcnt vmcnt(0)" ::: "memory");
        }
    }
    __syncthreads();
}

__global__ void __launch_bounds__(NTHR) fwd_megakernel(Params p) {
  cg::grid_group grid = cg::this_grid();
  if (threadIdx.x == 0) *(uint4*)(smem + 147584) = make_uint4(0u, 0u, 0u, 0u);
  __syncthreads();
  XcdBarrier xb = xcd_barrier_post((unsigned*)(p.ws + OFF_BAR), (volatile LAS unsigned*)(smem + 147584));
  if (obid() == 0 && otid() < 64) ((int*)(p.ws + OFF_CNT))[otid()] = 0;
  p0_copy_x(p);
  p0_filters(p);
  p0_mod(p);
  __syncthreads();
  phase_wconv(p, 0, 0);
  bf16* hbuf = (bf16*)(p.ws + OFF_H);
  bf16* hmid = (bf16*)(p.ws + OFF_HMID);
  float* xw = (float*)(p.ws + OFF_X);
  float* Pw = (float*)(p.ws + OFF_P);
  for (int l = 0; l < DEPTH; ++l) {
    const float* modl = (const float*)(p.ws + OFF_MOD) + (size_t)l * 9 * 9216;
    const size_t wset = (size_t)(l & 1) * WSET;
    if (l == 0) grid.sync();
    phase_norm(p, p.in[I_F1N] + l * D, modl, 0, 1);
    xcd_barrier(xb);
    phase_gemm(hbuf, p.ws + OFF_W1I + wset, 5632, 1024, EpiSwiglu{(unsigned short*)hmid});
    xcd_barrier(xb);
    phase_gemm(hmid, p.ws + OFF_W1O + wset, 1024, 2816, EpiResid{xw, modl, 2, 0.5f});
    xcd_barrier(xb);
    phase_norm(p, p.in[I_MN] + l * D, modl, 3, 4);
    xcd_barrier(xb);
    phase_gemm(hbuf, p.ws + OFF_WMI + wset, INCP, 1024, EpiP{Pw});
    xcd_barrier(xb);
    prep_rwkv(p, l);
    prep_gla(p, l);
    prep_hyena(p, l);
    xcd_barrier(xb);
    phase_mixers(p, l, l);
    xcd_barrier(xb);
    phase_post(p, l);
    xcd_barrier(xb);
    phase_gemm(hbuf, p.ws + OFF_WMO + wset, 1024, 1024, EpiResid{xw, modl, 5, 1.0f});
    xcd_barrier(xb);
    phase_norm(p, p.in[I_F2N] + l * D, modl, 6, 7);
    xcd_barrier(xb);
    phase_gemm(hbuf, p.ws + OFF_W2I + wset, 5632, 1024, EpiSwiglu{(unsigned short*)hmid});
    xcd_barrier(xb);
    phase_gemm(hmid, p.ws + OFF_W2O + wset, 1024, 2816, EpiResid{xw, modl, 8, 0.5f});
    xcd_barrier(xb);
  }
  phase_final_norm(p);
}

extern "C" void kernel_launch(void* const* d_in, const int* in_sizes, int n_in, void* d_out, int out_size, void* d_ws,
                              size_t ws_size, hipStream_t stream) {
  static int grid_blocks = 0;
  if (!grid_blocks) {
    int dev = 0, cus = 0, per_cu = 0;
    (void)hipGetDevice(&dev);
    (void)hipDeviceGetAttribute(&cus, hipDeviceAttributeMultiprocessorCount, dev);
    (void)hipFuncSetAttribute((const void*)fwd_megakernel, hipFuncAttributeMaxDynamicSharedMemorySize, LDS_BYTES);
    (void)hipOccupancyMaxActiveBlocksPerMultiprocessor(&per_cu, fwd_megakernel, NTHR, LDS_BYTES);
    if (per_cu < 1) per_cu = 1;
    grid_blocks = cus * per_cu;
    if (grid_blocks > 256) grid_blocks = 256;
  }
  if (ws_size < WS_NEED) fprintf(stderr, "workspace too small: %zu < %zu\n", ws_size, (size_t)WS_NEED);
  (void)hipMemsetAsync((char*)d_ws + OFF_BAR, 0, 16384, stream);
  Params p{};
  for (int i = 0; i < 41; ++i) p.in[i] = (const float*)d_in[i];
  p.out = (float*)d_out;
  p.ws = (char*)d_ws;
  void* args[] = {&p};
  hipError_t e = hipLaunchCooperativeKernel((void*)fwd_megakernel, dim3(grid_blocks), dim3(NTHR), args, LDS_BYTES, stream);
  if (e != hipSuccess) fprintf(stderr, "cooperative launch failed: %s (grid %d)\n", hipGetErrorString(e), grid_blocks);
}
```

```cpp
#include <hip/hip_runtime.h>
#include <hip/hip_bf16.h>
#include <hip/hip_cooperative_groups.h>
#include <cstdio>
namespace cg = cooperative_groups;

typedef __hip_bfloat16 bf16;
typedef __attribute__((ext_vector_type(8))) short bf16x8;
typedef __attribute__((ext_vector_type(4))) float f32x4;
typedef __attribute__((ext_vector_type(2))) float f32x2;

constexpr int D = 1024, NTOK = 12288, NCTX = 4096, DEPTH = 4, FH = 2816;
constexpr int INC = 3264, INCP = 3328;
constexpr int C_HY = 1184, C_RW = 1952;
constexpr int NTHR = 512;

constexpr size_t al256(size_t x) { return (x + 255) & ~(size_t)255; }
constexpr size_t OFF_CNT = 0;
constexpr size_t OFF_BAR = 4096;
constexpr size_t OFF_MOD = 4096 + 16384;
constexpr size_t SZ_MOD = (size_t)DEPTH * 9 * 9216 * 4;
constexpr size_t OFF_FT = al256(OFF_MOD + SZ_MOD);
constexpr size_t FT_L0 = 511 * 256, FT_L1 = 2047 * 256;
constexpr size_t FT_LAYER = FT_L0 + FT_L1;
constexpr size_t OFF_X = al256(OFF_FT + DEPTH * FT_LAYER * 4);
constexpr size_t OFF_H = al256(OFF_X + (size_t)NTOK * D * 4);
constexpr size_t OFF_W1I = al256(OFF_H + (size_t)NTOK * D * 2);
constexpr size_t OFF_W1O = al256(OFF_W1I + (size_t)5632 * 1024 * 2);
constexpr size_t OFF_WMI = al256(OFF_W1O + (size_t)1024 * 2816 * 2);
constexpr size_t OFF_WMO = al256(OFF_WMI + (size_t)INCP * 1024 * 2);
constexpr size_t OFF_W2I = al256(OFF_WMO + (size_t)1024 * 1024 * 2);
constexpr size_t OFF_W2O = al256(OFF_W2I + (size_t)5632 * 1024 * 2);
constexpr size_t WSET = al256(OFF_W2O + (size_t)1024 * 2816 * 2) - OFF_W1I;
constexpr size_t OFF_P = OFF_W1I + 2 * WSET;
constexpr size_t SZ_P = (size_t)NTOK * INC * 4;
constexpr size_t SZ_GO = (size_t)2 * NTOK * 384 * 4;
constexpr size_t OFF_GO = OFF_P;
constexpr size_t OFF_RO = OFF_P + SZ_GO;
constexpr size_t OFF_REC = al256(OFF_P + SZ_P);
constexpr size_t SZ_REC = (size_t)NTOK * 6 * 512 * 4;
constexpr size_t OFF_HMID = OFF_REC;
constexpr size_t OFF_GREC = al256(OFF_REC + SZ_REC);
constexpr size_t SZ_GREC = (size_t)NTOK * 6 * 256 * 4;
constexpr size_t OFF_HYZ = al256(OFF_GREC + SZ_GREC);
constexpr size_t OFF_HYX = al256(OFF_HYZ + (size_t)NTOK * 256 * 4);
constexpr size_t OFF_HZB = al256(OFF_HYX + (size_t)NTOK * 256 * 4);
constexpr size_t OFF_FTB = al256(OFF_HZB + (size_t)NTOK * 256 * 2);
constexpr size_t WS_NEED = al256(OFF_FTB + DEPTH * FT_LAYER * 2);

struct Params {
  const float* in[41];
  float* out;
  char* ws;
};

enum { I_XP = 0, I_XS, I_SG, I_SR, I_C, I_CCTX, I_ADAW, I_ADAB, I_F1N, I_F1WI, I_F1WO, I_MN, I_MWI, I_MWO,
       I_GW2, I_GB, I_GN, I_HCW, I_HCB, I_HW1, I_HB1, I_HW2, I_HB2, I_HFQ, I_HW3, I_HBIAS,
       I_RMU, I_RW0, I_RW2, I_RA0, I_RA2, I_RG2, I_RKK, I_RKA, I_RRK, I_RLW, I_RLB, I_F2N, I_F2WI, I_F2WO, I_FN };

extern __shared__ __attribute__((aligned(16))) char smem[];
constexpr int LDS_BYTES = 147600;

__device__ __forceinline__ int otid() { int t = (int)__builtin_amdgcn_workitem_id_x(); asm volatile("" : "+v"(t)); return t; }
__device__ __forceinline__ int obid() { int b = (int)__builtin_amdgcn_workgroup_id_x(); asm volatile("" : "+s"(b)); return b; }
__device__ __forceinline__ unsigned short f2bf(float f) {
  unsigned u = __float_as_uint(f);
  u += 0x7fffu + ((u >> 16) & 1u);
  return (unsigned short)(u >> 16);
}
__device__ __forceinline__ float dpp_f(float x, const int ctrl_sel) {
  int xi = __float_as_int(x), r;
  if (ctrl_sel == 0) r = __builtin_amdgcn_update_dpp(0, xi, 0xB1, 0xF, 0xF, true);
  else if (ctrl_sel == 1) r = __builtin_amdgcn_update_dpp(0, xi, 0x4E, 0xF, 0xF, true);
  else if (ctrl_sel == 2) r = __builtin_amdgcn_update_dpp(0, xi, 0x141, 0xF, 0xF, true);
  else r = __builtin_amdgcn_update_dpp(0, xi, 0x140, 0xF, 0xF, true);
  return __int_as_float(r);
}
__device__ __forceinline__ float wave_sum(float v) {
  v += dpp_f(v, 0); v += dpp_f(v, 1); v += dpp_f(v, 2); v += dpp_f(v, 3);
  const int vi = __float_as_int(v);
  return __int_as_float(__builtin_amdgcn_readlane(vi, 0)) + __int_as_float(__builtin_amdgcn_readlane(vi, 16)) +
         __int_as_float(__builtin_amdgcn_readlane(vi, 32)) + __int_as_float(__builtin_amdgcn_readlane(vi, 48));
}
__device__ __forceinline__ float sigmoidf_(float x) { return __builtin_amdgcn_rcpf(1.f + __builtin_amdgcn_exp2f(x * -1.4426950408889634f)); }
__device__ __forceinline__ float siluf_(float x) { return x * sigmoidf_(x); }
__device__ __forceinline__ int modrow(int row) { return row < NCTX ? 0 : 1 + ((row - NCTX) >> 10); }

__device__ __forceinline__ void p0_copy_x(const Params& p) {
  float4* x = (float4*)(p.ws + OFF_X);
  const float4* a = (const float4*)p.in[I_XP];
  const float4* b = (const float4*)p.in[I_XS];
  const size_t n4 = (size_t)NTOK * D / 4, nc4 = (size_t)NCTX * D / 4;
  for (size_t i = (size_t)obid() * NTHR + otid(); i < n4; i += (size_t)gridDim.x * NTHR)
    x[i] = i < nc4 ? a[i] : b[i - nc4];
}

__device__ __forceinline__ void p0_mod(const Params& p) {
  float* scond = (float*)smem;
  float* red = (float*)(smem + 40960);
  for (int i = otid(); i < 9 * 1024; i += NTHR) {
    int r = i >> 10, d = i & 1023;
    float c = r == 0 ? p.in[I_CCTX][d] : p.in[I_C][(r - 1) * 1024 + d];
    scond[i] = siluf_(c);
  }
  __syncthreads();
  float* mod = (float*)(p.ws + OFF_MOD);
  const int col = otid() & 63, ks = otid() >> 6;
  for (int task = obid(); task < DEPTH * 144; task += gridDim.x) {
    int l = task / 144, cg_ = task % 144;
    const float* w = p.in[I_ADAW] + (size_t)l * 1024 * 9216 + cg_ * 64 + col;
    float acc[9];
#pragma unroll
    for (int r = 0; r < 9; ++r) acc[r] = 0.f;
    for (int d0 = ks * 128; d0 < ks * 128 + 128; d0 += 8) {
      float wv[8];
#pragma unroll
      for (int u = 0; u < 8; ++u) wv[u] = w[(size_t)(d0 + u) * 9216];
#pragma unroll
      for (int u = 0; u < 8; ++u)
#pragma unroll
        for (int r = 0; r < 9; ++r) acc[r] += scond[r * 1024 + d0 + u] * wv[u];
    }
#pragma unroll
    for (int r = 0; r < 9; ++r) red[(ks * 9 + r) * 64 + col] = acc[r];
    __syncthreads();
    for (int i = otid(); i < 576; i += NTHR) {
      int r = i >> 6, c = i & 63;
      float s = 0.f;
#pragma unroll
      for (int k = 0; k < 8; ++k) s += red[(k * 9 + r) * 64 + c];
      int j = cg_ * 64 + c;
      mod[((size_t)l * 9 + r) * 9216 + j] = s + p.in[I_ADAB][l * 9216 + j];
    }
    __syncthreads();
  }
}

__device__ __forceinline__ void p0_filters(const Params& p) {
  const int wave = otid() >> 6, lane = otid() & 63;
  float* FT = (float*)(p.ws + OFF_FT);
  for (int task = obid() * 8 + wave; task < DEPTH * 1280; task += gridDim.x * 8) {
    int l = task / 1280, rem = task % 1280;
    int sel = rem >= 256, i = sel ? rem - 256 : rem, L = sel ? 1024 : 256;
    float t = (float)i / (float)(L - 1);
    float w = 6.283185307179586f * (float)i / (float)L;
    float zval = 0.f;
    {
      const float fstep = (15.f - 1e-4f) / 15.f;
      if (lane == 0) zval = t;
      else if (lane <= 16) zval = cosf((1e-4f + (float)(lane - 1) * fstep) * w);
      else if (lane <= 32) zval = -sinf((1e-4f + (float)(lane - 17) * fstep) * w);
    }
    const float* w1 = p.in[I_HW1] + l * 33 * 64;
    const float* w2 = p.in[I_HW2] + l * 64 * 64;
    const float* w3 = p.in[I_HW3] + l * 64 * 512;
    const float* fq = p.in[I_HFQ] + l * 128;
    float h1 = p.in[I_HB1][l * 64 + lane];
    for (int e = 0; e < 33; ++e) h1 += __shfl(zval, e) * w1[e * 64 + lane];
    h1 = sinf(fq[lane] * h1);
    float h2 = p.in[I_HB2][l * 64 + lane];
    for (int e = 0; e < 64; ++e) h2 += __shfl(h1, e) * w2[e * 64 + lane];
    h2 = sinf(fq[64 + lane] * h2);
    float acc[8];
#pragma unroll
    for (int m = 0; m < 8; ++m) acc[m] = 0.f;
    for (int e = 0; e < 64; ++e) {
      float hv = __shfl(h2, e);
#pragma unroll
      for (int m = 0; m < 8; ++m) acc[m] += hv * w3[e * 512 + m * 64 + lane];
    }
    float* ft = FT + (size_t)l * FT_LAYER + (sel ? FT_L0 : 0);
    const float a0 = -3.0701134573253945f, a1 = -15.350567286626973f;
#pragma unroll
    for (int m = 0; m < 8; ++m) {
      int cp = m * 64 + lane, c = cp & 255;
      float delta = fabsf(a0 + (float)c * ((a1 - a0) / 255.f));
      float val = acc[m] * expf(-t * delta);
      unsigned short* ftb = (unsigned short*)(p.ws + OFF_FTB) + (size_t)l * FT_LAYER + (sel ? FT_L0 : 0);
      if (cp < 256) { ft[(size_t)(L - 1 + i) * 256 + c] = val; ftb[(size_t)(L - 1 + i) * 256 + c] = f2bf(val); }
      else if (i >= 1) { ft[(size_t)(L - 1 - i) * 256 + c] = val; ftb[(size_t)(L - 1 - i) * 256 + c] = f2bf(val); }
    }
  }
}

__device__ __forceinline__ void conv_tile(const float* src, int srcN, int k0, int srccol0, bool zero, bf16* dst, int dstK, int n0) {
  float* tile = (float*)smem;
  const int tid = otid();
  {
    int r = tid >> 4, c4 = (tid & 15) * 4;
#pragma unroll
    for (int rr = 0; rr < 2; ++rr) {
      int row = r + rr * 32;
      float4 v = zero ? make_float4(0.f, 0.f, 0.f, 0.f)
                      : *(const float4*)(src + (size_t)(k0 + row) * srcN + srccol0 + c4);
      tile[row * 65 + c4 + 0] = v.x; tile[row * 65 + c4 + 1] = v.y;
      tile[row * 65 + c4 + 2] = v.z; tile[row * 65 + c4 + 3] = v.w;
    }
  }
  __syncthreads();
  {
    int nn = tid >> 3, ks = (tid & 7) * 8;
    unsigned short v[8];
#pragma unroll
    for (int j = 0; j < 8; ++j) v[j] = f2bf(tile[(ks + j) * 65 + nn]);
    uint4 o;
    o.x = v[0] | ((unsigned)v[1] << 16); o.y = v[2] | ((unsigned)v[3] << 16);
    o.z = v[4] | ((unsigned)v[5] << 16); o.w = v[6] | ((unsigned)v[7] << 16);
    *(uint4*)(dst + (size_t)(n0 + nn) * dstK + k0 + ks) = o;
  }
  __syncthreads();
}

__device__ __forceinline__ unsigned cvt_pk_bf16_(float lo, float hi) { unsigned r; asm volatile("v_cvt_pk_bf16_f32 %0, %1, %2" : "=v"(r) : "v"(lo), "v"(hi)); return r; }
struct WTile { const float* src; int srcN, k0, srccol, dstK, n0; bool zero; size_t dstoff; };
__device__ __forceinline__ WTile wtile_decode(const Params& p, int l, int u) {
  WTile w;
  w.zero = false;
  if (u < 1408 || (u >= 3200 && u < 4608)) {
    const bool second = u >= 3200;
    if (second) u -= 3200;
    w.src = p.in[second ? I_F2WI : I_F1WI] + (size_t)l * 1024 * 5632;
    w.dstoff = second ? OFF_W2I : OFF_W1I;
    const int tn = u % 88, tk = u / 88;
    const int n0 = tn * 64, pn = n0 >> 8, within = n0 & 255;
    w.srccol = within < 128 ? pn * 128 + within : 2816 + pn * 128 + (within - 128);
    w.srcN = 5632; w.k0 = tk * 64; w.dstK = 1024; w.n0 = n0;
  } else if ((u >= 1408 && u < 2112) || u >= 4608) {
    const bool second = u >= 4608;
    u -= second ? 4608 : 1408;
    w.src = p.in[second ? I_F2WO : I_F1WO] + (size_t)l * 2816 * 1024;
    w.dstoff = second ? OFF_W2O : OFF_W1O;
    const int tn = u % 16, tk = u / 16;
    w.srcN = 1024; w.k0 = tk * 64; w.srccol = tn * 64; w.dstK = 2816; w.n0 = tn * 64;
  } else if (u < 2944) {
    u -= 2112;
    w.src = p.in[I_MWI] + (size_t)l * 1024 * INC;
    w.dstoff = OFF_WMI;
    const int tn = u % 52, tk = u / 52;
    w.srcN = INC; w.k0 = tk * 64; w.srccol = tn * 64; w.dstK = 1024; w.n0 = tn * 64; w.zero = tn == 51;
  } else {
    u -= 2944;
    w.src = p.in[I_MWO] + (size_t)l * 1024 * 1024;
    w.dstoff = OFF_WMO;
    const int tn = u % 16, tk = u / 16;
    w.srcN = 1024; w.k0 = tk * 64; w.srccol = tn * 64; w.dstK = 1024; w.n0 = tn * 64;
  }
  return w;
}
__device__ __forceinline__ void phase_wconv(const Params& p, int l, int set) {
  for (int t = obid(); t < 5312; t += gridDim.x) {
    const WTile w = wtile_decode(p, l, t);
    conv_tile(w.src, w.srcN, w.k0, w.srccol, w.zero, (bf16*)(p.ws + w.dstoff + (size_t)set * WSET), w.dstK, w.n0);
  }
}
__device__ __forceinline__ void wconv_wave(const Params& p, int l, int set, int u) {
  const int lane = otid() & 63;
  const WTile w = wtile_decode(p, l, u);
  unsigned pk[32];
  if (!w.zero) {
    const float* s = w.src + (size_t)w.k0 * w.srcN + w.srccol + lane;
#pragma unroll
    for (int kk = 0; kk < 64; kk += 2) pk[kk >> 1] = cvt_pk_bf16_(s[(size_t)kk * w.srcN], s[(size_t)(kk + 1) * w.srcN]);
  } else {
#pragma unroll
    for (int i = 0; i < 32; ++i) pk[i] = 0u;
  }
  uint4* d = (uint4*)((unsigned short*)(p.ws + w.dstoff + (size_t)set * WSET) + (size_t)(w.n0 + lane) * w.dstK + w.k0);
#pragma unroll
  for (int i = 0; i < 8; ++i) d[i] = make_uint4(pk[4 * i], pk[4 * i + 1], pk[4 * i + 2], pk[4 * i + 3]);
}

__device__ __forceinline__ void phase_norm(const Params& p, const float* gain, const float* modl, int shi, int sci) {
  const int wave = otid() >> 6, lane = otid() & 63;
  const float* x = (const float*)(p.ws + OFF_X);
  bf16* h = (bf16*)(p.ws + OFF_H);
  const int nw = gridDim.x * 8;
  float4 g4[4];
#pragma unroll
  for (int i = 0; i < 4; ++i) g4[i] = ((const float4*)gain)[i * 64 + lane];
  for (int row0 = obid() * 8 + wave; row0 < NTOK; row0 += 2 * nw) {
    float4 v[2][4], sc[2][4], sh[2][4];
    int rows[2];
#pragma unroll
    for (int q = 0; q < 2; ++q) {
      const int row = (row0 + q * nw < NTOK) ? row0 + q * nw : row0;
      rows[q] = row;
      const float4* xr = (const float4*)(x + (size_t)row * D);
      const float* mr = modl + (size_t)modrow(row) * 9216;
#pragma unroll
      for (int i = 0; i < 4; ++i) {
        v[q][i] = xr[i * 64 + lane];
        sc[q][i] = ((const float4*)(mr + sci * 1024))[i * 64 + lane];
        sh[q][i] = ((const float4*)(mr + shi * 1024))[i * 64 + lane];
      }
    }
    __builtin_amdgcn_sched_barrier(0);
#pragma unroll
    for (int q = 0; q < 2; ++q) {
      if (q == 1 && row0 + nw >= NTOK) break;
      float ss = 0.f;
#pragma unroll
      for (int i = 0; i < 4; ++i) ss += v[q][i].x * v[q][i].x + v[q][i].y * v[q][i].y + v[q][i].z * v[q][i].z + v[q][i].w * v[q][i].w;
      ss = wave_sum(ss);
      const float rstd = rsqrtf(ss * (1.f / 1024.f) + 1e-6f);
#pragma unroll
      for (int i = 0; i < 4; ++i) {
        const float4 g = g4[i], s = sc[q][i], bq = sh[q][i];
        float y0 = v[q][i].x * rstd * g.x * (1.f + s.x) + bq.x;
        float y1 = v[q][i].y * rstd * g.y * (1.f + s.y) + bq.y;
        float y2 = v[q][i].z * rstd * g.z * (1.f + s.z) + bq.z;
        float y3 = v[q][i].w * rstd * g.w * (1.f + s.w) + bq.w;
        uint2 o;
        o.x = f2bf(y0) | ((unsigned)f2bf(y1) << 16);
        o.y = f2bf(y2) | ((unsigned)f2bf(y3) << 16);
        *(uint2*)(h + (size_t)rows[q] * D + (i * 64 + lane) * 4) = o;
      }
    }
  }
}

__device__ __forceinline__ void phase_final_norm(const Params& p) {
  const int wave = otid() >> 6, lane = otid() & 63;
  const float* x = (const float*)(p.ws + OFF_X);
  const float4* g4 = (const float4*)p.in[I_FN];
  for (int row = obid() * 8 + wave; row < NTOK; row += gridDim.x * 8) {
    const float4* xr = (const float4*)(x + (size_t)row * D);
    float4 v[4];
    float ss = 0.f;
#pragma unroll
    for (int i = 0; i < 4; ++i) {
      v[i] = xr[i * 64 + lane];
      ss += v[i].x * v[i].x + v[i].y * v[i].y + v[i].z * v[i].z + v[i].w * v[i].w;
    }
    ss = wave_sum(ss);
    float rstd = rsqrtf(ss * (1.f / 1024.f) + 1e-6f);
    float4* o = (float4*)(p.out + (size_t)row * D);
#pragma unroll
    for (int i = 0; i < 4; ++i) {
      float4 g = g4[i * 64 + lane];
      o[i * 64 + lane] = make_float4(v[i].x * rstd * g.x, v[i].y * rstd * g.y, v[i].z * rstd * g.z, v[i].w * rstd * g.w);
    }
  }
}

namespace pg8 {
#define PG8_LAS __attribute__((address_space(3)))
typedef unsigned short bf16_t;
typedef short bf16x8 __attribute__((ext_vector_type(8)));
typedef float f32x4 __attribute__((ext_vector_type(4)));
typedef unsigned u32x4 __attribute__((ext_vector_type(4)));
constexpr int BM = 256, BK = 64, HALF = 128, HTB = HALF * BK * 2  , STAGE_BYTES = 8 * HTB, NXCD = 8, WGM = 8;

__host__ __device__ __forceinline__ int lds_byte(int r, int c) { const int st = (r >> 4) * 2 + (c >> 5), rr = r & 15, cc = c & 31, ob = rr * 64 + cc * 2; return st * 1024 + (ob ^ (((ob >> 9) & 1) << 5)); }
__host__ __device__ __forceinline__ void stage_rc(int b, int& R, int& C) { const int st = b / 1024, sb = b % 1024, swz = sb ^ (((sb >> 9) & 1) << 5); R = (st >> 1) * 16 + swz / 64; C = (st & 1) * 32 + (swz % 64) / 2; }
__host__ __device__ __forceinline__ int perm32(int rho) { const int n = rho >> 4, i = rho & 15; return 8 * (i >> 2) + 4 * n + (i & 3); }

struct Unit { int pm, pn; };
struct Gemm { const bf16_t* A; const bf16_t* Bt; int M, N, K; };

struct StaticOrder {
    int nM, nN, nwg, G, c;
    __host__ __device__ void init(int M, int N, int G_, int c_) { nM = M / BM; nN = N / BM; nwg = nM * nN; G = G_; c = c_; }
    __host__ __device__ bool next(int i, Unit& u) const {
        const long L = (long)i * G + c; if (L >= nwg) return false;
        int wgid = (int)L; { const int q = nwg / NXCD, r = nwg % NXCD, xcd = wgid % NXCD, off = wgid / NXCD; wgid = (xcd < r ? xcd * (q + 1) : r * (q + 1) + (xcd - r) * q) + off; }
        const int nig = WGM * nN, gid = wgid / nig, fm = gid * WGM, gsz = (nM - fm) < WGM ? (nM - fm) : WGM;
        u.pm = fm + ((wgid % nig) % gsz); u.pn = (wgid % nig) / gsz; return true;
    }
    __device__ __forceinline__ void a_ready(const Unit&) const {}
    __device__ __forceinline__ void done(const Unit&) const {}
};
__device__ __forceinline__ unsigned cvt_pk_bf16(float lo, float hi) { unsigned r; asm volatile("v_cvt_pk_bf16_f32 %0, %1, %2" : "=v"(r) : "v"(lo), "v"(hi)); return r; }

template <class Epi, class Sched, bool STAMP = false>
__device__ __forceinline__ void gemm_phase(PG8_LAS unsigned char* lds, const Gemm g, const Sched& S, const Epi& E, unsigned long long* stamps) {
    const int tid = otid(), wid = __builtin_amdgcn_readfirstlane(tid >> 6), lane = tid & 63, wr = wid >> 2, wc = wid & 3, fr = lane & 15, fq = lane >> 4;
    const int K = g.K, nt = K / BK;
    int ts_lo = 0, ts_hi = 0, nts = 0; const unsigned long long rt_entry = STAMP ? (unsigned long long)wall_clock64() : 0ull;
#define PG8_STAMP() do { if (STAMP && wid == 0 && nts < 64) { const unsigned long long _c = (unsigned long long)clock64(); \
        ts_lo = (lane == nts) ? (int)(unsigned)_c : ts_lo; ts_hi = (lane == nts) ? (int)(unsigned)(_c >> 32) : ts_hi; ++nts; } } while (0)
    PG8_STAMP();
    unsigned voffA[2], voffB[2];
#pragma unroll
    for (int i = 0; i < 2; ++i) { int R, C; stage_rc(tid * 16 + i * 8192, R, C); const int Rb = Epi::PERM ? ((R & ~31) + perm32(R & 31)) : R;
        voffA[i] = (unsigned)(R * K + C) * 2u; voffB[i] = (unsigned)(Rb * K + C) * 2u; }
    const size_t kstep = (size_t)(BK * 2);
    const size_t hstep = (size_t)HALF * K * 2;
    const size_t tstep = 2 * hstep;
    const unsigned ldsw = (unsigned)wid * 1024u;
    const int aoff = lds_byte(wr * 64 + fr, fq * 8), boff = lds_byte(wc * 32 + fr, fq * 8);
#define PG8_SA(b, h) (((b) * 2 + (h)) * HTB)
#define PG8_SB(b, h) ((4 + (b) * 2 + (h)) * HTB)
#define PG8_STAGE(bufoff, gbase, voff) do { _Pragma("unroll") for (int _i = 0; _i < 2; ++_i) \
        __builtin_amdgcn_global_load_lds((const unsigned*)((const char*)(gbase) + (voff)[_i]), (PG8_LAS unsigned*)(lds + (bufoff) + ldsw + _i * 8192), 16, 0, 0); } while (0)
#define PG8_LDA(dst, b, h) do { _Pragma("unroll") for (int m = 0; m < 4; ++m) _Pragma("unroll") for (int k = 0; k < 2; ++k) dst[m][k] = *(const PG8_LAS bf16x8*)(lds + PG8_SA(b, h) + aoff + m * 2048 + k * 1024); } while (0)
#define PG8_LDB(dst, b, h) do { _Pragma("unroll") for (int n = 0; n < 2; ++n) _Pragma("unroll") for (int k = 0; k < 2; ++k) dst[n][k] = *(const PG8_LAS bf16x8*)(lds + PG8_SB(b, h) + boff + n * 2048 + k * 1024); } while (0)
#define PG8_MMA(ai, bj, At, Bt) do { __builtin_amdgcn_s_setprio(1); _Pragma("unroll") for (int m = 0; m < 4; ++m) _Pragma("unroll") for (int n = 0; n < 2; ++n) _Pragma("unroll") for (int k = 0; k < 2; ++k) \
        acc[ai][bj][m][n] = __builtin_amdgcn_mfma_f32_16x16x32_bf16(Bt[n][k], At[m][k], acc[ai][bj][m][n], 0, 0, 0); __builtin_amdgcn_s_setprio(0); } while (0)
#define PG8_WAIT_V(n) asm volatile("s_waitcnt vmcnt(" #n ")" ::: "memory")
#define PG8_WAIT_L(n) asm volatile("s_waitcnt lgkmcnt(" #n ")" ::: "memory")
#define PG8_BAR __builtin_amdgcn_s_barrier()
#define PG8_SCHED __builtin_amdgcn_sched_barrier(0)
    Unit cur, nxt; int ui = 0;
    if (!S.next(0, cur)) return;
    f32x4 acc[2][2][4][2];
#pragma unroll
    for (int a = 0; a < 2; ++a)
#pragma unroll
        for (int b = 0; b < 2; ++b)
#pragma unroll
            for (int m = 0; m < 4; ++m)
#pragma unroll
                for (int n = 0; n < 2; ++n) acc[a][b][m][n] = (f32x4){0.f, 0.f, 0.f, 0.f};
    bf16x8 At[4][2], B0[2][2], B1[2][2];
    const char* cA = (const char*)g.A + (size_t)cur.pm * tstep; const char* cB = (const char*)g.Bt + (size_t)cur.pn * tstep;
    S.a_ready(cur);
    PG8_STAGE(PG8_SB(0, 0), cB, voffB); PG8_STAGE(PG8_SA(0, 0), cA, voffA); PG8_STAGE(PG8_SB(0, 1), cB + hstep, voffB); PG8_STAGE(PG8_SA(0, 1), cA + hstep, voffA);
    if (wr == 1) PG8_BAR;
    PG8_WAIT_V(4); PG8_BAR;
    PG8_STAGE(PG8_SB(1, 0), cB + kstep, voffB); PG8_STAGE(PG8_SA(1, 0), cA + kstep, voffA); PG8_STAGE(PG8_SB(1, 1), cB + hstep + kstep, voffB);
    PG8_WAIT_V(6); PG8_BAR;
    PG8_STAMP();
    for (;;) {
        const bool has_next = S.next(ui + 1, nxt);
        const char* nA = has_next ? (const char*)g.A + (size_t)nxt.pm * tstep : cA; const char* nB = has_next ? (const char*)g.Bt + (size_t)nxt.pn * tstep : cB;
        for (int t = 0; t < nt; t += 2) {
            const bool last = (t == nt - 2);
            const char* a1 = cA + (size_t)(t + 1) * kstep;
            const char* a2 = last ? nA : cA + (size_t)(t + 2) * kstep; const char* b2 = last ? nB : cB + (size_t)(t + 2) * kstep;
            const char* a3 = a2 + kstep; const char* b3 = b2 + kstep;
            if (last && has_next) S.a_ready(nxt);
            PG8_LDB(B0, 0, 0); PG8_SCHED; PG8_LDA(At, 0, 0); PG8_STAGE(PG8_SA(1, 1), a1 + hstep, voffA);
            PG8_WAIT_L(8); PG8_BAR; PG8_WAIT_L(0); PG8_MMA(0, 0, At, B0); PG8_BAR; PG8_SCHED;
            PG8_LDB(B1, 0, 1); PG8_STAGE(PG8_SB(0, 0), b2, voffB);
            PG8_BAR; PG8_WAIT_L(0); PG8_MMA(0, 1, At, B1); PG8_BAR;
            PG8_LDA(At, 0, 1); PG8_STAGE(PG8_SA(0, 0), a2, voffA);
            PG8_BAR; PG8_WAIT_L(0); PG8_MMA(1, 0, At, B0); PG8_BAR; PG8_SCHED;
            PG8_STAGE(PG8_SB(0, 1), b2 + hstep, voffB);
            PG8_WAIT_V(6); PG8_BAR; PG8_MMA(1, 1, At, B1); PG8_BAR;
            PG8_LDB(B0, 1, 0); PG8_SCHED; PG8_LDA(At, 1, 0); PG8_STAGE(PG8_SA(0, 1), a2 + hstep, voffA);
            PG8_WAIT_L(8); PG8_BAR; PG8_WAIT_L(0); PG8_MMA(0, 0, At, B0); PG8_BAR; PG8_SCHED;
            PG8_LDB(B1, 1, 1); PG8_STAGE(PG8_SB(1, 0), b3, voffB);
            PG8_BAR; PG8_WAIT_L(0); PG8_MMA(0, 1, At, B1); PG8_BAR;
            PG8_LDA(At, 1, 1); PG8_STAGE(PG8_SA(1, 0), a3, voffA);
            PG8_BAR; PG8_WAIT_L(0); PG8_MMA(1, 0, At, B0); PG8_BAR; PG8_SCHED;
            PG8_STAGE(PG8_SB(1, 1), b3 + hstep, voffB);
            PG8_WAIT_V(6); PG8_BAR; PG8_MMA(1, 1, At, B1); PG8_BAR;
        }
        PG8_STAMP();
        if constexpr (!Epi::AFTER_DRAIN) { E(acc, cur, wr, wc, fr, fq); S.done(cur); }
        PG8_STAMP();
        if (!has_next) break;
#pragma unroll
        for (int a = 0; a < 2; ++a)
#pragma unroll
            for (int b = 0; b < 2; ++b)
#pragma unroll
                for (int m = 0; m < 4; ++m)
#pragma unroll
                    for (int n = 0; n < 2; ++n) acc[a][b][m][n] = (f32x4){0.f, 0.f, 0.f, 0.f};
        cur = nxt; cA = nA; cB = nB; ++ui;
    }
    PG8_WAIT_V(0);
    if (wr == 0) PG8_BAR;
    PG8_BAR;
    if constexpr (Epi::AFTER_DRAIN) { E.fused(acc, cur, wr, wc, fr, fq, lds, wid, lane); S.done(cur); }
    PG8_STAMP();
    if (STAMP && wid == 0) { stamps[lane] = lane < nts ? (((unsigned long long)(unsigned)ts_hi << 32) | (unsigned)ts_lo) : 0ull;
        if (lane == 62) stamps[62] = rt_entry; if (lane == 63) stamps[63] = (unsigned long long)wall_clock64(); }
#undef PG8_STAMP
#undef PG8_SA
#undef PG8_SB
#undef PG8_STAGE
#undef PG8_LDA
#undef PG8_LDB
#undef PG8_MMA
#undef PG8_WAIT_V
#undef PG8_WAIT_L
#undef PG8_BAR
#undef PG8_SCHED
}
}

struct EpiSwiglu {
  static constexpr bool PERM = true, AFTER_DRAIN = false;
  unsigned short* H;
  __device__ __forceinline__ void operator()(const pg8::f32x4 (&acc)[2][2][4][2], const pg8::Unit& u, int wr, int wc, int fr, int fq) const {
    const int row0 = u.pm * 256 + wr * 64 + fr, hc0 = u.pn * 128 + wc * 32 + 8 * fq;
#pragma unroll
    for (int ai = 0; ai < 2; ++ai)
#pragma unroll
      for (int m = 0; m < 4; ++m) {
        unsigned short* rowp = H + (size_t)(row0 + ai * 128 + m * 16) * FH + hc0;
        float v[8];
#pragma unroll
        for (int n = 0; n < 2; ++n)
#pragma unroll
          for (int i = 0; i < 4; ++i) v[n * 4 + i] = siluf_(acc[ai][0][m][n][i]) * acc[ai][1][m][n][i];
        pg8::u32x4 o;
        o[0] = pg8::cvt_pk_bf16(v[0], v[1]); o[1] = pg8::cvt_pk_bf16(v[2], v[3]);
        o[2] = pg8::cvt_pk_bf16(v[4], v[5]); o[3] = pg8::cvt_pk_bf16(v[6], v[7]);
        *(pg8::u32x4*)rowp = o;
      }
  }
};
struct EpiResid {
  static constexpr bool PERM = false, AFTER_DRAIN = false;
  float* X; const float* modl; int gidx; float scale;
  __device__ __forceinline__ void operator()(const pg8::f32x4 (&acc)[2][2][4][2], const pg8::Unit& u, int wr, int wc, int fr, int fq) const {
    const int row0 = u.pm * 256 + wr * 64 + fr, col0 = u.pn * 256 + wc * 32 + 4 * fq;
#pragma unroll
    for (int ai = 0; ai < 2; ++ai)
#pragma unroll
      for (int m = 0; m < 4; ++m) {
        const int row = row0 + ai * 128 + m * 16;
        const float* gt = modl + (size_t)modrow(row) * 9216 + gidx * 1024 + col0;
        float* xp = X + (size_t)row * D + col0;
#pragma unroll
        for (int bj = 0; bj < 2; ++bj)
#pragma unroll
          for (int n = 0; n < 2; ++n) {
            pg8::f32x4 g = *(const pg8::f32x4*)(gt + bj * 128 + n * 16);
            pg8::f32x4* q = (pg8::f32x4*)(xp + bj * 128 + n * 16);
            *q = *q + (g * scale) * acc[ai][bj][m][n];
          }
      }
  }
};
struct EpiP {
  static constexpr bool PERM = false, AFTER_DRAIN = false;
  float* P;
  __device__ __forceinline__ void operator()(const pg8::f32x4 (&acc)[2][2][4][2], const pg8::Unit& u, int wr, int wc, int fr, int fq) const {
    const int row0 = u.pm * 256 + wr * 64 + fr, col0 = u.pn * 256 + wc * 32 + 4 * fq;
#pragma unroll
    for (int ai = 0; ai < 2; ++ai)
#pragma unroll
      for (int m = 0; m < 4; ++m) {
        float* rp = P + (size_t)(row0 + ai * 128 + m * 16) * INC;
#pragma unroll
        for (int bj = 0; bj < 2; ++bj)
#pragma unroll
          for (int n = 0; n < 2; ++n) {
            const int col = col0 + bj * 128 + n * 16;
            if (col < INC) *(pg8::f32x4*)(rp + col) = acc[ai][bj][m][n];
          }
      }
  }
};

template <class Epi>
__device__ __forceinline__ void phase_gemm(const void* A, const void* Bt, int N, int K, const Epi& E) {
  pg8::Gemm g; g.A = (const pg8::bf16_t*)A; g.Bt = (const pg8::bf16_t*)Bt; g.M = NTOK; g.N = N; g.K = K;
  int c_ = obid(), G_ = (int)gridDim.x;
  asm volatile("" : "+s"(c_), "+s"(G_));
  pg8::StaticOrder S; S.init(NTOK, N, G_, c_);
  pg8::gemm_phase<Epi, pg8::StaticOrder, false>((PG8_LAS unsigned char*)smem, g, S, E, nullptr);
  __syncthreads();
}

__device__ __forceinline__ int scan2tok(int R) {
  if (R < NCTX) return R;
  int q = R - NCTX, b = q >> 10, n = q & 1023;
  return NCTX + b * 1024 + (n & 15) * 64 + (n >> 4);
}

__device__ __forceinline__ float rw_shift(const float* P, int R, int n, int L, int c, float mu) {
  float pc = P[(size_t)scan2tok(R) * INC + C_RW + c];
  float pp = n > 0 ? P[(size_t)scan2tok(R - 1) * INC + C_RW + c] : 0.f;
  float pn = n < L - 1 ? P[(size_t)scan2tok(R + 1) * INC + C_RW + c] : 0.f;
  return pc + (0.5f * (pp + pn) - pc) * mu;
}

__device__ __forceinline__ float rdlane(float v, int l) { return __int_as_float(__builtin_amdgcn_readlane(__float_as_int(v), l)); }

__device__ __forceinline__ void prep_rwkv(const Params& p, int l) {
  const int wave = otid() >> 6, lane = otid() & 63;
  const float* P = (const float*)(p.ws + OFF_P);
  float* rec = (float*)(p.ws + OFF_REC);
  const float* mu = p.in[I_RMU] + l * 1312;
  const float* w0 = p.in[I_RW0] + l * 768;
  const float* w2 = p.in[I_RW2] + (size_t)l * 64 * 384;
  const float* a0 = p.in[I_RA0] + l * 384;
  const float* a2 = p.in[I_RA2] + (size_t)l * 32 * 384;
  const float* g2 = p.in[I_RG2] + (size_t)l * 64 * 384;
  const float* kkw = p.in[I_RKK] + l * 384;
  const float* kaw = p.in[I_RKA] + l * 384;
  float* wl = (float*)smem;
#pragma unroll 1
  for (int hp = 0; hp < 2; ++hp) {
    const int hb = hp * 3;
    __syncthreads();
    for (int i = otid(); i < 160 * 48; i += NTHR) {
      const int r = i / 48, c4 = (i % 48) * 4;
      const float* src = (r < 64 ? w2 + r * 384 : (r < 96 ? a2 + (r - 64) * 384 : g2 + (r - 96) * 384)) + hb * 64 + c4;
      *(float4*)(wl + r * 192 + c4) = *(const float4*)src;
    }
    __syncthreads();
    for (int task = obid() * 8 + wave; task < NTOK / 6; task += gridDim.x * 8) {
      const int R0 = task * 6;
      int nn[6], LL[6];
#pragma unroll
      for (int tp = 0; tp < 6; ++tp) {
        const int R = R0 + tp;
        if (R < NCTX) { nn[tp] = R & 255; LL[tp] = 256; } else { nn[tp] = (R - NCTX) & 1023; LL[tp] = 1024; }
      }
      float x0[6], x1[6], x2[6];
#pragma unroll
      for (int tp = 0; tp < 6; ++tp) {
        x0[tp] = rw_shift(P, R0 + tp, nn[tp], LL[tp], 1152 + lane, mu[1152 + lane]);
        x1[tp] = rw_shift(P, R0 + tp, nn[tp], LL[tp], 1216 + lane, mu[1216 + lane]);
        const int c2 = 1280 + (lane & 31);
        x2[tp] = rw_shift(P, R0 + tp, nn[tp], LL[tp], c2, mu[c2]);
        if (tp & 1) __builtin_amdgcn_sched_barrier(0);
      }
      float kx[3][6];
#pragma unroll
      for (int h = 0; h < 3; ++h) {
        const int c = (hb + h) * 64 + lane;
#pragma unroll
        for (int tp = 0; tp < 6; ++tp) {
          kx[h][tp] = rw_shift(P, R0 + tp, nn[tp], LL[tp], 384 + c, mu[384 + c]);
        }
      }
#pragma unroll
      for (int tp = 0; tp < 6; ++tp) {
        x0[tp] = tanhf(x0[tp]);
        x1[tp] = lane < 32 ? x1[tp] : sigmoidf_(x1[tp]);
        x2[tp] = sigmoidf_(x2[tp]);
      }
      float af[3][6], ab[3][6], aa[3][6], ag[3][6];
#pragma unroll
      for (int h = 0; h < 3; ++h)
#pragma unroll
        for (int tp = 0; tp < 6; ++tp) { af[h][tp] = 0.f; ab[h][tp] = 0.f; aa[h][tp] = 0.f; ag[h][tp] = 0.f; }
      const float* wlp = wl + lane;
      for (int j = 0; j < 32; ++j) {
        float wc[15];
#pragma unroll
        for (int h = 0; h < 3; ++h) {
          wc[h] = wlp[j * 192 + h * 64]; wc[3 + h] = wlp[(32 + j) * 192 + h * 64];
          wc[6 + h] = wlp[(64 + j) * 192 + h * 64]; wc[9 + h] = wlp[(96 + j) * 192 + h * 64]; wc[12 + h] = wlp[(128 + j) * 192 + h * 64];
        }
#pragma unroll
        for (int tp = 0; tp < 6; ++tp) {
          const float sf = rdlane(x0[tp], j), sb = rdlane(x0[tp], 32 + j), sA = rdlane(x1[tp], j), sg = rdlane(x1[tp], 32 + j), sh = rdlane(x2[tp], j);
#pragma unroll
          for (int h = 0; h < 3; ++h) {
            af[h][tp] += sf * wc[h]; ab[h][tp] += sb * wc[3 + h]; aa[h][tp] += sA * wc[6 + h];
            ag[h][tp] += sg * wc[9 + h]; ag[h][tp] += sh * wc[12 + h];
          }
        }
      }
      int R0e = R0;
      asm volatile("" : "+v"(R0e));
#pragma unroll
      for (int h = 0; h < 3; ++h) {
        const int c = (hb + h) * 64 + lane;
#pragma unroll
        for (int tp = 0; tp < 6; ++tp) {
          const int R = R0e + tp;
          const float kxv = kx[h][tp];
          const float aav = aa[h][tp], afv = af[h][tp], abv = ab[h][tp], agv = ag[h][tp];
          float a = sigmoidf_(a0[c] + aav);
          float kk = kxv * kkw[c];
          float ss = wave_sum(kk * kk);
          kk = kk * rsqrtf(fmaxf(ss, 1e-24f));
          float k2 = kxv * (1.f + (a - 1.f) * kaw[c]);
          float uf = w0[c] + afv, ub = w0[384 + c] + abv;
          float df = expf(-0.6065306597126334f * sigmoidf_(uf));
          float db = expf(-0.6065306597126334f * sigmoidf_(ub));
          const float r_ = rw_shift(P, R, nn[tp], LL[tp], c, mu[c]);
          const float v_ = rw_shift(P, R, nn[tp], LL[tp], 768 + c, mu[768 + c]);
          float* o = rec + ((size_t)R * 6 + hb + h) * 512 + lane;
          o[0] = r_; o[128] = v_;
          o[64] = k2; o[192] = -kk; o[256] = kk * a; o[320] = df; o[384] = db; o[448] = agv;
        }
      }
    }
  }
  __syncthreads();
}

__device__ __forceinline__ float logsigmoidf_(float x) { return fminf(x, 0.f) - log1pf(expf(-fabsf(x))); }

__device__ __forceinline__ void prep_gla(const Params& p, int l) {
  const int wave = otid() >> 6, lane = otid() & 63;
  const float* P = (const float*)(p.ws + OFF_P);
  float* grec = (float*)(p.ws + OFF_GREC);
  const float* w2 = p.in[I_GW2] + (size_t)l * 2 * 16 * 192;
  const float* ab = p.in[I_GB] + l * 384;
  const int z = lane >> 5, d = lane & 31;
  float wreg[6][16], breg[6];
#pragma unroll
  for (int h = 0; h < 6; ++h) {
    breg[h] = ab[z * 192 + h * 32 + d];
#pragma unroll
    for (int r = 0; r < 16; ++r) wreg[h][r] = w2[(z * 16 + r) * 192 + h * 32 + d];
  }
  for (int tok = obid() * 8 + wave; tok < NTOK; tok += gridDim.x * 8) {
    const float* pr = P + (size_t)tok * INC;
    float lr[16];
#pragma unroll
    for (int r4 = 0; r4 < 4; ++r4) {
      float4 v = *(const float4*)(pr + 1152 + z * 16 + r4 * 4);
      lr[r4 * 4 + 0] = v.x; lr[r4 * 4 + 1] = v.y; lr[r4 * 4 + 2] = v.z; lr[r4 * 4 + 3] = v.w;
    }
    float qk[6], vv[6], gg[6];
#pragma unroll
    for (int h = 0; h < 6; ++h) {
      qk[h] = lane < 32 ? pr[h * 32 + lane] : pr[192 + h * 32 + (lane - 32)];
      vv[h] = pr[384 + h * 64 + lane];
      gg[h] = pr[768 + h * 64 + lane];
    }
#pragma unroll
    for (int h = 0; h < 6; ++h) {
      float acc = breg[h];
#pragma unroll
      for (int r = 0; r < 16; ++r) acc += lr[r] * wreg[h][r];
      float alpha = expf(logsigmoidf_(acc) * (1.f / 16.f));
      float* o = grec + ((size_t)tok * 6 + h) * 256 + lane;
      o[0] = lane < 32 ? qk[h] * 0.17677669529663687f : qk[h];
      o[64] = alpha; o[128] = vv[h]; o[192] = gg[h];
    }
  }
}

__device__ __forceinline__ void prep_hyena(const Params& p, int l) {
  const float* P = (const float*)(p.ws + OFF_P);
  float* hz = (float*)(p.ws + OFF_HYZ);
  float* hx = (float*)(p.ws + OFF_HYX);
  const float* cw = p.in[I_HCW] + l * 3 * 768;
  const float* cb = p.in[I_HCB] + l * 768;
  const int c = otid() & 255, rsub = otid() >> 8;
  float w_[3][3], b_[3];
#pragma unroll
  for (int s = 0; s < 3; ++s) { b_[s] = cb[s * 256 + c]; for (int t = 0; t < 3; ++t) w_[s][t] = cw[t * 768 + s * 256 + c]; }
  for (int r0 = obid() * 8; r0 < NTOK; r0 += gridDim.x * 8) {
    float pv[4][3][3];
    int rows[4];
#pragma unroll
    for (int q = 0; q < 4; ++q) {
      const int row = r0 + q * 2 + rsub;
      rows[q] = row;
      int t, L;
      if (row < NCTX) { t = row & 255; L = 256; } else { t = (row - NCTX) & 1023; L = 1024; }
      const float* pc = P + (size_t)row * INC + C_HY + c;
#pragma unroll
      for (int s = 0; s < 3; ++s) {
        pv[q][s][1] = pc[s * 256];
        pv[q][s][0] = t > 0 ? pc[s * 256 - INC] : 0.f;
        pv[q][s][2] = t < L - 1 ? pc[s * 256 + INC] : 0.f;
      }
    }
#pragma unroll
    for (int q = 0; q < 4; ++q) {
      float u[3];
#pragma unroll
      for (int s = 0; s < 3; ++s) u[s] = pv[q][s][0] * w_[s][0] + pv[q][s][1] * w_[s][1] + pv[q][s][2] * w_[s][2] + b_[s];
      hx[(size_t)rows[q] * 256 + c] = u[0];
      hz[(size_t)rows[q] * 256 + c] = u[1] * u[2];
      ((unsigned short*)(p.ws + OFF_HZB))[(size_t)rows[q] * 256 + c] = f2bf(u[1] * u[2]);
    }
  }
}

__device__ __forceinline__ void glds16(const void* g, void* l) {
  __builtin_amdgcn_global_load_lds((const unsigned*)g, (unsigned*)l, 16, 0, 0);
}

#define VMW(n) asm volatile("s_waitcnt vmcnt(" #n ")" ::: "memory")
#define LGKM0 __builtin_amdgcn_s_waitcnt(0xC07F)
__device__ __forceinline__ float quad_sum(float x) {
  x += __int_as_float(__builtin_amdgcn_update_dpp(0, __float_as_int(x), 0xB1, 0xF, 0xF, true));
  x += __int_as_float(__builtin_amdgcn_update_dpp(0, __float_as_int(x), 0x4E, 0xF, 0xF, true));
  return x;
}

template <int R> struct RwOps { f32x4 A[2], B[2], K[2], W[2], Rr[2]; float v[R]; };
constexpr int RW_SLOT = 1536;
__device__ __forceinline__ void rw_fill(const float* recg, char* slot, int lane, int dir) {
  glds16((const char*)recg + lane * 16, slot);
  if (lane < 32) {
    const char* g2 = (const char*)recg + (lane < 16 ? 1024 + lane * 16 : (5 + dir) * 256 + (lane - 16) * 16);
    glds16(g2, slot + 1024);
  }
}
template <int R>
__device__ __forceinline__ void rw_load(RwOps<R>& o, const char* rec, int k8, int vrow) {
  const f32x4* q = (const f32x4*)rec + k8 * 2;
#pragma unroll
  for (int i = 0; i < 2; ++i) { o.Rr[i] = q[i]; o.K[i] = q[16 + i]; o.A[i] = q[48 + i]; o.B[i] = q[64 + i]; o.W[i] = q[80 + i]; }
  if (R == 2) { f32x2 t = *(const f32x2*)((const float*)rec + 128 + vrow); o.v[0] = t.x; o.v[R - 1] = t.y; }
  else o.v[0] = ((const float*)rec)[128 + vrow];
}
template <int R>
__device__ __forceinline__ void rw_step(f32x2 (&S)[R][4], const RwOps<R>& o, float (&res)[R]) {
  const f32x2 A0 = {o.A[0][0], o.A[0][1]}, A1 = {o.A[0][2], o.A[0][3]}, A2 = {o.A[1][0], o.A[1][1]}, A3 = {o.A[1][2], o.A[1][3]};
  float sa[R];
#pragma unroll
  for (int r = 0; r < R; ++r) {
    f32x2 p0 = S[r][0] * A0, q0 = S[r][1] * A1;
    p0 += S[r][2] * A2; q0 += S[r][3] * A3;
    p0 += q0;
    sa[r] = p0.x + p0.y;
  }
#pragma unroll
  for (int r = 0; r < R; ++r) sa[r] += dpp_f(sa[r], 0);
#pragma unroll
  for (int r = 0; r < R; ++r) sa[r] += dpp_f(sa[r], 1);
#pragma unroll
  for (int r = 0; r < R; ++r) sa[r] += dpp_f(sa[r], 2);
#pragma unroll
  for (int i = 0; i < 4; ++i) {
    const f32x2 W = {o.W[i >> 1][(i & 1) * 2], o.W[i >> 1][(i & 1) * 2 + 1]};
    const f32x2 B = {o.B[i >> 1][(i & 1) * 2], o.B[i >> 1][(i & 1) * 2 + 1]};
    const f32x2 K = {o.K[i >> 1][(i & 1) * 2], o.K[i >> 1][(i & 1) * 2 + 1]};
#pragma unroll
    for (int r = 0; r < R; ++r) S[r][i] = S[r][i] * W + (f32x2{sa[r], sa[r]} * B + f32x2{o.v[r], o.v[r]} * K);
  }
  const f32x2 R0 = {o.Rr[0][0], o.Rr[0][1]}, R1 = {o.Rr[0][2], o.Rr[0][3]}, R2 = {o.Rr[1][0], o.Rr[1][1]}, R3 = {o.Rr[1][2], o.Rr[1][3]};
#pragma unroll
  for (int r = 0; r < R; ++r) {
    f32x2 u0 = S[r][0] * R0, w0 = S[r][1] * R1;
    u0 += S[r][2] * R2; w0 += S[r][3] * R3;
    u0 += w0;
    res[r] = u0.x + u0.y;
  }
#pragma unroll
  for (int r = 0; r < R; ++r) res[r] += dpp_f(res[r], 0);
#pragma unroll
  for (int r = 0; r < R; ++r) res[r] += dpp_f(res[r], 1);
#pragma unroll
  for (int r = 0; r < R; ++r) res[r] += dpp_f(res[r], 2);
}

template <int NW>
__device__ __forceinline__ void rw_poll(volatile unsigned* f, unsigned target) {
  for (unsigned sp = 0; sp < (1u << 20); ++sp) {
    unsigned m = min(min(f[0], f[1]), min(f[2], f[3]));
    if (NW == 8) m = min(m, min(min(f[4], f[5]), min(f[6], f[7])));
    if ((unsigned)__builtin_amdgcn_readfirstlane((int)m) >= target) break;
    __builtin_amdgcn_s_sleep(1);
  }
  asm volatile("" ::: "memory");
}

constexpr int RQ_STEPS = 64;
template <int NW, int R, int RING>
__device__ __forceinline__ void rwkv_scan(const Params& p, int l, int scan, int w, int rowoff, char* ring, volatile unsigned* fl) {
  constexpr int LPC = 8 / NW;
  constexpr int NCHR = RING / 8;
  static_assert(NW == 4 && (RING == 64 || RING == 32), "vmcnt immediates below are written for these cases");
  const int lane = otid() & 63;
  scan = __builtin_amdgcn_readfirstlane(scan);
  w = __builtin_amdgcn_readfirstlane(w);
  int b, hd, L, rowbase;
  const bool lat = scan < 96;
  if (lat) { b = scan / 12; hd = scan % 12; L = 1024; rowbase = NCTX + b * 1024; }
  else { int t2 = scan - 96; b = t2 / 12; hd = t2 % 12; L = 256; rowbase = b * 256; }
  const int h = hd >> 1, dir = hd & 1;
  const int k8 = lane & 7, vrow = rowoff + w * (8 * R) + (lane >> 3) * R;
  const float* rec = (const float*)(p.ws + OFF_REC);
  float* RO = (float*)(p.ws + OFF_RO) + (size_t)dir * NTOK * 384 + h * 64 + vrow + (R == 2 ? (k8 & 1) : 0);
  f32x2 S[R][4];
  if (lat) {
    const float* sb = p.in[I_SR] + ((((size_t)b * DEPTH + l) * 2 + dir) * 6 + h) * 4096 + vrow * 64 + k8 * 8;
#pragma unroll
    for (int r = 0; r < R; ++r)
#pragma unroll
      for (int i = 0; i < 2; ++i) { float4 v = *(const float4*)(sb + r * 64 + i * 4); S[r][2 * i] = f32x2{v.x, v.y}; S[r][2 * i + 1] = f32x2{v.z, v.w}; }
  } else {
#pragma unroll
    for (int r = 0; r < R; ++r)
#pragma unroll
      for (int i = 0; i < 4; ++i) S[r][i] = f32x2{0.f, 0.f};
  }
  VMW(0);
  const int NCH = L >> 3;
#define RW_REC(st) (rec + ((size_t)(rowbase + (dir ? L - 1 - (st) : (st))) * 6 + h) * 512)
#define RW_SLOTP(st) (ring + ((st) & (RING - 1)) * RW_SLOT)
#pragma unroll
  for (int c = 0; c < NCHR - 1; ++c)
#pragma unroll
    for (int t = 0; t < LPC; ++t) { const int s = 8 * c + NW * t + w; rw_fill(RW_REC(s), RW_SLOTP(s), lane, dir); }
  RwOps<R> oa{};
  float osel = 0.f;
  for (int c = 0; c < NCH; ++c) {
    if (c + NCHR - 2 <= NCH - 1) { if (RING == 64) VMW(20); else VMW(4); } else VMW(0);
    if (lane == 0) fl[w] = (unsigned)(c + 2);
    rw_poll<NW>(fl, (unsigned)(c + 2));
    if (c == 0) rw_load<R>(oa, RW_SLOTP(0), k8, vrow);
    for (int j = 0; j < 8; j += 2) {
      const int s = 8 * c + j;
      RwOps<R> ob;
      LGKM0;
      rw_load<R>(ob, RW_SLOTP(s + 1), k8, vrow);
      __builtin_amdgcn_sched_barrier(0);
      {
        float o[R];
        rw_step<R>(S, oa, o);
        if (R == 2) osel = ((s & 3) == (k8 >> 1)) ? ((k8 & 1) ? o[R - 1] : o[0]) : osel;
        else osel = ((s & 7) == k8) ? o[0] : osel;
      }
      __builtin_amdgcn_sched_barrier(0);
      LGKM0;
      rw_load<R>(oa, RW_SLOTP(s + 2), k8, vrow);
      __builtin_amdgcn_sched_barrier(0);
      {
        float o[R];
        rw_step<R>(S, ob, o);
        if (R == 2) {
          osel = (((s + 1) & 3) == (k8 >> 1)) ? ((k8 & 1) ? o[R - 1] : o[0]) : osel;
          if (((s + 1) & 3) == 3) {
            const int st = s - 2 + (k8 >> 1);
            const int n = dir ? L - 1 - st : st;
            RO[(size_t)(rowbase + n) * 384] = osel;
          }
        } else {
          osel = (((s + 1) & 7) == k8) ? o[0] : osel;
          if (((s + 1) & 7) == 7) {
            const int st = s - 6 + k8;
            const int n = dir ? L - 1 - st : st;
            RO[(size_t)(rowbase + n) * 384] = osel;
          }
        }
      }
      __builtin_amdgcn_sched_barrier(0);
    }
    asm volatile("" ::: "memory");
    if (lane == 0) fl[8 + w] = (unsigned)(c + 1);
    if (c + NCHR - 1 < NCH) {
      rw_poll<NW>(fl + 8, (unsigned)c);
#pragma unroll
      for (int t = 0; t < LPC; ++t) { const int s = 8 * (c + NCHR - 1) + NW * t + w; rw_fill(RW_REC(s), RW_SLOTP(s), lane, dir); }
    }
  }
#undef RW_REC
#undef RW_SLOTP
  if (!lat) {
    float* so = p.out + (size_t)NTOK * D + (size_t)16 * DEPTH * 2 * 6 * 2048 +
                ((((size_t)b * DEPTH + l) * 2 + dir) * 6 + h) * 4096 + vrow * 64 + k8 * 8;
#pragma unroll
    for (int r = 0; r < R; ++r)
#pragma unroll
      for (int i = 0; i < 2; ++i) *(float4*)(so + r * 64 + i * 4) = make_float4(S[r][2 * i].x, S[r][2 * i].y, S[r][2 * i + 1].x, S[r][2 * i + 1].y);
  }
  VMW(0);
}

struct RwOpsLa { f32x4 An[2], B[2], K[2], W[2], Rr[2]; float v; };
__device__ __forceinline__ void rw_load_la(RwOpsLa& o, const char* rec, const char* recn, int k8, int vrow) {
  const f32x4* q = (const f32x4*)rec + k8 * 2;
  const f32x4* qn = (const f32x4*)recn + k8 * 2;
#pragma unroll
  for (int i = 0; i < 2; ++i) { o.Rr[i] = q[i]; o.K[i] = q[16 + i]; o.B[i] = q[64 + i]; o.W[i] = q[80 + i]; o.An[i] = qn[48 + i]; }
  o.v = ((const float*)rec)[128 + vrow];
}
__device__ __forceinline__ float rw_step_la(f32x2 (&S)[4], float& sa, const RwOpsLa& o) {
  f32x2 W2[4], B2[4], K2[4], A2[4], R2[4];
#pragma unroll
  for (int i = 0; i < 4; ++i) {
    const int a = i >> 1, c = (i & 1) * 2;
    W2[i] = f32x2{o.W[a][c], o.W[a][c + 1]}; B2[i] = f32x2{o.B[a][c], o.B[a][c + 1]}; K2[i] = f32x2{o.K[a][c], o.K[a][c + 1]};
    A2[i] = f32x2{o.An[a][c], o.An[a][c + 1]}; R2[i] = f32x2{o.Rr[a][c], o.Rr[a][c + 1]};
  }
  const f32x2 vv = {o.v, o.v};
  f32x2 T[4];
#pragma unroll
  for (int i = 0; i < 4; ++i) T[i] = S[i] * W2[i] + vv * K2[i];
  f32x2 g0 = T[0] * A2[0], g1 = T[1] * A2[1];
  g0 += T[2] * A2[2]; g1 += T[3] * A2[3]; g0 += g1;
  f32x2 b0 = B2[0] * A2[0], b1 = B2[1] * A2[1];
  b0 += B2[2] * A2[2]; b1 += B2[3] * A2[3]; b0 += b1;
  float gp = g0.x + g0.y, bp = b0.x + b0.y;
  gp += dpp_f(gp, 0); bp += dpp_f(bp, 0);
  gp += dpp_f(gp, 1); bp += dpp_f(bp, 1);
  gp += dpp_f(gp, 2); bp += dpp_f(bp, 2);
  const f32x2 sav = {sa, sa};
#pragma unroll
  for (int i = 0; i < 4; ++i) S[i] = sav * B2[i] + T[i];
  f32x2 u0 = S[0] * R2[0], u1 = S[1] * R2[1];
  u0 += S[2] * R2[2]; u1 += S[3] * R2[3]; u0 += u1;
  float ov = u0.x + u0.y;
  ov += dpp_f(ov, 0); ov += dpp_f(ov, 1); ov += dpp_f(ov, 2);
  sa = sa * bp + gp;
  return ov;
}

__device__ __forceinline__ void rwkv_scan_la(const Params& p, int l, int scan, int w, int rowoff, char* ring, volatile unsigned* fl) {
  constexpr int NW = 4, R = 1, RING = 64;
  constexpr int LPC = 8 / NW;
  constexpr int NCHR = RING / 8;
  static_assert(NW == 4 && (RING == 64 || RING == 32), "vmcnt immediates below are written for these cases");
  const int lane = otid() & 63;
  scan = __builtin_amdgcn_readfirstlane(scan);
  w = __builtin_amdgcn_readfirstlane(w);
  int b, hd, L, rowbase;
  const bool lat = scan < 96;
  if (lat) { b = scan / 12; hd = scan % 12; L = 1024; rowbase = NCTX + b * 1024; }
  else { int t2 = scan - 96; b = t2 / 12; hd = t2 % 12; L = 256; rowbase = b * 256; }
  const int h = hd >> 1, dir = hd & 1;
  const int k8 = lane & 7, vrow = rowoff + w * (8 * R) + (lane >> 3) * R;
  const float* rec = (const float*)(p.ws + OFF_REC);
  float* RO = (float*)(p.ws + OFF_RO) + (size_t)dir * NTOK * 384 + h * 64 + vrow + (R == 2 ? (k8 & 1) : 0);
  f32x2 S[R][4];
  if (lat) {
    const float* sb = p.in[I_SR] + ((((size_t)b * DEPTH + l) * 2 + dir) * 6 + h) * 4096 + vrow * 64 + k8 * 8;
#pragma unroll
    for (int r = 0; r < R; ++r)
#pragma unroll
      for (int i = 0; i < 2; ++i) { float4 v = *(const float4*)(sb + r * 64 + i * 4); S[r][2 * i] = f32x2{v.x, v.y}; S[r][2 * i + 1] = f32x2{v.z, v.w}; }
  } else {
#pragma unroll
    for (int r = 0; r < R; ++r)
#pragma unroll
      for (int i = 0; i < 4; ++i) S[r][i] = f32x2{0.f, 0.f};
  }
  VMW(0);
  const int NCH = L >> 3;
#define RW_REC(st) (rec + ((size_t)(rowbase + (dir ? L - 1 - (st) : (st))) * 6 + h) * 512)
#define RW_SLOTP(st) (ring + ((st) & (RING - 1)) * RW_SLOT)
#pragma unroll
  for (int c = 0; c < NCHR - 1; ++c)
#pragma unroll
    for (int t = 0; t < LPC; ++t) { const int s = 8 * c + NW * t + w; rw_fill(RW_REC(s), RW_SLOTP(s), lane, dir); }
  RwOpsLa oa{};
  float sa = 0.f;
  float osel = 0.f;
  for (int c = 0; c < NCH; ++c) {
    if (c + NCHR - 2 <= NCH - 1) { if (RING == 64) VMW(20); else VMW(4); } else VMW(0);
    if (lane == 0) fl[w] = (unsigned)(c + 2);
    rw_poll<NW>(fl, (unsigned)(c + 2));
    if (c == 0) {
      const f32x4* q0 = (const f32x4*)RW_SLOTP(0) + k8 * 2;
      const f32x4 a0 = q0[48], a1 = q0[49];
      f32x2 d0 = S[0][0] * f32x2{a0[0], a0[1]}, d1 = S[0][1] * f32x2{a0[2], a0[3]};
      d0 += S[0][2] * f32x2{a1[0], a1[1]}; d1 += S[0][3] * f32x2{a1[2], a1[3]};
      d0 += d1;
      sa = d0.x + d0.y;
      sa += dpp_f(sa, 0); sa += dpp_f(sa, 1); sa += dpp_f(sa, 2);
      rw_load_la(oa, RW_SLOTP(0), RW_SLOTP(1), k8, vrow);
    }
    for (int j = 0; j < 8; j += 2) {
      const int s = 8 * c + j;
      RwOpsLa ob;
      LGKM0;
      rw_load_la(ob, RW_SLOTP(s + 1), RW_SLOTP(s + 2), k8, vrow);
      __builtin_amdgcn_sched_barrier(0);
      {
        float o[R];
        o[0] = rw_step_la(S[0], sa, oa);
        if (R == 2) osel = ((s & 3) == (k8 >> 1)) ? ((k8 & 1) ? o[R - 1] : o[0]) : osel;
        else osel = ((s & 7) == k8) ? o[0] : osel;
      }
      __builtin_amdgcn_sched_barrier(0);
      LGKM0;
      rw_load_la(oa, RW_SLOTP(s + 2), RW_SLOTP(s + 3), k8, vrow);
      __builtin_amdgcn_sched_barrier(0);
      {
        float o[R];
        o[0] = rw_step_la(S[0], sa, ob);
        if (R == 2) {
          osel = (((s + 1) & 3) == (k8 >> 1)) ? ((k8 & 1) ? o[R - 1] : o[0]) : osel;
          if (((s + 1) & 3) == 3) {
            const int st = s - 2 + (k8 >> 1);
            const int n = dir ? L - 1 - st : st;
            RO[(size_t)(rowbase + n) * 384] = osel;
          }
        } else {
          osel = (((s + 1) & 7) == k8) ? o[0] : osel;
          if (((s + 1) & 7) == 7) {
            const int st = s - 6 + k8;
            const int n = dir ? L - 1 - st : st;
            RO[(size_t)(rowbase + n) * 384] = osel;
          }
        }
      }
      __builtin_amdgcn_sched_barrier(0);
    }
    asm volatile("" ::: "memory");
    if (lane == 0) fl[8 + w] = (unsigned)(c + 1);
    if (c + NCHR - 1 < NCH) {
      rw_poll<NW>(fl + 8, (unsigned)c);
#pragma unroll
      for (int t = 0; t < LPC; ++t) { const int s = 8 * (c + NCHR - 1) + NW * t + w; rw_fill(RW_REC(s), RW_SLOTP(s), lane, dir); }
    }
  }
#undef RW_REC
#undef RW_SLOTP
  if (!lat) {
    float* so = p.out + (size_t)NTOK * D + (size_t)16 * DEPTH * 2 * 6 * 2048 +
                ((((size_t)b * DEPTH + l) * 2 + dir) * 6 + h) * 4096 + vrow * 64 + k8 * 8;
#pragma unroll
    for (int r = 0; r < R; ++r)
#pragma unroll
      for (int i = 0; i < 2; ++i) *(float4*)(so + r * 64 + i * 4) = make_float4(S[r][2 * i].x, S[r][2 * i].y, S[r][2 * i + 1].x, S[r][2 * i + 1].y);
  }
  VMW(0);
}

template <int NE> struct GlOps { f32x4 Q[2], K[2], A[2]; float v[NE]; };
constexpr int GL_RING = 32, GL_SLOT = 768;
template <int NE>
__device__ __forceinline__ void gl_load(GlOps<NE>& o, const char* rec, int dir, int dq, int ecol) {
  const f32x4* q = (const f32x4*)rec;
#pragma unroll
  for (int i = 0; i < 2; ++i) { o.Q[i] = q[dq * 2 + i]; o.K[i] = q[8 + dq * 2 + i]; o.A[i] = q[16 + dir * 8 + dq * 2 + i]; }
  if (NE == 4) { f32x4 t = *(const f32x4*)((const float*)rec + 128 + ecol); o.v[0] = t[0]; o.v[1] = t[1]; o.v[NE - 2] = t[2]; o.v[NE - 1] = t[3]; }
  else { f32x2 t = *(const f32x2*)((const float*)rec + 128 + ecol); o.v[0] = t.x; o.v[1] = t.y; }
}
template <int NE>
__device__ __forceinline__ float gl_step(f32x2 (&S)[8][NE / 2], const GlOps<NE>& o, int dq) {
  f32x2 vv[NE / 2], acc[NE / 2];
#pragma unroll
  for (int e = 0; e < NE / 2; ++e) { vv[e] = f32x2{o.v[2 * e], o.v[2 * e + 1]}; acc[e] = f32x2{0.f, 0.f}; }
#pragma unroll
  for (int d = 0; d < 8; ++d) {
    const float a = o.A[d >> 2][d & 3], kk = o.K[d >> 2][d & 3], qq = o.Q[d >> 2][d & 3];
    const f32x2 av = {a, a}, kv = {kk, kk}, qv = {qq, qq};
#pragma unroll
    for (int e = 0; e < NE / 2; ++e) { S[d][e] = av * S[d][e] + kv * vv[e]; acc[e] += qv * S[d][e]; }
  }
  if (NE == 4) {
    const float r0 = quad_sum(acc[0].x), r1 = quad_sum(acc[0].y), r2 = quad_sum(acc[NE / 2 - 1].x), r3 = quad_sum(acc[NE / 2 - 1].y);
    return dq == 0 ? r0 : (dq == 1 ? r1 : (dq == 2 ? r2 : r3));
  } else {
    const float r0 = quad_sum(acc[0].x), r1 = quad_sum(acc[0].y);
    return (dq & 1) ? r1 : r0;
  }
}
template <int NE>
__device__ __forceinline__ void gla_scan(const Params& p, int l, int task, int eh, char* ring  ) {
  const int lane = otid() & 63;
  task = __builtin_amdgcn_readfirstlane(task);
  int b, hd, L, rowbase;
  const bool lat = task < 96;
  if (lat) { b = task / 12; hd = task % 12; L = 1024; rowbase = NCTX + b * 1024; }
  else { int t2 = task - 96; b = t2 / 12; hd = t2 % 12; L = 256; rowbase = b * 256; }
  const int h = hd >> 1, dir = hd & 1;
  const int dq = lane & 3, eg = lane >> 2;
  const int ecol = (NE == 4) ? eg * 4 : eh * 32 + eg * 2;
  const bool owner = (NE == 4) || dq < 2;
  const float* grec = (const float*)(p.ws + OFF_GREC);
  float* GO = (float*)(p.ws + OFF_GO) + (size_t)dir * NTOK * 384 + h * 64 + ecol + (NE == 4 ? dq : (dq & 1));
  f32x2 S[8][NE / 2];
  if (lat) {
    const float* s0 = p.in[I_SG] + ((((size_t)b * DEPTH + l) * 2 + dir) * 6 + h) * 2048 + (dq * 8) * 64 + ecol;
#pragma unroll
    for (int d = 0; d < 8; ++d)
#pragma unroll
      for (int e = 0; e < NE / 2; ++e) { f32x2 v = *(const f32x2*)(s0 + d * 64 + 2 * e); S[d][e] = v; }
  } else {
#pragma unroll
    for (int d = 0; d < 8; ++d)
#pragma unroll
      for (int e = 0; e < NE / 2; ++e) S[d][e] = f32x2{0.f, 0.f};
  }
  VMW(0);
#define GL_REC(st) ((const char*)(grec + ((size_t)(rowbase + (dir ? L - 1 - (st) : (st))) * 6 + h) * 256))
#pragma unroll
  for (int s = 0; s < GL_RING; ++s) { if (lane < 48) glds16(GL_REC(s) + lane * 16, ring + s * GL_SLOT); }
  GlOps<NE> oa{};
  VMW(31);
  gl_load<NE>(oa, ring, dir, dq, ecol);
  for (int s = 0; s < L; s += 2) {
    GlOps<NE> ob;
    LGKM0; if (s + GL_RING >= L) VMW(0); else VMW(30);
    gl_load<NE>(ob, ring + ((s + 1) & (GL_RING - 1)) * GL_SLOT, dir, dq, ecol);
    __builtin_amdgcn_sched_barrier(0);
    {
      float o = gl_step<NE>(S, oa, dq);
      const int n = dir ? L - 1 - s : s;
      if (owner) GO[(size_t)(rowbase + n) * 384] = o;
    }
    asm volatile("" ::: "memory");
    if (s + GL_RING < L && lane < 48) glds16(GL_REC(s + GL_RING) + lane * 16, ring + (s & (GL_RING - 1)) * GL_SLOT);
    __builtin_amdgcn_sched_barrier(0);
    LGKM0; if (s + 1 + GL_RING >= L) VMW(0); else VMW(30);
    gl_load<NE>(oa, ring + ((s + 2) & (GL_RING - 1)) * GL_SLOT, dir, dq, ecol);
    __builtin_amdgcn_sched_barrier(0);
    {
      float o = gl_step<NE>(S, ob, dq);
      const int n = dir ? L - 2 - s : s + 1;
      if (owner) GO[(size_t)(rowbase + n) * 384] = o;
    }
    asm volatile("" ::: "memory");
    if (s + 1 + GL_RING < L && lane < 48) glds16(GL_REC(s + 1 + GL_RING) + lane * 16, ring + ((s + 1) & (GL_RING - 1)) * GL_SLOT);
    __builtin_amdgcn_sched_barrier(0);
  }
#undef GL_REC
  if (!lat) {
    float* so = p.out + (size_t)NTOK * D + ((((size_t)b * DEPTH + l) * 2 + dir) * 6 + h) * 2048 + (dq * 8) * 64 + ecol;
#pragma unroll
    for (int d = 0; d < 8; ++d)
#pragma unroll
      for (int e = 0; e < NE / 2; ++e) *(f32x2*)(so + d * 64 + 2 * e) = S[d][e];
  }
  VMW(0);
}

constexpr int HY_TASKS = 768;
__device__ __forceinline__ void hyena_task(const Params& p, int l, int task) {
  const int lane = otid() & 63;
  int b, cgp, tb, L, rowbase;
  const float* ft = (const float*)(p.ws + OFF_FT) + (size_t)l * FT_LAYER;
  if (task < 512) { b = task >> 6; cgp = (task >> 5) & 1; tb = task & 31; L = 1024; rowbase = NCTX + b * 1024; ft += FT_L0; }
  else { int t2 = task - 512; b = t2 >> 4; cgp = (t2 >> 3) & 1; tb = t2 & 7; L = 256; rowbase = b * 256; }
  const int c = cgp * 128 + lane * 2;
  const int t0 = tb * 32;
  const float* hz = (const float*)(p.ws + OFF_HYZ) + (size_t)rowbase * 256 + c;
  const float* hx = (const float*)(p.ws + OFF_HYX) + (size_t)rowbase * 256 + c;
  const float* fc = ft + c;
  const unsigned short* hzb = (const unsigned short*)(p.ws + OFF_HZB) + (size_t)rowbase * 256 + c;
  const unsigned short* fcb = (const unsigned short*)(p.ws + OFF_FTB) + (size_t)(ft - (const float*)(p.ws + OFF_FT)) + c;
  f32x2 acc[32];
#pragma unroll
  for (int i = 0; i < 32; ++i) acc[i] = f32x2{0.f, 0.f};
  for (int s0 = 0; s0 < L; s0 += 16) {
    f32x2 z[16], f[47];
#pragma unroll
    for (int j = 0; j < 16; ++j) { const unsigned u = *(const unsigned*)(hzb + (size_t)(s0 + j) * 256); z[j] = f32x2{__uint_as_float(u << 16), __uint_as_float(u & 0xffff0000u)}; }
    const unsigned short* fb = fcb + (size_t)(t0 - s0 - 15 + L - 1) * 256;
#pragma unroll
    for (int m = 0; m < 47; ++m) { const unsigned u = *(const unsigned*)(fb + (size_t)m * 256); f[m] = f32x2{__uint_as_float(u << 16), __uint_as_float(u & 0xffff0000u)}; }
#pragma unroll
    for (int i = 0; i < 32; ++i)
#pragma unroll
      for (int j = 0; j < 16; ++j) acc[i] += f[i - j + 15] * z[j];
  }
  const f32x2 bias = *(const f32x2*)(p.in[I_HBIAS] + l * 256 + c);
  unsigned* O = (unsigned*)(p.ws + OFF_H);
#pragma unroll
  for (int i = 0; i < 32; ++i) {
    int t = t0 + i;
    f32x2 zz = *(const f32x2*)(hz + (size_t)t * 256), xx = *(const f32x2*)(hx + (size_t)t * 256);
    f32x2 y = xx * (acc[i] + zz * bias);
    O[((size_t)(rowbase + t) * D + 384 + c) >> 1] = (unsigned)f2bf(y.x) | ((unsigned)f2bf(y.y) << 16);
  }
}

constexpr int LDS_GLA = 98304, LDS_FLAGS = 147456, LDS_XB = 147584;
__device__ __forceinline__ void phase_mixers(const Params& p, int l, int cidx) {
  const int wave = otid() >> 6, lane = otid() & 63;
  const int bid = obid();
  volatile unsigned* fl = (volatile unsigned*)(smem + LDS_FLAGS);
  if (otid() < 32) fl[otid()] = 0u;
  __syncthreads();
  __builtin_amdgcn_s_setprio(3);
  if (bid < 192) {
    if (wave < 4) rwkv_scan_la(p, l, bid >> 1, wave, (bid & 1) * 32, smem, fl);
    else rwkv_scan<4, 2, 32>(p, l, 96 + bid, wave - 4, 0, smem + 98304, fl + 16);
  } else if (wave < 3) {
    const int g = (bid - 192) * 3 + wave;
    gla_scan<2>(p, l, g >> 1, g & 1, smem + wave * 24576);
  } else if (wave < 6) {
    gla_scan<4>(p, l, 96 + (bid - 192) * 3 + (wave - 3), 0, smem + wave * 24576);
  }
  __builtin_amdgcn_s_setprio(0);
  int* cnt = (int*)(p.ws + OFF_CNT) + cidx;
  const int ntask = HY_TASKS + (l < DEPTH - 1 ? 5312 : 0);
  while (true) {
    int t = 0;
    if (lane == 0) t = atomicAdd(cnt, 1);
    t = __shfl(t, 0);
    if (t >= ntask) break;
    if (t < HY_TASKS) hyena_task(p, l, t);
    else wconv_wave(p, l + 1, (l + 1) & 1, t - HY_TASKS);
  }
}

__device__ __forceinline__ void phase_post(const Params& p, int l) {
  const int wave = otid() >> 6, lane = otid() & 63;
  const float* GO = (const float*)(p.ws + OFF_GO);
  const float* RO = (const float*)(p.ws + OFF_RO);
  const float* grec = (const float*)(p.ws + OFF_GREC);
  const float* rec = (const float*)(p.ws + OFF_REC);
  unsigned short* O = (unsigned short*)(p.ws + OFF_H);
  const float gn = p.in[I_GN][l * 64 + lane];
  float lw[6], lb[6], rk[6];
#pragma unroll
  for (int h = 0; h < 6; ++h) { lw[h] = p.in[I_RLW][l * 384 + h * 64 + lane]; lb[h] = p.in[I_RLB][l * 384 + h * 64 + lane]; rk[h] = p.in[I_RRK][l * 384 + h * 64 + lane]; }
  for (int R = obid() * 8 + wave; R < NTOK; R += gridDim.x * 8) {
    const int tokr = scan2tok(R);
    float go[6], gg[6], ro[6], r_[6], k_[6], v_[6], g_[6];
#pragma unroll
    for (int h = 0; h < 6; ++h) {
      go[h] = GO[(size_t)R * 384 + h * 64 + lane] + GO[(size_t)(NTOK + R) * 384 + h * 64 + lane];
      gg[h] = grec[((size_t)R * 6 + h) * 256 + 192 + lane];
      ro[h] = RO[(size_t)R * 384 + h * 64 + lane] + RO[(size_t)(NTOK + R) * 384 + h * 64 + lane];
      const float* rr = rec + ((size_t)R * 6 + h) * 512 + lane;
      r_[h] = rr[0]; k_[h] = rr[64]; v_[h] = rr[128]; g_[h] = rr[448];
    }
    __builtin_amdgcn_sched_barrier(0);
#pragma unroll
    for (int h = 0; h < 6; ++h) {
      const float o = go[h];
      float ms = wave_sum(o * o) * (1.f / 64.f);
      float y = o * rsqrtf(ms + 1e-6f) * gn;
      O[(size_t)R * D + h * 64 + lane] = f2bf(y * siluf_(gg[h]));
    }
#pragma unroll
    for (int h = 0; h < 6; ++h) {
      const int c = h * 64 + lane;
      const float o = ro[h];
      float mean = wave_sum(o) * (1.f / 64.f);
      float dlt = o - mean;
      float var = wave_sum(dlt * dlt) * (1.f / 64.f);
      float y = dlt * rsqrtf(var + 64e-5f) * lw[h] + lb[h];
      float bonus = wave_sum(r_[h] * k_[h] * rk[h]) * v_[h];
      O[(size_t)tokr * D + 640 + c] = f2bf((y + bonus) * g_[h]);
    }
  }
}

#define XB_TMO      128
#define XB_XCNT(j)  (256  + 64 * (j))
#define XB_XSUB(j)  (1280 + 64 * (j))
#define XB_XGEN(j)  (2304 + 64 * (j))
#define XB_TOP      3328
#define XB_TOPGEN   3392
#define XCD_BAR_WORDS 3456
#define XB_SPIN_CAP (1u << 18)
#define LAS __attribute__((address_space(3)))

__device__ __forceinline__ unsigned xb_ld(unsigned* p)              { return __hip_atomic_load(p, __ATOMIC_RELAXED, __HIP_MEMORY_SCOPE_AGENT); }
__device__ __forceinline__ unsigned xb_add(unsigned* p, unsigned v) { return __hip_atomic_fetch_add(p, v, __ATOMIC_RELAXED, __HIP_MEMORY_SCOPE_AGENT); }
__device__ __forceinline__ unsigned xb_xcc_id() { return (unsigned)__builtin_amdgcn_s_getreg((3 << 11) | 20) & 0xFu; }
#define XB_SPIN(cond, bar) do { unsigned _sp = 0; while (cond) { __builtin_amdgcn_s_sleep(1); \
    if ((++_sp & 255u) == 0u) { if (xb_ld(&(bar)[XB_TMO])) break; if (_sp > XB_SPIN_CAP) { atomicAdd(&(bar)[XB_TMO], 1u); break; } } } } while (0)

struct XcdBarrier {
    unsigned* bar; unsigned x;
    volatile LAS unsigned* st;
};

__device__ __forceinline__ XcdBarrier xcd_barrier_post(unsigned* bar, volatile LAS unsigned* st) {
    XcdBarrier b; b.bar = bar; b.x = xb_xcc_id(); b.st = st;
    if (threadIdx.x == 0) (void)xb_add(&bar[XB_XCNT(b.x)], 1u);
    return b;
}
__device__ __forceinline__ void xcd_barrier_complete(unsigned* bar, unsigned x, unsigned& nloc, unsigned& nx) {
    const unsigned G = gridDim.x * gridDim.y * gridDim.z;
    unsigned sum, cnt, mine, sp = 0u;
    for (;;) {
        sum = 0u; cnt = 0u; mine = 0u;
#pragma unroll
        for (unsigned j = 0; j < 16; ++j) { const unsigned c = xb_ld(&bar[XB_XCNT(j)]); sum += c; cnt += (c > 0u) ? 1u : 0u; mine = (j == x) ? c : mine; }
        if (sum == G) break;
        __builtin_amdgcn_s_sleep(1);
        if ((++sp & 255u) == 0u) { if (xb_ld(&bar[XB_TMO])) break; if (sp > XB_SPIN_CAP) { atomicAdd(&bar[XB_TMO], 1u); break; } }
    }
    nloc = mine > 0u ? mine : 1u; nx = cnt > 0u ? cnt : 1u;
}

__device__ __forceinline__ void xcd_barrier(const XcdBarrier& b) {
    asm volatile("s_waitcnt vmcnt(0)" ::: "memory");
    __syncthreads();
    if (threadIdx.x == 0) {
        unsigned* bar = b.bar;
        __builtin_amdgcn_s_waitcnt(0);
        unsigned nloc = b.st[0], nx = b.st[1];
        if (nloc == 0u) { xcd_barrier_complete(bar, b.x, nloc, nx); b.st[0] = nloc; b.st[1] = nx; }
        const unsigned old = xb_add(&bar[XB_XSUB(b.x)], 1u);
        const unsigned gen = old / nloc;
        if (old + 1u == (gen + 1u) * nloc) {
            __builtin_amdgcn_fence(__ATOMIC_RELEASE, "agent");
            asm volatile("s_waitcnt vmcnt(0)" ::: "memory");
            const unsigned og = xb_add(&bar[XB_TOP], 1u);
            const unsigned tg = og / nx;
            if (og + 1u == (tg + 1u) * nx) xb_add(&bar[XB_TOPGEN], 1u);
            else XB_SPIN(xb_ld(&bar[XB_TOPGEN]) == tg, bar);
            __builtin_amdgcn_fence(__ATOMIC_ACQUIRE, "agent");
            xb_add(&bar[XB_XGEN(b.x)], 1u);
            asm volatile("s_waitcnt vmcnt(0)" ::: "memory");
        } else {
            XB_SPIN(xb_ld(&bar[XB_XGEN(b.x)]) == gen, bar);
            __builtin_amdgcn_fence(__ATOMIC_ACQUIRE, "agent");
            asm volatile("s_waitcnt vmcnt(0)" ::: "memory");
        }
    }
    __syncthreads();
}

__global__ void __launch_bounds__(NTHR) fwd_megakernel(Params p) {
  cg::grid_group grid = cg::this_grid();
  if (threadIdx.x == 0) *(uint4*)(smem + 147584) = make_uint4(0u, 0u, 0u, 0u);
  __syncthreads();
  XcdBarrier xb = xcd_barrier_post((unsigned*)(p.ws + OFF_BAR), (volatile LAS unsigned*)(smem + 147584));
  if (obid() == 0 && otid() < 64) ((int*)(p.ws + OFF_CNT))[otid()] = 0;
  p0_copy_x(p);
  p0_filters(p);
  p0_mod(p);
  __syncthreads();
  phase_wconv(p, 0, 0);
  bf16* hbuf = (bf16*)(p.ws + OFF_H);
  bf16* hmid = (bf16*)(p.ws + OFF_HMID);
  float* xw = (float*)(p.ws + OFF_X);
  float* Pw = (float*)(p.ws + OFF_P);
  for (int l = 0; l < DEPTH; ++l) {
    const float* modl = (const float*)(p.ws + OFF_MOD) + (size_t)l * 9 * 9216;
    const size_t wset = (size_t)(l & 1) * WSET;
    if (l == 0) grid.sync();
    phase_norm(p, p.in[I_F1N] + l * D, modl, 0, 1);
    xcd_barrier(xb);
    phase_gemm(hbuf, p.ws + OFF_W1I + wset, 5632, 1024, EpiSwiglu{(unsigned short*)hmid});
    xcd_barrier(xb);
    phase_gemm(hmid, p.ws + OFF_W1O + wset, 1024, 2816, EpiResid{xw, modl, 2, 0.5f});
    xcd_barrier(xb);
    phase_norm(p, p.in[I_MN] + l * D, modl, 3, 4);
    xcd_barrier(xb);
    phase_gemm(hbuf, p.ws + OFF_WMI + wset, INCP, 1024, EpiP{Pw});
    xcd_barrier(xb);
    prep_rwkv(p, l);
    prep_gla(p, l);
    prep_hyena(p, l);
    xcd_barrier(xb);
    phase_mixers(p, l, l);
    xcd_barrier(xb);
    phase_post(p, l);
    xcd_barrier(xb);
    phase_gemm(hbuf, p.ws + OFF_WMO + wset, 1024, 1024, EpiResid{xw, modl, 5, 1.0f});
    xcd_barrier(xb);
    phase_norm(p, p.in[I_F2N] + l * D, modl, 6, 7);
    xcd_barrier(xb);
    phase_gemm(hbuf, p.ws + OFF_W2I + wset, 5632, 1024, EpiSwiglu{(unsigned short*)hmid});
    xcd_barrier(xb);
    phase_gemm(hmid, p.ws + OFF_W2O + wset, 1024, 2816, EpiResid{xw, modl, 8, 0.5f});
    xcd_barrier(xb);
  }
  phase_final_norm(p);
}

extern "C" void kernel_launch(void* const* d_in, const int* in_sizes, int n_in, void* d_out, int out_size, void* d_ws,
                              size_t ws_size, hipStream_t stream) {
  static int grid_blocks = 0;
  if (!grid_blocks) {
    int dev = 0, cus = 0, per_cu = 0;
    (void)hipGetDevice(&dev);
    (void)hipDeviceGetAttribute(&cus, hipDeviceAttributeMultiprocessorCount, dev);
    (void)hipFuncSetAttribute((const void*)fwd_megakernel, hipFuncAttributeMaxDynamicSharedMemorySize, LDS_BYTES);
    (void)hipOccupancyMaxActiveBlocksPerMultiprocessor(&per_cu, fwd_megakernel, NTHR, LDS_BYTES);
    if (per_cu < 1) per_cu = 1;
    grid_blocks = cus * per_cu;
    if (grid_blocks > 256) grid_blocks = 256;
  }
  if (ws_size < WS_NEED) fprintf(stderr, "workspace too small: %zu < %zu\n", ws_size, (size_t)WS_NEED);
  (void)hipMemsetAsync((char*)d_ws + OFF_BAR, 0, 16384, stream);
  Params p{};
  for (int i = 0; i < 41; ++i) p.in[i] = (const float*)d_in[i];
  p.out = (float*)d_out;
  p.ws = (char*)d_ws;
  void* args[] = {&p};
  hipError_t e = hipLaunchCooperativeKernel((void*)fwd_megakernel, dim3(grid_blocks), dim3(NTHR), args, LDS_BYTES, stream);
  if (e != hipSuccess) fprintf(stderr, "cooperative launch failed: %s (grid %d)\n", hipGetErrorString(e), grid_blocks);
}
```

```cpp
#include <hip/hip_runtime.h>
#include <hip/hip_bf16.h>
#include <hip/hip_cooperative_groups.h>
#include <cstdio>
namespace cg = cooperative_groups;

typedef __hip_bfloat16 bf16;
typedef __attribute__((ext_vector_type(8))) short bf16x8;
typedef __attribute__((ext_vector_type(4))) float f32x4;
typedef __attribute__((ext_vector_type(2))) float f32x2;

constexpr int D = 1024, NTOK = 12288, NCTX = 4096, DEPTH = 4, FH = 2816;
constexpr int INC = 3264, INCP = 3328;
constexpr int C_HY = 1184, C_RW = 1952;
constexpr int NTHR = 512;

constexpr size_t al256(size_t x) { return (x + 255) & ~(size_t)255; }
constexpr size_t OFF_CNT = 0;
constexpr size_t OFF_BAR = 4096;
constexpr size_t OFF_MOD = 4096 + 16384;
constexpr size_t SZ_MOD = (size_t)DEPTH * 9 * 9216 * 4;
constexpr size_t OFF_FT = al256(OFF_MOD + SZ_MOD);
constexpr size_t FT_L0 = 511 * 256, FT_L1 = 2047 * 256;
constexpr size_t FT_LAYER = FT_L0 + FT_L1;
constexpr size_t OFF_X = al256(OFF_FT + DEPTH * FT_LAYER * 4);
constexpr size_t OFF_H = al256(OFF_X + (size_t)NTOK * D * 4);
constexpr size_t OFF_W1I = al256(OFF_H + (size_t)NTOK * D * 2);
constexpr size_t OFF_W1O = al256(OFF_W1I + (size_t)5632 * 1024 * 2);
constexpr size_t OFF_WMI = al256(OFF_W1O + (size_t)1024 * 2816 * 2);
constexpr size_t OFF_WMO = al256(OFF_WMI + (size_t)INCP * 1024 * 2);
constexpr size_t OFF_W2I = al256(OFF_WMO + (size_t)1024 * 1024 * 2);
constexpr size_t OFF_W2O = al256(OFF_W2I + (size_t)5632 * 1024 * 2);
constexpr size_t WSET = al256(OFF_W2O + (size_t)1024 * 2816 * 2) - OFF_W1I;
constexpr size_t OFF_P = OFF_W1I + 2 * WSET;
constexpr size_t SZ_P = (size_t)NTOK * INC * 4;
constexpr size_t SZ_GO = (size_t)2 * NTOK * 384 * 4;
constexpr size_t OFF_GO = OFF_P;
constexpr size_t OFF_RO = OFF_P + SZ_GO;
constexpr size_t OFF_REC = al256(OFF_P + SZ_P);
constexpr size_t SZ_REC = (size_t)NTOK * 6 * 512 * 4;
constexpr size_t OFF_HMID = OFF_REC;
constexpr size_t OFF_GREC = al256(OFF_REC + SZ_REC);
constexpr size_t SZ_GREC = (size_t)NTOK * 6 * 256 * 4;
constexpr size_t OFF_HYZ = al256(OFF_GREC + SZ_GREC);
constexpr size_t OFF_HYX = al256(OFF_HYZ + (size_t)NTOK * 256 * 4);
constexpr size_t OFF_HZB = al256(OFF_HYX + (size_t)NTOK * 256 * 4);
constexpr size_t OFF_FTB = al256(OFF_HZB + (size_t)NTOK * 256 * 2);
constexpr size_t WS_NEED = al256(OFF_FTB + DEPTH * FT_LAYER * 2);

struct Params {
  const float* in[41];
  float* out;
  char* ws;
};

enum { I_XP = 0, I_XS, I_SG, I_SR, I_C, I_CCTX, I_ADAW, I_ADAB, I_F1N, I_F1WI, I_F1WO, I_MN, I_MWI, I_MWO,
       I_GW2, I_GB, I_GN, I_HCW, I_HCB, I_HW1, I_HB1, I_HW2, I_HB2, I_HFQ, I_HW3, I_HBIAS,
       I_RMU, I_RW0, I_RW2, I_RA0, I_RA2, I_RG2, I_RKK, I_RKA, I_RRK, I_RLW, I_RLB, I_F2N, I_F2WI, I_F2WO, I_FN };

extern __shared__ __attribute__((aligned(16))) char smem[];
constexpr int LDS_BYTES = 147600;

__device__ __forceinline__ int otid() { int t = (int)__builtin_amdgcn_workitem_id_x(); asm volatile("" : "+v"(t)); return t; }
__device__ __forceinline__ int obid() { int b = (int)__builtin_amdgcn_workgroup_id_x(); asm volatile("" : "+s"(b)); return b; }
__device__ __forceinline__ unsigned short f2bf(float f) {
  unsigned u = __float_as_uint(f);
  u += 0x7fffu + ((u >> 16) & 1u);
  return (unsigned short)(u >> 16);
}
__device__ __forceinline__ float dpp_f(float x, const int ctrl_sel) {
  int xi = __float_as_int(x), r;
  if (ctrl_sel == 0) r = __builtin_amdgcn_update_dpp(0, xi, 0xB1, 0xF, 0xF, true);
  else if (ctrl_sel == 1) r = __builtin_amdgcn_update_dpp(0, xi, 0x4E, 0xF, 0xF, true);
  else if (ctrl_sel == 2) r = __builtin_amdgcn_update_dpp(0, xi, 0x141, 0xF, 0xF, true);
  else r = __builtin_amdgcn_update_dpp(0, xi, 0x140, 0xF, 0xF, true);
  return __int_as_float(r);
}
__device__ __forceinline__ float wave_sum(float v) {
  v += dpp_f(v, 0); v += dpp_f(v, 1); v += dpp_f(v, 2); v += dpp_f(v, 3);
  const int vi = __float_as_int(v);
  return __int_as_float(__builtin_amdgcn_readlane(vi, 0)) + __int_as_float(__builtin_amdgcn_readlane(vi, 16)) +
         __int_as_float(__builtin_amdgcn_readlane(vi, 32)) + __int_as_float(__builtin_amdgcn_readlane(vi, 48));
}
__device__ __forceinline__ float sigmoidf_(float x) { return __builtin_amdgcn_rcpf(1.f + __builtin_amdgcn_exp2f(x * -1.4426950408889634f)); }
__device__ __forceinline__ float siluf_(float x) { return x * sigmoidf_(x); }
__device__ __forceinline__ int modrow(int row) { return row < NCTX ? 0 : 1 + ((row - NCTX) >> 10); }

__device__ __forceinline__ void p0_copy_x(const Params& p) {
  float4* x = (float4*)(p.ws + OFF_X);
  const float4* a = (const float4*)p.in[I_XP];
  const float4* b = (const float4*)p.in[I_XS];
  const size_t n4 = (size_t)NTOK * D / 4, nc4 = (size_t)NCTX * D / 4;
  for (size_t i = (size_t)obid() * NTHR + otid(); i < n4; i += (size_t)gridDim.x * NTHR)
    x[i] = i < nc4 ? a[i] : b[i - nc4];
}

__device__ __forceinline__ void p0_mod(const Params& p) {
  float* scond = (float*)smem;
  float* red = (float*)(smem + 40960);
  for (int i = otid(); i < 9 * 1024; i += NTHR) {
    int r = i >> 10, d = i & 1023;
    float c = r == 0 ? p.in[I_CCTX][d] : p.in[I_C][(r - 1) * 1024 + d];
    scond[i] = siluf_(c);
  }
  __syncthreads();
  float* mod = (float*)(p.ws + OFF_MOD);
  const int col = otid() & 63, ks = otid() >> 6;
  for (int task = obid(); task < DEPTH * 144; task += gridDim.x) {
    int l = task / 144, cg_ = task % 144;
    const float* w = p.in[I_ADAW] + (size_t)l * 1024 * 9216 + cg_ * 64 + col;
    float acc[9];
#pragma unroll
    for (int r = 0; r < 9; ++r) acc[r] = 0.f;
    for (int d0 = ks * 128; d0 < ks * 128 + 128; d0 += 8) {
      float wv[8];
#pragma unroll
      for (int u = 0; u < 8; ++u) wv[u] = w[(size_t)(d0 + u) * 9216];
#pragma unroll
      for (int u = 0; u < 8; ++u)
#pragma unroll
        for (int r = 0; r < 9; ++r) acc[r] += scond[r * 1024 + d0 + u] * wv[u];
    }
#pragma unroll
    for (int r = 0; r < 9; ++r) red[(ks * 9 + r) * 64 + col] = acc[r];
    __syncthreads();
    for (int i = otid(); i < 576; i += NTHR) {
      int r = i >> 6, c = i & 63;
      float s = 0.f;
#pragma unroll
      for (int k = 0; k < 8; ++k) s += red[(k * 9 + r) * 64 + c];
      int j = cg_ * 64 + c;
      mod[((size_t)l * 9 + r) * 9216 + j] = s + p.in[I_ADAB][l * 9216 + j];
    }
    __syncthreads();
  }
}

__device__ __forceinline__ void p0_filters(const Params& p) {
  const int wave = otid() >> 6, lane = otid() & 63;
  float* FT = (float*)(p.ws + OFF_FT);
  for (int task = obid() * 8 + wave; task < DEPTH * 1280; task += gridDim.x * 8) {
    int l = task / 1280, rem = task % 1280;
    int sel = rem >= 256, i = sel ? rem - 256 : rem, L = sel ? 1024 : 256;
    float t = (float)i / (float)(L - 1);
    float w = 6.283185307179586f * (float)i / (float)L;
    float zval = 0.f;
    {
      const float fstep = (15.f - 1e-4f) / 15.f;
      if (lane == 0) zval = t;
      else if (lane <= 16) zval = cosf((1e-4f + (float)(lane - 1) * fstep) * w);
      else if (lane <= 32) zval = -sinf((1e-4f + (float)(lane - 17) * fstep) * w);
    }
    const float* w1 = p.in[I_HW1] + l * 33 * 64;
    const float* w2 = p.in[I_HW2] + l * 64 * 64;
    const float* w3 = p.in[I_HW3] + l * 64 * 512;
    const float* fq = p.in[I_HFQ] + l * 128;
    float h1 = p.in[I_HB1][l * 64 + lane];
    for (int e = 0; e < 33; ++e) h1 += __shfl(zval, e) * w1[e * 64 + lane];
    h1 = sinf(fq[lane] * h1);
    float h2 = p.in[I_HB2][l * 64 + lane];
    for (int e = 0; e < 64; ++e) h2 += __shfl(h1, e) * w2[e * 64 + lane];
    h2 = sinf(fq[64 + lane] * h2);
    float acc[8];
#pragma unroll
    for (int m = 0; m < 8; ++m) acc[m] = 0.f;
    for (int e = 0; e < 64; ++e) {
      float hv = __shfl(h2, e);
#pragma unroll
      for (int m = 0; m < 8; ++m) acc[m] += hv * w3[e * 512 + m * 64 + lane];
    }
    float* ft = FT + (size_t)l * FT_LAYER + (sel ? FT_L0 : 0);
    const float a0 = -3.0701134573253945f, a1 = -15.350567286626973f;
#pragma unroll
    for (int m = 0; m < 8; ++m) {
      int cp = m * 64 + lane, c = cp & 255;
      float delta = fabsf(a0 + (float)c * ((a1 - a0) / 255.f));
      float val = acc[m] * expf(-t * delta);
      unsigned short* ftb = (unsigned short*)(p.ws + OFF_FTB) + (size_t)l * FT_LAYER + (sel ? FT_L0 : 0);
      if (cp < 256) { ft[(size_t)(L - 1 + i) * 256 + c] = val; ftb[(size_t)(L - 1 + i) * 256 + c] = f2bf(val); }
      else if (i >= 1) { ft[(size_t)(L - 1 - i) * 256 + c] = val; ftb[(size_t)(L - 1 - i) * 256 + c] = f2bf(val); }
    }
  }
}

__device__ __forceinline__ void conv_tile(const float* src, int srcN, int k0, int srccol0, bool zero, bf16* dst, int dstK, int n0) {
  float* tile = (float*)smem;
  const int tid = otid();
  {
    int r = tid >> 4, c4 = (tid & 15) * 4;
#pragma unroll
    for (int rr = 0; rr < 2; ++rr) {
      int row = r + rr * 32;
      float4 v = zero ? make_float4(0.f, 0.f, 0.f, 0.f)
                      : *(const float4*)(src + (size_t)(k0 + row) * srcN + srccol0 + c4);
      tile[row * 65 + c4 + 0] = v.x; tile[row * 65 + c4 + 1] = v.y;
      tile[row * 65 + c4 + 2] = v.z; tile[row * 65 + c4 + 3] = v.w;
    }
  }
  __syncthreads();
  {
    int nn = tid >> 3, ks = (tid & 7) * 8;
    unsigned short v[8];
#pragma unroll
    for (int j = 0; j < 8; ++j) v[j] = f2bf(tile[(ks + j) * 65 + nn]);
    uint4 o;
    o.x = v[0] | ((unsigned)v[1] << 16); o.y = v[2] | ((unsigned)v[3] << 16);
    o.z = v[4] | ((unsigned)v[5] << 16); o.w = v[6] | ((unsigned)v[7] << 16);
    *(uint4*)(dst + (size_t)(n0 + nn) * dstK + k0 + ks) = o;
  }
  __syncthreads();
}

__device__ __forceinline__ unsigned cvt_pk_bf16_(float lo, float hi) { unsigned r; asm volatile("v_cvt_pk_bf16_f32 %0, %1, %2" : "=v"(r) : "v"(lo), "v"(hi)); return r; }
struct WTile { const float* src; int srcN, k0, srccol, dstK, n0; bool zero; size_t dstoff; };
__device__ __forceinline__ WTile wtile_decode(const Params& p, int l, int u) {
  WTile w;
  w.zero = false;
  if (u < 1408 || (u >= 3200 && u < 4608)) {
    const bool second = u >= 3200;
    if (second) u -= 3200;
    w.src = p.in[second ? I_F2WI : I_F1WI] + (size_t)l * 1024 * 5632;
    w.dstoff = second ? OFF_W2I : OFF_W1I;
    const int tn = u % 88, tk = u / 88;
    const int n0 = tn * 64, pn = n0 >> 8, within = n0 & 255;
    w.srccol = within < 128 ? pn * 128 + within : 2816 + pn * 128 + (within - 128);
    w.srcN = 5632; w.k0 = tk * 64; w.dstK = 1024; w.n0 = n0;
  } else if ((u >= 1408 && u < 2112) || u >= 4608) {
    const bool second = u >= 4608;
    u -= second ? 4608 : 1408;
    w.src = p.in[second ? I_F2WO : I_F1WO] + (size_t)l * 2816 * 1024;
    w.dstoff = second ? OFF_W2O : OFF_W1O;
    const int tn = u % 16, tk = u / 16;
    w.srcN = 1024; w.k0 = tk * 64; w.srccol = tn * 64; w.dstK = 2816; w.n0 = tn * 64;
  } else if (u < 2944) {
    u -= 2112;
    w.src = p.in[I_MWI] + (size_t)l * 1024 * INC;
    w.dstoff = OFF_WMI;
    const int tn = u % 52, tk = u / 52;
    w.srcN = INC; w.k0 = tk * 64; w.srccol = tn * 64; w.dstK = 1024; w.n0 = tn * 64; w.zero = tn == 51;
  } else {
    u -= 2944;
    w.src = p.in[I_MWO] + (size_t)l * 1024 * 1024;
    w.dstoff = OFF_WMO;
    const int tn = u % 16, tk = u / 16;
    w.srcN = 1024; w.k0 = tk * 64; w.srccol = tn * 64; w.dstK = 1024; w.n0 = tn * 64;
  }
  return w;
}
__device__ __forceinline__ void phase_wconv(const Params& p, int l, int set) {
  for (int t = obid(); t < 5312; t += gridDim.x) {
    const WTile w = wtile_decode(p, l, t);
    conv_tile(w.src, w.srcN, w.k0, w.srccol, w.zero, (bf16*)(p.ws + w.dstoff + (size_t)set * WSET), w.dstK, w.n0);
  }
}
__device__ __forceinline__ void wconv_wave(const Params& p, int l, int set, int u) {
  const int lane = otid() & 63;
  const WTile w = wtile_decode(p, l, u);
  unsigned pk[32];
  if (!w.zero) {
    const float* s = w.src + (size_t)w.k0 * w.srcN + w.srccol + lane;
#pragma unroll
    for (int kk = 0; kk < 64; kk += 2) pk[kk >> 1] = cvt_pk_bf16_(s[(size_t)kk * w.srcN], s[(size_t)(kk + 1) * w.srcN]);
  } else {
#pragma unroll
    for (int i = 0; i < 32; ++i) pk[i] = 0u;
  }
  uint4* d = (uint4*)((unsigned short*)(p.ws + w.dstoff + (size_t)set * WSET) + (size_t)(w.n0 + lane) * w.dstK + w.k0);
#pragma unroll
  for (int i = 0; i < 8; ++i) d[i] = make_uint4(pk[4 * i], pk[4 * i + 1], pk[4 * i + 2], pk[4 * i + 3]);
}

__device__ __forceinline__ void phase_norm(const Params& p, const float* gain, const float* modl, int shi, int sci) {
  const int wave = otid() >> 6, lane = otid() & 63;
  const float* x = (const float*)(p.ws + OFF_X);
  bf16* h = (bf16*)(p.ws + OFF_H);
  const int nw = gridDim.x * 8;
  float4 g4[4];
#pragma unroll
  for (int i = 0; i < 4; ++i) g4[i] = ((const float4*)gain)[i * 64 + lane];
  for (int row0 = obid() * 8 + wave; row0 < NTOK; row0 += 2 * nw) {
    float4 v[2][4], sc[2][4], sh[2][4];
    int rows[2];
#pragma unroll
    for (int q = 0; q < 2; ++q) {
      const int row = (row0 + q * nw < NTOK) ? row0 + q * nw : row0;
      rows[q] = row;
      const float4* xr = (const float4*)(x + (size_t)row * D);
      const float* mr = modl + (size_t)modrow(row) * 9216;
#pragma unroll
      for (int i = 0; i < 4; ++i) {
        v[q][i] = xr[i * 64 + lane];
        sc[q][i] = ((const float4*)(mr + sci * 1024))[i * 64 + lane];
        sh[q][i] = ((const float4*)(mr + shi * 1024))[i * 64 + lane];
      }
    }
    __builtin_amdgcn_sched_barrier(0);
#pragma unroll
    for (int q = 0; q < 2; ++q) {
      if (q == 1 && row0 + nw >= NTOK) break;
      float ss = 0.f;
#pragma unroll
      for (int i = 0; i < 4; ++i) ss += v[q][i].x * v[q][i].x + v[q][i].y * v[q][i].y + v[q][i].z * v[q][i].z + v[q][i].w * v[q][i].w;
      ss = wave_sum(ss);
      const float rstd = rsqrtf(ss * (1.f / 1024.f) + 1e-6f);
#pragma unroll
      for (int i = 0; i < 4; ++i) {
        const float4 g = g4[i], s = sc[q][i], bq = sh[q][i];
        float y0 = v[q][i].x * rstd * g.x * (1.f + s.x) + bq.x;
        float y1 = v[q][i].y * rstd * g.y * (1.f + s.y) + bq.y;
        float y2 = v[q][i].z * rstd * g.z * (1.f + s.z) + bq.z;
        float y3 = v[q][i].w * rstd * g.w * (1.f + s.w) + bq.w;
        uint2 o;
        o.x = f2bf(y0) | ((unsigned)f2bf(y1) << 16);
        o.y = f2bf(y2) | ((unsigned)f2bf(y3) << 16);
        *(uint2*)(h + (size_t)rows[q] * D + (i * 64 + lane) * 4) = o;
      }
    }
  }
}

__device__ __forceinline__ void phase_final_norm(const Params& p) {
  const int wave = otid() >> 6, lane = otid() & 63;
  const float* x = (const float*)(p.ws + OFF_X);
  const float4* g4 = (const float4*)p.in[I_FN];
  for (int row = obid() * 8 + wave; row < NTOK; row += gridDim.x * 8) {
    const float4* xr = (const float4*)(x + (size_t)row * D);
    float4 v[4];
    float ss = 0.f;
#pragma unroll
    for (int i = 0; i < 4; ++i) {
      v[i] = xr[i * 64 + lane];
      ss += v[i].x * v[i].x + v[i].y * v[i].y + v[i].z * v[i].z + v[i].w * v[i].w;
    }
    ss = wave_sum(ss);
    float rstd = rsqrtf(ss * (1.f / 1024.f) + 1e-6f);
    float4* o = (float4*)(p.out + (size_t)row * D);
#pragma unroll
    for (int i = 0; i < 4; ++i) {
      float4 g = g4[i * 64 + lane];
      o[i * 64 + lane] = make_float4(v[i].x * rstd * g.x, v[i].y * rstd * g.y, v[i].z * rstd * g.z, v[i].w * rstd * g.w);
    }
  }
}

namespace pg8 {
#define PG8_LAS __attribute__((address_space(3)))
typedef unsigned short bf16_t;
typedef short bf16x8 __attribute__((ext_vector_type(8)));
typedef float f32x4 __attribute__((ext_vector_type(4)));
typedef unsigned u32x4 __attribute__((ext_vector_type(4)));
constexpr int BM = 256, BK = 64, HALF = 128, HTB = HALF * BK * 2  , STAGE_BYTES = 8 * HTB, NXCD = 8, WGM = 8;

__host__ __device__ __forceinline__ int lds_byte(int r, int c) { const int st = (r >> 4) * 2 + (c >> 5), rr = r & 15, cc = c & 31, ob = rr * 64 + cc * 2; return st * 1024 + (ob ^ (((ob >> 9) & 1) << 5)); }
__host__ __device__ __forceinline__ void stage_rc(int b, int& R, int& C) { const int st = b / 1024, sb = b % 1024, swz = sb ^ (((sb >> 9) & 1) << 5); R = (st >> 1) * 16 + swz / 64; C = (st & 1) * 32 + (swz % 64) / 2; }
__host__ __device__ __forceinline__ int perm32(int rho) { const int n = rho >> 4, i = rho & 15; return 8 * (i >> 2) + 4 * n + (i & 3); }

struct Unit { int pm, pn; };
struct Gemm { const bf16_t* A; const bf16_t* Bt; int M, N, K; };

struct StaticOrder {
    int nM, nN, nwg, G, c;
    __host__ __device__ void init(int M, int N, int G_, int c_) { nM = M / BM; nN = N / BM; nwg = nM * nN; G = G_; c = c_; }
    __host__ __device__ bool next(int i, Unit& u) const {
        const long L = (long)i * G + c; if (L >= nwg) return false;
        int wgid = (int)L; { const int q = nwg / NXCD, r = nwg % NXCD, xcd = wgid % NXCD, off = wgid / NXCD; wgid = (xcd < r ? xcd * (q + 1) : r * (q + 1) + (xcd - r) * q) + off; }
        const int nig = WGM * nN, gid = wgid / nig, fm = gid * WGM, gsz = (nM - fm) < WGM ? (nM - fm) : WGM;
        u.pm = fm + ((wgid % nig) % gsz); u.pn = (wgid % nig) / gsz; return true;
    }
    __device__ __forceinline__ void a_ready(const Unit&) const {}
    __device__ __forceinline__ void done(const Unit&) const {}
};
__device__ __forceinline__ unsigned cvt_pk_bf16(float lo, float hi) { unsigned r; asm volatile("v_cvt_pk_bf16_f32 %0, %1, %2" : "=v"(r) : "v"(lo), "v"(hi)); return r; }

template <class Epi, class Sched, bool STAMP = false>
__device__ __forceinline__ void gemm_phase(PG8_LAS unsigned char* lds, const Gemm g, const Sched& S, const Epi& E, unsigned long long* stamps) {
    const int tid = otid(), wid = __builtin_amdgcn_readfirstlane(tid >> 6), lane = tid & 63, wr = wid >> 2, wc = wid & 3, fr = lane & 15, fq = lane >> 4;
    const int K = g.K, nt = K / BK;
    int ts_lo = 0, ts_hi = 0, nts = 0; const unsigned long long rt_entry = STAMP ? (unsigned long long)wall_clock64() : 0ull;
#define PG8_STAMP() do { if (STAMP && wid == 0 && nts < 64) { const unsigned long long _c = (unsigned long long)clock64(); \
        ts_lo = (lane == nts) ? (int)(unsigned)_c : ts_lo; ts_hi = (lane == nts) ? (int)(unsigned)(_c >> 32) : ts_hi; ++nts; } } while (0)
    PG8_STAMP();
    unsigned voffA[2], voffB[2];
#pragma unroll
    for (int i = 0; i < 2; ++i) { int R, C; stage_rc(tid * 16 + i * 8192, R, C); const int Rb = Epi::PERM ? ((R & ~31) + perm32(R & 31)) : R;
        voffA[i] = (unsigned)(R * K + C) * 2u; voffB[i] = (unsigned)(Rb * K + C) * 2u; }
    const size_t kstep = (size_t)(BK * 2);
    const size_t hstep = (size_t)HALF * K * 2;
    const size_t tstep = 2 * hstep;
    const unsigned ldsw = (unsigned)wid * 1024u;
    const int aoff = lds_byte(wr * 64 + fr, fq * 8), boff = lds_byte(wc * 32 + fr, fq * 8);
#define PG8_SA(b, h) (((b) * 2 + (h)) * HTB)
#define PG8_SB(b, h) ((4 + (b) * 2 + (h)) * HTB)
#define PG8_STAGE(bufoff, gbase, voff) do { _Pragma("unroll") for (int _i = 0; _i < 2; ++_i) \
        __builtin_amdgcn_global_load_lds((const unsigned*)((const char*)(gbase) + (voff)[_i]), (PG8_LAS unsigned*)(lds + (bufoff) + ldsw + _i * 8192), 16, 0, 0); } while (0)
#define PG8_LDA(dst, b, h) do { _Pragma("unroll") for (int m = 0; m < 4; ++m) _Pragma("unroll") for (int k = 0; k < 2; ++k) dst[m][k] = *(const PG8_LAS bf16x8*)(lds + PG8_SA(b, h) + aoff + m * 2048 + k * 1024); } while (0)
#define PG8_LDB(dst, b, h) do { _Pragma("unroll") for (int n = 0; n < 2; ++n) _Pragma("unroll") for (int k = 0; k < 2; ++k) dst[n][k] = *(const PG8_LAS bf16x8*)(lds + PG8_SB(b, h) + boff + n * 2048 + k * 1024); } while (0)
#define PG8_MMA(ai, bj, At, Bt) do { __builtin_amdgcn_s_setprio(1); _Pragma("unroll") for (int m = 0; m < 4; ++m) _Pragma("unroll") for (int n = 0; n < 2; ++n) _Pragma("unroll") for (int k = 0; k < 2; ++k) \
        acc[ai][bj][m][n] = __builtin_amdgcn_mfma_f32_16x16x32_bf16(Bt[n][k], At[m][k], acc[ai][bj][m][n], 0, 0, 0); __builtin_amdgcn_s_setprio(0); } while (0)
#define PG8_WAIT_V(n) asm volatile("s_waitcnt vmcnt(" #n ")" ::: "memory")
#define PG8_WAIT_L(n) asm volatile("s_waitcnt lgkmcnt(" #n ")" ::: "memory")
#define PG8_BAR __builtin_amdgcn_s_barrier()
#define PG8_SCHED __builtin_amdgcn_sched_barrier(0)
    Unit cur, nxt; int ui = 0;
    if (!S.next(0, cur)) return;
    f32x4 acc[2][2][4][2];
#pragma unroll
    for (int a = 0; a < 2; ++a)
#pragma unroll
        for (int b = 0; b < 2; ++b)
#pragma unroll
            for (int m = 0; m < 4; ++m)
#pragma unroll
                for (int n = 0; n < 2; ++n) acc[a][b][m][n] = (f32x4){0.f, 0.f, 0.f, 0.f};
    bf16x8 At[4][2], B0[2][2], B1[2][2];
    const char* cA = (const char*)g.A + (size_t)cur.pm * tstep; const char* cB = (const char*)g.Bt + (size_t)cur.pn * tstep;
    S.a_ready(cur);
    PG8_STAGE(PG8_SB(0, 0), cB, voffB); PG8_STAGE(PG8_SA(0, 0), cA, voffA); PG8_STAGE(PG8_SB(0, 1), cB + hstep, voffB); PG8_STAGE(PG8_SA(0, 1), cA + hstep, voffA);
    if (wr == 1) PG8_BAR;
    PG8_WAIT_V(4); PG8_BAR;
    PG8_STAGE(PG8_SB(1, 0), cB + kstep, voffB); PG8_STAGE(PG8_SA(1, 0), cA + kstep, voffA); PG8_STAGE(PG8_SB(1, 1), cB + hstep + kstep, voffB);
    PG8_WAIT_V(6); PG8_BAR;
    PG8_STAMP();
    for (;;) {
        const bool has_next = S.next(ui + 1, nxt);
        const char* nA = has_next ? (const char*)g.A + (size_t)nxt.pm * tstep : cA; const char* nB = has_next ? (const char*)g.Bt + (size_t)nxt.pn * tstep : cB;
        for (int t = 0; t < nt; t += 2) {
            const bool last = (t == nt - 2);
            const char* a1 = cA + (size_t)(t + 1) * kstep;
            const char* a2 = last ? nA : cA + (size_t)(t + 2) * kstep; const char* b2 = last ? nB : cB + (size_t)(t + 2) * kstep;
            const char* a3 = a2 + kstep; const char* b3 = b2 + kstep;
            if (last && has_next) S.a_ready(nxt);
            PG8_LDB(B0, 0, 0); PG8_SCHED; PG8_LDA(At, 0, 0); PG8_STAGE(PG8_SA(1, 1), a1 + hstep, voffA);
            PG8_WAIT_L(8); PG8_BAR; PG8_WAIT_L(0); PG8_MMA(0, 0, At, B0); PG8_BAR; PG8_SCHED;
            PG8_LDB(B1, 0, 1); PG8_STAGE(PG8_SB(0, 0), b2, voffB);
            PG8_BAR; PG8_WAIT_L(0); PG8_MMA(0, 1, At, B1); PG8_BAR;
            PG8_LDA(At, 0, 1); PG8_STAGE(PG8_SA(0, 0), a2, voffA);
            PG8_BAR; PG8_WAIT_L(0); PG8_MMA(1, 0, At, B0); PG8_BAR; PG8_SCHED;
            PG8_STAGE(PG8_SB(0, 1), b2 + hstep, voffB);
            PG8_WAIT_V(6); PG8_BAR; PG8_MMA(1, 1, At, B1); PG8_BAR;
            PG8_LDB(B0, 1, 0); PG8_SCHED; PG8_LDA(At, 1, 0); PG8_STAGE(PG8_SA(0, 1), a2 + hstep, voffA);
            PG8_WAIT_L(8); PG8_BAR; PG8_WAIT_L(0); PG8_MMA(0, 0, At, B0); PG8_BAR; PG8_SCHED;
            PG8_LDB(B1, 1, 1); PG8_STAGE(PG8_SB(1, 0), b3, voffB);
            PG8_BAR; PG8_WAIT_L(0); PG8_MMA(0, 1, At, B1); PG8_BAR;
            PG8_LDA(At, 1, 1); PG8_STAGE(PG8_SA(1, 0), a3, voffA);
            PG8_BAR; PG8_WAIT_L(0); PG8_MMA(1, 0, At, B0); PG8_BAR; PG8_SCHED;
            PG8_STAGE(PG8_SB(1, 1), b3 + hstep, voffB);
            PG8_WAIT_V(6); PG8_BAR; PG8_MMA(1, 1, At, B1); PG8_BAR;
        }
        PG8_STAMP();
        if constexpr (!Epi::AFTER_DRAIN) { E(acc, cur, wr, wc, fr, fq); S.done(cur); }
        PG8_STAMP();
        if (!has_next) break;
#pragma unroll
        for (int a = 0; a < 2; ++a)
#pragma unroll
            for (int b = 0; b < 2; ++b)
#pragma unroll
                for (int m = 0; m < 4; ++m)
#pragma unroll
                    for (int n = 0; n < 2; ++n) acc[a][b][m][n] = (f32x4){0.f, 0.f, 0.f, 0.f};
        cur = nxt; cA = nA; cB = nB; ++ui;
    }
    PG8_WAIT_V(0);
    if (wr == 0) PG8_BAR;
    PG8_BAR;
    if constexpr (Epi::AFTER_DRAIN) { E.fused(acc, cur, wr, wc, fr, fq, lds, wid, lane); S.done(cur); }
    PG8_STAMP();
    if (STAMP && wid == 0) { stamps[lane] = lane < nts ? (((unsigned long long)(unsigned)ts_hi << 32) | (unsigned)ts_lo) : 0ull;
        if (lane == 62) stamps[62] = rt_entry; if (lane == 63) stamps[63] = (unsigned long long)wall_clock64(); }
#undef PG8_STAMP
#undef PG8_SA
#undef PG8_SB
#undef PG8_STAGE
#undef PG8_LDA
#undef PG8_LDB
#undef PG8_MMA
#undef PG8_WAIT_V
#undef PG8_WAIT_L
#undef PG8_BAR
#undef PG8_SCHED
}
}

struct EpiSwiglu {
  static constexpr bool PERM = true, AFTER_DRAIN = false;
  unsigned short* H;
  __device__ __forceinline__ void operator()(const pg8::f32x4 (&acc)[2][2][4][2], const pg8::Unit& u, int wr, int wc, int fr, int fq) const {
    const int row0 = u.pm * 256 + wr * 64 + fr, hc0 = u.pn * 128 + wc * 32 + 8 * fq;
#pragma unroll
    for (int ai = 0; ai < 2; ++ai)
#pragma unroll
      for (int m = 0; m < 4; ++m) {
        unsigned short* rowp = H + (size_t)(row0 + ai * 128 + m * 16) * FH + hc0;
        float v[8];
#pragma unroll
        for (int n = 0; n < 2; ++n)
#pragma unroll
          for (int i = 0; i < 4; ++i) v[n * 4 + i] = siluf_(acc[ai][0][m][n][i]) * acc[ai][1][m][n][i];
        pg8::u32x4 o;
        o[0] = pg8::cvt_pk_bf16(v[0], v[1]); o[1] = pg8::cvt_pk_bf16(v[2], v[3]);
        o[2] = pg8::cvt_pk_bf16(v[4], v[5]); o[3] = pg8::cvt_pk_bf16(v[6], v[7]);
        *(pg8::u32x4*)rowp = o;
      }
  }
};
struct EpiResid {
  static constexpr bool PERM = false, AFTER_DRAIN = false;
  float* X; const float* modl; int gidx; float scale;
  __device__ __forceinline__ void operator()(const pg8::f32x4 (&acc)[2][2][4][2], const pg8::Unit& u, int wr, int wc, int fr, int fq) const {
    const int row0 = u.pm * 256 + wr * 64 + fr, col0 = u.pn * 256 + wc * 32 + 4 * fq;
#pragma unroll
    for (int ai = 0; ai < 2; ++ai)
#pragma unroll
      for (int m = 0; m < 4; ++m) {
        const int row = row0 + ai * 128 + m * 16;
        const float* gt = modl + (size_t)modrow(row) * 9216 + gidx * 1024 + col0;
        float* xp = X + (size_t)row * D + col0;
        pg8::f32x4 gv[2][2], xv[2][2];
#pragma unroll
        for (int bj = 0; bj < 2; ++bj)
#pragma unroll
          for (int n = 0; n < 2; ++n) {
            gv[bj][n] = *(const pg8::f32x4*)(gt + bj * 128 + n * 16);
            xv[bj][n] = *(const pg8::f32x4*)(xp + bj * 128 + n * 16);
          }
#pragma unroll
        for (int bj = 0; bj < 2; ++bj)
#pragma unroll
          for (int n = 0; n < 2; ++n) *(pg8::f32x4*)(xp + bj * 128 + n * 16) = xv[bj][n] + (gv[bj][n] * scale) * acc[ai][bj][m][n];
      }
  }
};
struct EpiP {
  static constexpr bool PERM = false, AFTER_DRAIN = false;
  float* P;
  __device__ __forceinline__ void operator()(const pg8::f32x4 (&acc)[2][2][4][2], const pg8::Unit& u, int wr, int wc, int fr, int fq) const {
    const int row0 = u.pm * 256 + wr * 64 + fr, col0 = u.pn * 256 + wc * 32 + 4 * fq;
#pragma unroll
    for (int ai = 0; ai < 2; ++ai)
#pragma unroll
      for (int m = 0; m < 4; ++m) {
        float* rp = P + (size_t)(row0 + ai * 128 + m * 16) * INC;
#pragma unroll
        for (int bj = 0; bj < 2; ++bj)
#pragma unroll
          for (int n = 0; n < 2; ++n) {
            const int col = col0 + bj * 128 + n * 16;
            if (col < INC) *(pg8::f32x4*)(rp + col) = acc[ai][bj][m][n];
          }
      }
  }
};

template <class Epi>
__device__ __forceinline__ void phase_gemm(const void* A, const void* Bt, int N, int K, const Epi& E) {
  pg8::Gemm g; g.A = (const pg8::bf16_t*)A; g.Bt = (const pg8::bf16_t*)Bt; g.M = NTOK; g.N = N; g.K = K;
  int c_ = obid(), G_ = (int)gridDim.x;
  asm volatile("" : "+s"(c_), "+s"(G_));
  pg8::StaticOrder S; S.init(NTOK, N, G_, c_);
  pg8::gemm_phase<Epi, pg8::StaticOrder, false>((PG8_LAS unsigned char*)smem, g, S, E, nullptr);
  __syncthreads();
}

__device__ __forceinline__ int scan2tok(int R) {
  if (R < NCTX) return R;
  int q = R - NCTX, b = q >> 10, n = q & 1023;
  return NCTX + b * 1024 + (n & 15) * 64 + (n >> 4);
}

__device__ __forceinline__ float rw_shift(const float* P, int R, int n, int L, int c, float mu) {
  float pc = P[(size_t)scan2tok(R) * INC + C_RW + c];
  float pp = n > 0 ? P[(size_t)scan2tok(R - 1) * INC + C_RW + c] : 0.f;
  float pn = n < L - 1 ? P[(size_t)scan2tok(R + 1) * INC + C_RW + c] : 0.f;
  return pc + (0.5f * (pp + pn) - pc) * mu;
}

__device__ __forceinline__ float rdlane(float v, int l) { return __int_as_float(__builtin_amdgcn_readlane(__float_as_int(v), l)); }

__device__ __forceinline__ void prep_rwkv(const Params& p, int l) {
  const int wave = otid() >> 6, lane = otid() & 63;
  const float* P = (const float*)(p.ws + OFF_P);
  float* rec = (float*)(p.ws + OFF_REC);
  const float* mu = p.in[I_RMU] + l * 1312;
  const float* w0 = p.in[I_RW0] + l * 768;
  const float* w2 = p.in[I_RW2] + (size_t)l * 64 * 384;
  const float* a0 = p.in[I_RA0] + l * 384;
  const float* a2 = p.in[I_RA2] + (size_t)l * 32 * 384;
  const float* g2 = p.in[I_RG2] + (size_t)l * 64 * 384;
  const float* kkw = p.in[I_RKK] + l * 384;
  const float* kaw = p.in[I_RKA] + l * 384;
  float* wl = (float*)smem;
#pragma unroll 1
  for (int hp = 0; hp < 2; ++hp) {
    const int hb = hp * 3;
    __syncthreads();
    for (int i = otid(); i < 160 * 48; i += NTHR) {
      const int r = i / 48, c4 = (i % 48) * 4;
      const float* src = (r < 64 ? w2 + r * 384 : (r < 96 ? a2 + (r - 64) * 384 : g2 + (r - 96) * 384)) + hb * 64 + c4;
      *(float4*)(wl + r * 192 + c4) = *(const float4*)src;
    }
    __syncthreads();
    for (int task = obid() * 8 + wave; task < NTOK / 6; task += gridDim.x * 8) {
      const int R0 = task * 6;
      int nn[6], LL[6];
#pragma unroll
      for (int tp = 0; tp < 6; ++tp) {
        const int R = R0 + tp;
        if (R < NCTX) { nn[tp] = R & 255; LL[tp] = 256; } else { nn[tp] = (R - NCTX) & 1023; LL[tp] = 1024; }
      }
      float x0[6], x1[6], x2[6];
#pragma unroll
      for (int tp = 0; tp < 6; ++tp) {
        x0[tp] = rw_shift(P, R0 + tp, nn[tp], LL[tp], 1152 + lane, mu[1152 + lane]);
        x1[tp] = rw_shift(P, R0 + tp, nn[tp], LL[tp], 1216 + lane, mu[1216 + lane]);
        const int c2 = 1280 + (lane & 31);
        x2[tp] = rw_shift(P, R0 + tp, nn[tp], LL[tp], c2, mu[c2]);
        if (tp & 1) __builtin_amdgcn_sched_barrier(0);
      }
      float kx[3][6];
#pragma unroll
      for (int h = 0; h < 3; ++h) {
        const int c = (hb + h) * 64 + lane;
#pragma unroll
        for (int tp = 0; tp < 6; ++tp) {
          kx[h][tp] = rw_shift(P, R0 + tp, nn[tp], LL[tp], 384 + c, mu[384 + c]);
        }
      }
#pragma unroll
      for (int tp = 0; tp < 6; ++tp) {
        x0[tp] = tanhf(x0[tp]);
        x1[tp] = lane < 32 ? x1[tp] : sigmoidf_(x1[tp]);
        x2[tp] = sigmoidf_(x2[tp]);
      }
      float af[3][6], ab[3][6], aa[3][6], ag[3][6];
#pragma unroll
      for (int h = 0; h < 3; ++h)
#pragma unroll
        for (int tp = 0; tp < 6; ++tp) { af[h][tp] = 0.f; ab[h][tp] = 0.f; aa[h][tp] = 0.f; ag[h][tp] = 0.f; }
      const float* wlp = wl + lane;
      for (int j = 0; j < 32; ++j) {
        float wc[15];
#pragma unroll
        for (int h = 0; h < 3; ++h) {
          wc[h] = wlp[j * 192 + h * 64]; wc[3 + h] = wlp[(32 + j) * 192 + h * 64];
          wc[6 + h] = wlp[(64 + j) * 192 + h * 64]; wc[9 + h] = wlp[(96 + j) * 192 + h * 64]; wc[12 + h] = wlp[(128 + j) * 192 + h * 64];
        }
#pragma unroll
        for (int tp = 0; tp < 6; ++tp) {
          const float sf = rdlane(x0[tp], j), sb = rdlane(x0[tp], 32 + j), sA = rdlane(x1[tp], j), sg = rdlane(x1[tp], 32 + j), sh = rdlane(x2[tp], j);
#pragma unroll
          for (int h = 0; h < 3; ++h) {
            af[h][tp] += sf * wc[h]; ab[h][tp] += sb * wc[3 + h]; aa[h][tp] += sA * wc[6 + h];
            ag[h][tp] += sg * wc[9 + h]; ag[h][tp] += sh * wc[12 + h];
          }
        }
      }
      int R0e = R0;
      asm volatile("" : "+v"(R0e));
#pragma unroll
      for (int h = 0; h < 3; ++h) {
        const int c = (hb + h) * 64 + lane;
#pragma unroll
        for (int tp = 0; tp < 6; ++tp) {
          const int R = R0e + tp;
          const float kxv = kx[h][tp];
          const float aav = aa[h][tp], afv = af[h][tp], abv = ab[h][tp], agv = ag[h][tp];
          float a = sigmoidf_(a0[c] + aav);
          float kk = kxv * kkw[c];
          float ss = wave_sum(kk * kk);
          kk = kk * rsqrtf(fmaxf(ss, 1e-24f));
          float k2 = kxv * (1.f + (a - 1.f) * kaw[c]);
          float uf = w0[c] + afv, ub = w0[384 + c] + abv;
          float df = expf(-0.6065306597126334f * sigmoidf_(uf));
          float db = expf(-0.6065306597126334f * sigmoidf_(ub));
          const float r_ = rw_shift(P, R, nn[tp], LL[tp], c, mu[c]);
          const float v_ = rw_shift(P, R, nn[tp], LL[tp], 768 + c, mu[768 + c]);
          float* o = rec + ((size_t)R * 6 + hb + h) * 512 + lane;
          o[0] = r_; o[128] = v_;
          o[64] = k2; o[192] = -kk; o[256] = kk * a; o[320] = df; o[384] = db; o[448] = agv;
        }
      }
    }
  }
  __syncthreads();
}

__device__ __forceinline__ float logsigmoidf_(float x) { return fminf(x, 0.f) - log1pf(expf(-fabsf(x))); }

__device__ __forceinline__ void prep_gla(const Params& p, int l) {
  const int wave = otid() >> 6, lane = otid() & 63;
  const float* P = (const float*)(p.ws + OFF_P);
  float* grec = (float*)(p.ws + OFF_GREC);
  const float* w2 = p.in[I_GW2] + (size_t)l * 2 * 16 * 192;
  const float* ab = p.in[I_GB] + l * 384;
  const int z = lane >> 5, d = lane & 31;
  float wreg[6][16], breg[6];
#pragma unroll
  for (int h = 0; h < 6; ++h) {
    breg[h] = ab[z * 192 + h * 32 + d];
#pragma unroll
    for (int r = 0; r < 16; ++r) wreg[h][r] = w2[(z * 16 + r) * 192 + h * 32 + d];
  }
  for (int tok = obid() * 8 + wave; tok < NTOK; tok += gridDim.x * 8) {
    const float* pr = P + (size_t)tok * INC;
    float lr[16];
#pragma unroll
    for (int r4 = 0; r4 < 4; ++r4) {
      float4 v = *(const float4*)(pr + 1152 + z * 16 + r4 * 4);
      lr[r4 * 4 + 0] = v.x; lr[r4 * 4 + 1] = v.y; lr[r4 * 4 + 2] = v.z; lr[r4 * 4 + 3] = v.w;
    }
    float qk[6], vv[6], gg[6];
#pragma unroll
    for (int h = 0; h < 6; ++h) {
      qk[h] = lane < 32 ? pr[h * 32 + lane] : pr[192 + h * 32 + (lane - 32)];
      vv[h] = pr[384 + h * 64 + lane];
      gg[h] = pr[768 + h * 64 + lane];
    }
    __builtin_amdgcn_sched_barrier(0);
#pragma unroll
    for (int h = 0; h < 6; ++h) {
      float acc = breg[h];
#pragma unroll
      for (int r = 0; r < 16; ++r) acc += lr[r] * wreg[h][r];
      float alpha = expf(logsigmoidf_(acc) * (1.f / 16.f));
      float* o = grec + ((size_t)tok * 6 + h) * 256 + lane;
      o[0] = lane < 32 ? qk[h] * 0.17677669529663687f : qk[h];
      o[64] = alpha; o[128] = vv[h]; o[192] = gg[h];
    }
  }
}

__device__ __forceinline__ void prep_hyena(const Params& p, int l) {
  const float* P = (const float*)(p.ws + OFF_P);
  float* hz = (float*)(p.ws + OFF_HYZ);
  float* hx = (float*)(p.ws + OFF_HYX);
  const float* cw = p.in[I_HCW] + l * 3 * 768;
  const float* cb = p.in[I_HCB] + l * 768;
  const int c = otid() & 255, rsub = otid() >> 8;
  float w_[3][3], b_[3];
#pragma unroll
  for (int s = 0; s < 3; ++s) { b_[s] = cb[s * 256 + c]; for (int t = 0; t < 3; ++t) w_[s][t] = cw[t * 768 + s * 256 + c]; }
  for (int r0 = obid() * 8; r0 < NTOK; r0 += gridDim.x * 8) {
    float pv[4][3][3];
    int rows[4];
#pragma unroll
    for (int q = 0; q < 4; ++q) {
      const int row = r0 + q * 2 + rsub;
      rows[q] = row;
      int t, L;
      if (row < NCTX) { t = row & 255; L = 256; } else { t = (row - NCTX) & 1023; L = 1024; }
      const float* pc = P + (size_t)row * INC + C_HY + c;
#pragma unroll
      for (int s = 0; s < 3; ++s) {
        pv[q][s][1] = pc[s * 256];
        pv[q][s][0] = t > 0 ? pc[s * 256 - INC] : 0.f;
        pv[q][s][2] = t < L - 1 ? pc[s * 256 + INC] : 0.f;
      }
    }
#pragma unroll
    for (int q = 0; q < 4; ++q) {
      float u[3];
#pragma unroll
      for (int s = 0; s < 3; ++s) u[s] = pv[q][s][0] * w_[s][0] + pv[q][s][1] * w_[s][1] + pv[q][s][2] * w_[s][2] + b_[s];
      hx[(size_t)rows[q] * 256 + c] = u[0];
      hz[(size_t)rows[q] * 256 + c] = u[1] * u[2];
      ((unsigned short*)(p.ws + OFF_HZB))[(size_t)rows[q] * 256 + c] = f2bf(u[1] * u[2]);
    }
  }
}

__device__ __forceinline__ void glds16(const void* g, void* l) {
  __builtin_amdgcn_global_load_lds((const unsigned*)g, (unsigned*)l, 16, 0, 0);
}

#define VMW(n) asm volatile("s_waitcnt vmcnt(" #n ")" ::: "memory")
#define LGKM0 __builtin_amdgcn_s_waitcnt(0xC07F)
__device__ __forceinline__ float quad_sum(float x) {
  x += __int_as_float(__builtin_amdgcn_update_dpp(0, __float_as_int(x), 0xB1, 0xF, 0xF, true));
  x += __int_as_float(__builtin_amdgcn_update_dpp(0, __float_as_int(x), 0x4E, 0xF, 0xF, true));
  return x;
}

template <int R> struct RwOps { f32x4 A[2], B[2], K[2], W[2], Rr[2]; float v[R]; };
constexpr int RW_SLOT = 1536;
__device__ __forceinline__ void rw_fill(const float* recg, char* slot, int lane, int dir) {
  glds16((const char*)recg + lane * 16, slot);
  if (lane < 32) {
    const char* g2 = (const char*)recg + (lane < 16 ? 1024 + lane * 16 : (5 + dir) * 256 + (lane - 16) * 16);
    glds16(g2, slot + 1024);
  }
}
template <int R>
__device__ __forceinline__ void rw_load(RwOps<R>& o, const char* rec, int k8, int vrow) {
  const f32x4* q = (const f32x4*)rec + k8 * 2;
#pragma unroll
  for (int i = 0; i < 2; ++i) { o.Rr[i] = q[i]; o.K[i] = q[16 + i]; o.A[i] = q[48 + i]; o.B[i] = q[64 + i]; o.W[i] = q[80 + i]; }
  if (R == 2) { f32x2 t = *(const f32x2*)((const float*)rec + 128 + vrow); o.v[0] = t.x; o.v[R - 1] = t.y; }
  else o.v[0] = ((const float*)rec)[128 + vrow];
}
template <int R>
__device__ __forceinline__ void rw_step(f32x2 (&S)[R][4], const RwOps<R>& o, float (&res)[R]) {
  const f32x2 A0 = {o.A[0][0], o.A[0][1]}, A1 = {o.A[0][2], o.A[0][3]}, A2 = {o.A[1][0], o.A[1][1]}, A3 = {o.A[1][2], o.A[1][3]};
  float sa[R];
#pragma unroll
  for (int r = 0; r < R; ++r) {
    f32x2 p0 = S[r][0] * A0, q0 = S[r][1] * A1;
    p0 += S[r][2] * A2; q0 += S[r][3] * A3;
    p0 += q0;
    sa[r] = p0.x + p0.y;
  }
#pragma unroll
  for (int r = 0; r < R; ++r) sa[r] += dpp_f(sa[r], 0);
#pragma unroll
  for (int r = 0; r < R; ++r) sa[r] += dpp_f(sa[r], 1);
#pragma unroll
  for (int r = 0; r < R; ++r) sa[r] += dpp_f(sa[r], 2);
#pragma unroll
  for (int i = 0; i < 4; ++i) {
    const f32x2 W = {o.W[i >> 1][(i & 1) * 2], o.W[i >> 1][(i & 1) * 2 + 1]};
    const f32x2 B = {o.B[i >> 1][(i & 1) * 2], o.B[i >> 1][(i & 1) * 2 + 1]};
    const f32x2 K = {o.K[i >> 1][(i & 1) * 2], o.K[i >> 1][(i & 1) * 2 + 1]};
#pragma unroll
    for (int r = 0; r < R; ++r) S[r][i] = S[r][i] * W + (f32x2{sa[r], sa[r]} * B + f32x2{o.v[r], o.v[r]} * K);
  }
  const f32x2 R0 = {o.Rr[0][0], o.Rr[0][1]}, R1 = {o.Rr[0][2], o.Rr[0][3]}, R2 = {o.Rr[1][0], o.Rr[1][1]}, R3 = {o.Rr[1][2], o.Rr[1][3]};
#pragma unroll
  for (int r = 0; r < R; ++r) {
    f32x2 u0 = S[r][0] * R0, w0 = S[r][1] * R1;
    u0 += S[r][2] * R2; w0 += S[r][3] * R3;
    u0 += w0;
    res[r] = u0.x + u0.y;
  }
#pragma unroll
  for (int r = 0; r < R; ++r) res[r] += dpp_f(res[r], 0);
#pragma unroll
  for (int r = 0; r < R; ++r) res[r] += dpp_f(res[r], 1);
#pragma unroll
  for (int r = 0; r < R; ++r) res[r] += dpp_f(res[r], 2);
}

template <int NW>
__device__ __forceinline__ void rw_poll(volatile unsigned* f, unsigned target) {
  for (unsigned sp = 0; sp < (1u << 20); ++sp) {
    unsigned m = min(min(f[0], f[1]), min(f[2], f[3]));
    if (NW == 8) m = min(m, min(min(f[4], f[5]), min(f[6], f[7])));
    if ((unsigned)__builtin_amdgcn_readfirstlane((int)m) >= target) break;
    __builtin_amdgcn_s_sleep(1);
  }
  asm volatile("" ::: "memory");
}

constexpr int RQ_STEPS = 64;
template <int NW, int R, int RING>
__device__ __forceinline__ void rwkv_scan(const Params& p, int l, int scan, int w, int rowoff, char* ring, volatile unsigned* fl) {
  constexpr int LPC = 8 / NW;
  constexpr int NCHR = RING / 8;
  static_assert(NW == 4 && (RING == 64 || RING == 32), "vmcnt immediates below are written for these cases");
  const int lane = otid() & 63;
  scan = __builtin_amdgcn_readfirstlane(scan);
  w = __builtin_amdgcn_readfirstlane(w);
  int b, hd, L, rowbase;
  const bool lat = scan < 96;
  if (lat) { b = scan / 12; hd = scan % 12; L = 1024; rowbase = NCTX + b * 1024; }
  else { int t2 = scan - 96; b = t2 / 12; hd = t2 % 12; L = 256; rowbase = b * 256; }
  const int h = hd >> 1, dir = hd & 1;
  const int k8 = lane & 7, vrow = rowoff + w * (8 * R) + (lane >> 3) * R;
  const float* rec = (const float*)(p.ws + OFF_REC);
  float* RO = (float*)(p.ws + OFF_RO) + (size_t)dir * NTOK * 384 + h * 64 + vrow + (R == 2 ? (k8 & 1) : 0);
  f32x2 S[R][4];
  if (lat) {
    const float* sb = p.in[I_SR] + ((((size_t)b * DEPTH + l) * 2 + dir) * 6 + h) * 4096 + vrow * 64 + k8 * 8;
#pragma unroll
    for (int r = 0; r < R; ++r)
#pragma unroll
      for (int i = 0; i < 2; ++i) { float4 v = *(const float4*)(sb + r * 64 + i * 4); S[r][2 * i] = f32x2{v.x, v.y}; S[r][2 * i + 1] = f32x2{v.z, v.w}; }
  } else {
#pragma unroll
    for (int r = 0; r < R; ++r)
#pragma unroll
      for (int i = 0; i < 4; ++i) S[r][i] = f32x2{0.f, 0.f};
  }
  VMW(0);
  const int NCH = L >> 3;
#define RW_REC(st) (rec + ((size_t)(rowbase + (dir ? L - 1 - (st) : (st))) * 6 + h) * 512)
#define RW_SLOTP(st) (ring + ((st) & (RING - 1)) * RW_SLOT)
#pragma unroll
  for (int c = 0; c < NCHR - 1; ++c)
#pragma unroll
    for (int t = 0; t < LPC; ++t) { const int s = 8 * c + NW * t + w; rw_fill(RW_REC(s), RW_SLOTP(s), lane, dir); }
  RwOps<R> oa{};
  float osel = 0.f;
  for (int c = 0; c < NCH; ++c) {
    if (c + NCHR - 2 <= NCH - 1) { if (RING == 64) VMW(20); else VMW(4); } else VMW(0);
    if (lane == 0) fl[w] = (unsigned)(c + 2);
    rw_poll<NW>(fl, (unsigned)(c + 2));
    if (c == 0) rw_load<R>(oa, RW_SLOTP(0), k8, vrow);
    for (int j = 0; j < 8; j += 2) {
      const int s = 8 * c + j;
      RwOps<R> ob;
      LGKM0;
      rw_load<R>(ob, RW_SLOTP(s + 1), k8, vrow);
      __builtin_amdgcn_sched_barrier(0);
      {
        float o[R];
        rw_step<R>(S, oa, o);
        if (R == 2) osel = ((s & 3) == (k8 >> 1)) ? ((k8 & 1) ? o[R - 1] : o[0]) : osel;
        else osel = ((s & 7) == k8) ? o[0] : osel;
      }
      __builtin_amdgcn_sched_barrier(0);
      LGKM0;
      rw_load<R>(oa, RW_SLOTP(s + 2), k8, vrow);
      __builtin_amdgcn_sched_barrier(0);
      {
        float o[R];
        rw_step<R>(S, ob, o);
        if (R == 2) {
          osel = (((s + 1) & 3) == (k8 >> 1)) ? ((k8 & 1) ? o[R - 1] : o[0]) : osel;
          if (((s + 1) & 3) == 3) {
            const int st = s - 2 + (k8 >> 1);
            const int n = dir ? L - 1 - st : st;
            RO[(size_t)(rowbase + n) * 384] = osel;
          }
        } else {
          osel = (((s + 1) & 7) == k8) ? o[0] : osel;
          if (((s + 1) & 7) == 7) {
            const int st = s - 6 + k8;
            const int n = dir ? L - 1 - st : st;
            RO[(size_t)(rowbase + n) * 384] = osel;
          }
        }
      }
      __builtin_amdgcn_sched_barrier(0);
    }
    asm volatile("" ::: "memory");
    if (lane == 0) fl[8 + w] = (unsigned)(c + 1);
    if (c + NCHR - 1 < NCH) {
      rw_poll<NW>(fl + 8, (unsigned)c);
#pragma unroll
      for (int t = 0; t < LPC; ++t) { const int s = 8 * (c + NCHR - 1) + NW * t + w; rw_fill(RW_REC(s), RW_SLOTP(s), lane, dir); }
    }
  }
#undef RW_REC
#undef RW_SLOTP
  if (!lat) {
    float* so = p.out + (size_t)NTOK * D + (size_t)16 * DEPTH * 2 * 6 * 2048 +
                ((((size_t)b * DEPTH + l) * 2 + dir) * 6 + h) * 4096 + vrow * 64 + k8 * 8;
#pragma unroll
    for (int r = 0; r < R; ++r)
#pragma unroll
      for (int i = 0; i < 2; ++i) *(float4*)(so + r * 64 + i * 4) = make_float4(S[r][2 * i].x, S[r][2 * i].y, S[r][2 * i + 1].x, S[r][2 * i + 1].y);
  }
  VMW(0);
}

struct RwOpsLa { f32x4 An[2], B[2], K[2], W[2], Rr[2]; float v; };
__device__ __forceinline__ void rw_load_la(RwOpsLa& o, const char* rec, const char* recn, int k8, int vrow) {
  const f32x4* q = (const f32x4*)rec + k8 * 2;
  const f32x4* qn = (const f32x4*)recn + k8 * 2;
#pragma unroll
  for (int i = 0; i < 2; ++i) { o.Rr[i] = q[i]; o.K[i] = q[16 + i]; o.B[i] = q[64 + i]; o.W[i] = q[80 + i]; o.An[i] = qn[48 + i]; }
  o.v = ((const float*)rec)[128 + vrow];
}
__device__ __forceinline__ float rw_step_la(f32x2 (&S)[4], float& sa, const RwOpsLa& o) {
  f32x2 W2[4], B2[4], K2[4], A2[4], R2[4];
#pragma unroll
  for (int i = 0; i < 4; ++i) {
    const int a = i >> 1, c = (i & 1) * 2;
    W2[i] = f32x2{o.W[a][c], o.W[a][c + 1]}; B2[i] = f32x2{o.B[a][c], o.B[a][c + 1]}; K2[i] = f32x2{o.K[a][c], o.K[a][c + 1]};
    A2[i] = f32x2{o.An[a][c], o.An[a][c + 1]}; R2[i] = f32x2{o.Rr[a][c], o.Rr[a][c + 1]};
  }
  const f32x2 vv = {o.v, o.v};
  f32x2 T[4];
#pragma unroll
  for (int i = 0; i < 4; ++i) T[i] = S[i] * W2[i] + vv * K2[i];
  f32x2 g0 = T[0] * A2[0], g1 = T[1] * A2[1];
  g0 += T[2] * A2[2]; g1 += T[3] * A2[3]; g0 += g1;
  f32x2 b0 = B2[0] * A2[0], b1 = B2[1] * A2[1];
  b0 += B2[2] * A2[2]; b1 += B2[3] * A2[3]; b0 += b1;
  float gp = g0.x + g0.y, bp = b0.x + b0.y;
  gp += dpp_f(gp, 0); bp += dpp_f(bp, 0);
  gp += dpp_f(gp, 1); bp += dpp_f(bp, 1);
  gp += dpp_f(gp, 2); bp += dpp_f(bp, 2);
  const f32x2 sav = {sa, sa};
#pragma unroll
  for (int i = 0; i < 4; ++i) S[i] = sav * B2[i] + T[i];
  f32x2 u0 = S[0] * R2[0], u1 = S[1] * R2[1];
  u0 += S[2] * R2[2]; u1 += S[3] * R2[3]; u0 += u1;
  float ov = u0.x + u0.y;
  ov += dpp_f(ov, 0); ov += dpp_f(ov, 1); ov += dpp_f(ov, 2);
  sa = sa * bp + gp;
  return ov;
}

__device__ __forceinline__ void rwkv_scan_la(const Params& p, int l, int scan, int w, int rowoff, char* ring, volatile unsigned* fl) {
  constexpr int NW = 4, R = 1, RING = 64;
  constexpr int LPC = 8 / NW;
  constexpr int NCHR = RING / 8;
  static_assert(NW == 4 && (RING == 64 || RING == 32), "vmcnt immediates below are written for these cases");
  const int lane = otid() & 63;
  scan = __builtin_amdgcn_readfirstlane(scan);
  w = __builtin_amdgcn_readfirstlane(w);
  int b, hd, L, rowbase;
  const bool lat = scan < 96;
  if (lat) { b = scan / 12; hd = scan % 12; L = 1024; rowbase = NCTX + b * 1024; }
  else { int t2 = scan - 96; b = t2 / 12; hd = t2 % 12; L = 256; rowbase = b * 256; }
  const int h = hd >> 1, dir = hd & 1;
  const int k8 = lane & 7, vrow = rowoff + w * (8 * R) + (lane >> 3) * R;
  const float* rec = (const float*)(p.ws + OFF_REC);
  float* RO = (float*)(p.ws + OFF_RO) + (size_t)dir * NTOK * 384 + h * 64 + vrow + (R == 2 ? (k8 & 1) : 0);
  f32x2 S[R][4];
  if (lat) {
    const float* sb = p.in[I_SR] + ((((size_t)b * DEPTH + l) * 2 + dir) * 6 + h) * 4096 + vrow * 64 + k8 * 8;
#pragma unroll
    for (int r = 0; r < R; ++r)
#pragma unroll
      for (int i = 0; i < 2; ++i) { float4 v = *(const float4*)(sb + r * 64 + i * 4); S[r][2 * i] = f32x2{v.x, v.y}; S[r][2 * i + 1] = f32x2{v.z, v.w}; }
  } else {
#pragma unroll
    for (int r = 0; r < R; ++r)
#pragma unroll
      for (int i = 0; i < 4; ++i) S[r][i] = f32x2{0.f, 0.f};
  }
  VMW(0);
  const int NCH = L >> 3;
#define RW_REC(st) (rec + ((size_t)(rowbase + (dir ? L - 1 - (st) : (st))) * 6 + h) * 512)
#define RW_SLOTP(st) (ring + ((st) & (RING - 1)) * RW_SLOT)
#pragma unroll
  for (int c = 0; c < NCHR - 1; ++c)
#pragma unroll
    for (int t = 0; t < LPC; ++t) { const int s = 8 * c + NW * t + w; rw_fill(RW_REC(s), RW_SLOTP(s), lane, dir); }
  RwOpsLa oa{};
  float sa = 0.f;
  float osel = 0.f;
  for (int c = 0; c < NCH; ++c) {
    if (c + NCHR - 2 <= NCH - 1) { if (RING == 64) VMW(20); else VMW(4); } else VMW(0);
    if (lane == 0) fl[w] = (unsigned)(c + 2);
    rw_poll<NW>(fl, (unsigned)(c + 2));
    if (c == 0) {
      const f32x4* q0 = (const f32x4*)RW_SLOTP(0) + k8 * 2;
      const f32x4 a0 = q0[48], a1 = q0[49];
      f32x2 d0 = S[0][0] * f32x2{a0[0], a0[1]}, d1 = S[0][1] * f32x2{a0[2], a0[3]};
      d0 += S[0][2] * f32x2{a1[0], a1[1]}; d1 += S[0][3] * f32x2{a1[2], a1[3]};
      d0 += d1;
      sa = d0.x + d0.y;
      sa += dpp_f(sa, 0); sa += dpp_f(sa, 1); sa += dpp_f(sa, 2);
      rw_load_la(oa, RW_SLOTP(0), RW_SLOTP(1), k8, vrow);
    }
    for (int j = 0; j < 8; j += 2) {
      const int s = 8 * c + j;
      RwOpsLa ob;
      LGKM0;
      rw_load_la(ob, RW_SLOTP(s + 1), RW_SLOTP(s + 2), k8, vrow);
      __builtin_amdgcn_sched_barrier(0);
      {
        float o[R];
        o[0] = rw_step_la(S[0], sa, oa);
        if (R == 2) osel = ((s & 3) == (k8 >> 1)) ? ((k8 & 1) ? o[R - 1] : o[0]) : osel;
        else osel = ((s & 7) == k8) ? o[0] : osel;
      }
      __builtin_amdgcn_sched_barrier(0);
      LGKM0;
      rw_load_la(oa, RW_SLOTP(s + 2), RW_SLOTP(s + 3), k8, vrow);
      __builtin_amdgcn_sched_barrier(0);
      {
        float o[R];
        o[0] = rw_step_la(S[0], sa, ob);
        if (R == 2) {
          osel = (((s + 1) & 3) == (k8 >> 1)) ? ((k8 & 1) ? o[R - 1] : o[0]) : osel;
          if (((s + 1) & 3) == 3) {
            const int st = s - 2 + (k8 >> 1);
            const int n = dir ? L - 1 - st : st;
            RO[(size_t)(rowbase + n) * 384] = osel;
          }
        } else {
          osel = (((s + 1) & 7) == k8) ? o[0] : osel;
          if (((s + 1) & 7) == 7) {
            const int st = s - 6 + k8;
            const int n = dir ? L - 1 - st : st;
            RO[(size_t)(rowbase + n) * 384] = osel;
          }
        }
      }
      __builtin_amdgcn_sched_barrier(0);
    }
    asm volatile("" ::: "memory");
    if (lane == 0) fl[8 + w] = (unsigned)(c + 1);
    if (c + NCHR - 1 < NCH) {
      rw_poll<NW>(fl + 8, (unsigned)c);
#pragma unroll
      for (int t = 0; t < LPC; ++t) { const int s = 8 * (c + NCHR - 1) + NW * t + w; rw_fill(RW_REC(s), RW_SLOTP(s), lane, dir); }
    }
  }
#undef RW_REC
#undef RW_SLOTP
  if (!lat) {
    float* so = p.out + (size_t)NTOK * D + (size_t)16 * DEPTH * 2 * 6 * 2048 +
                ((((size_t)b * DEPTH + l) * 2 + dir) * 6 + h) * 4096 + vrow * 64 + k8 * 8;
#pragma unroll
    for (int r = 0; r < R; ++r)
#pragma unroll
      for (int i = 0; i < 2; ++i) *(float4*)(so + r * 64 + i * 4) = make_float4(S[r][2 * i].x, S[r][2 * i].y, S[r][2 * i + 1].x, S[r][2 * i + 1].y);
  }
  VMW(0);
}

template <int NE> struct GlOps { f32x4 Q[2], K[2], A[2]; float v[NE]; };
constexpr int GL_RING = 32, GL_SLOT = 768;
template <int NE>
__device__ __forceinline__ void gl_load(GlOps<NE>& o, const char* rec, int dir, int dq, int ecol) {
  const f32x4* q = (const f32x4*)rec;
#pragma unroll
  for (int i = 0; i < 2; ++i) { o.Q[i] = q[dq * 2 + i]; o.K[i] = q[8 + dq * 2 + i]; o.A[i] = q[16 + dir * 8 + dq * 2 + i]; }
  if (NE == 4) { f32x4 t = *(const f32x4*)((const float*)rec + 128 + ecol); o.v[0] = t[0]; o.v[1] = t[1]; o.v[NE - 2] = t[2]; o.v[NE - 1] = t[3]; }
  else { f32x2 t = *(const f32x2*)((const float*)rec + 128 + ecol); o.v[0] = t.x; o.v[1] = t.y; }
}
template <int NE>
__device__ __forceinline__ float gl_step(f32x2 (&S)[8][NE / 2], const GlOps<NE>& o, int dq) {
  f32x2 vv[NE / 2], acc[NE / 2];
#pragma unroll
  for (int e = 0; e < NE / 2; ++e) { vv[e] = f32x2{o.v[2 * e], o.v[2 * e + 1]}; acc[e] = f32x2{0.f, 0.f}; }
#pragma unroll
  for (int d = 0; d < 8; ++d) {
    const float a = o.A[d >> 2][d & 3], kk = o.K[d >> 2][d & 3], qq = o.Q[d >> 2][d & 3];
    const f32x2 av = {a, a}, kv = {kk, kk}, qv = {qq, qq};
#pragma unroll
    for (int e = 0; e < NE / 2; ++e) { S[d][e] = av * S[d][e] + kv * vv[e]; acc[e] += qv * S[d][e]; }
  }
  if (NE == 4) {
    const float r0 = quad_sum(acc[0].x), r1 = quad_sum(acc[0].y), r2 = quad_sum(acc[NE / 2 - 1].x), r3 = quad_sum(acc[NE / 2 - 1].y);
    return dq == 0 ? r0 : (dq == 1 ? r1 : (dq == 2 ? r2 : r3));
  } else {
    const float r0 = quad_sum(acc[0].x), r1 = quad_sum(acc[0].y);
    return (dq & 1) ? r1 : r0;
  }
}
template <int NE>
__device__ __forceinline__ void gla_scan(const Params& p, int l, int task, int eh, char* ring  ) {
  const int lane = otid() & 63;
  task = __builtin_amdgcn_readfirstlane(task);
  int b, hd, L, rowbase;
  const bool lat = task < 96;
  if (lat) { b = task / 12; hd = task % 12; L = 1024; rowbase = NCTX + b * 1024; }
  else { int t2 = task - 96; b = t2 / 12; hd = t2 % 12; L = 256; rowbase = b * 256; }
  const int h = hd >> 1, dir = hd & 1;
  const int dq = lane & 3, eg = lane >> 2;
  const int ecol = (NE == 4) ? eg * 4 : eh * 32 + eg * 2;
  const bool owner = (NE == 4) || dq < 2;
  const float* grec = (const float*)(p.ws + OFF_GREC);
  float* GO = (float*)(p.ws + OFF_GO) + (size_t)dir * NTOK * 384 + h * 64 + ecol + (NE == 4 ? dq : (dq & 1));
  f32x2 S[8][NE / 2];
  if (lat) {
    const float* s0 = p.in[I_SG] + ((((size_t)b * DEPTH + l) * 2 + dir) * 6 + h) * 2048 + (dq * 8) * 64 + ecol;
#pragma unroll
    for (int d = 0; d < 8; ++d)
#pragma unroll
      for (int e = 0; e < NE / 2; ++e) { f32x2 v = *(const f32x2*)(s0 + d * 64 + 2 * e); S[d][e] = v; }
  } else {
#pragma unroll
    for (int d = 0; d < 8; ++d)
#pragma unroll
      for (int e = 0; e < NE / 2; ++e) S[d][e] = f32x2{0.f, 0.f};
  }
  VMW(0);
#define GL_REC(st) ((const char*)(grec + ((size_t)(rowbase + (dir ? L - 1 - (st) : (st))) * 6 + h) * 256))
#pragma unroll
  for (int s = 0; s < GL_RING; ++s) { if (lane < 48) glds16(GL_REC(s) + lane * 16, ring + s * GL_SLOT); }
  GlOps<NE> oa{};
  VMW(31);
  gl_load<NE>(oa, ring, dir, dq, ecol);
  for (int s = 0; s < L; s += 2) {
    GlOps<NE> ob;
    LGKM0; if (s + GL_RING >= L) VMW(0); else VMW(30);
    gl_load<NE>(ob, ring + ((s + 1) & (GL_RING - 1)) * GL_SLOT, dir, dq, ecol);
    __builtin_amdgcn_sched_barrier(0);
    {
      float o = gl_step<NE>(S, oa, dq);
      const int n = dir ? L - 1 - s : s;
      if (owner) GO[(size_t)(rowbase + n) * 384] = o;
    }
    asm volatile("" ::: "memory");
    if (s + GL_RING < L && lane < 48) glds16(GL_REC(s + GL_RING) + lane * 16, ring + (s & (GL_RING - 1)) * GL_SLOT);
    __builtin_amdgcn_sched_barrier(0);
    LGKM0; if (s + 1 + GL_RING >= L) VMW(0); else VMW(30);
    gl_load<NE>(oa, ring + ((s + 2) & (GL_RING - 1)) * GL_SLOT, dir, dq, ecol);
    __builtin_amdgcn_sched_barrier(0);
    {
      float o = gl_step<NE>(S, ob, dq);
      const int n = dir ? L - 2 - s : s + 1;
      if (owner) GO[(size_t)(rowbase + n) * 384] = o;
    }
    asm volatile("" ::: "memory");
    if (s + 1 + GL_RING < L && lane < 48) glds16(GL_REC(s + 1 + GL_RING) + lane * 16, ring + ((s + 1) & (GL_RING - 1)) * GL_SLOT);
    __builtin_amdgcn_sched_barrier(0);
  }
#undef GL_REC
  if (!lat) {
    float* so = p.out + (size_t)NTOK * D + ((((size_t)b * DEPTH + l) * 2 + dir) * 6 + h) * 2048 + (dq * 8) * 64 + ecol;
#pragma unroll
    for (int d = 0; d < 8; ++d)
#pragma unroll
      for (int e = 0; e < NE / 2; ++e) *(f32x2*)(so + d * 64 + 2 * e) = S[d][e];
  }
  VMW(0);
}

constexpr int HY_TASKS = 768;
__device__ __forceinline__ void hyena_task(const Params& p, int l, int task) {
  const int lane = otid() & 63;
  int b, cgp, tb, L, rowbase;
  const float* ft = (const float*)(p.ws + OFF_FT) + (size_t)l * FT_LAYER;
  if (task < 512) { b = task >> 6; cgp = (task >> 5) & 1; tb = task & 31; L = 1024; rowbase = NCTX + b * 1024; ft += FT_L0; }
  else { int t2 = task - 512; b = t2 >> 4; cgp = (t2 >> 3) & 1; tb = t2 & 7; L = 256; rowbase = b * 256; }
  const int c = cgp * 128 + lane * 2;
  const int t0 = tb * 32;
  const float* hz = (const float*)(p.ws + OFF_HYZ) + (size_t)rowbase * 256 + c;
  const float* hx = (const float*)(p.ws + OFF_HYX) + (size_t)rowbase * 256 + c;
  const float* fc = ft + c;
  const unsigned short* hzb = (const unsigned short*)(p.ws + OFF_HZB) + (size_t)rowbase * 256 + c;
  const unsigned short* fcb = (const unsigned short*)(p.ws + OFF_FTB) + (size_t)(ft - (const float*)(p.ws + OFF_FT)) + c;
  f32x2 acc[32];
#pragma unroll
  for (int i = 0; i < 32; ++i) acc[i] = f32x2{0.f, 0.f};
  for (int s0 = 0; s0 < L; s0 += 16) {
    f32x2 z[16], f[47];
#pragma unroll
    for (int j = 0; j < 16; ++j) { const unsigned u = *(const unsigned*)(hzb + (size_t)(s0 + j) * 256); z[j] = f32x2{__uint_as_float(u << 16), __uint_as_float(u & 0xffff0000u)}; }
    const unsigned short* fb = fcb + (size_t)(t0 - s0 - 15 + L - 1) * 256;
#pragma unroll
    for (int m = 0; m < 47; ++m) { const unsigned u = *(const unsigned*)(fb + (size_t)m * 256); f[m] = f32x2{__uint_as_float(u << 16), __uint_as_float(u & 0xffff0000u)}; }
#pragma unroll
    for (int i = 0; i < 32; ++i)
#pragma unroll
      for (int j = 0; j < 16; ++j) acc[i] += f[i - j + 15] * z[j];
  }
  const f32x2 bias = *(const f32x2*)(p.in[I_HBIAS] + l * 256 + c);
  unsigned* O = (unsigned*)(p.ws + OFF_H);
#pragma unroll
  for (int i = 0; i < 32; ++i) {
    int t = t0 + i;
    f32x2 zz = *(const f32x2*)(hz + (size_t)t * 256), xx = *(const f32x2*)(hx + (size_t)t * 256);
    f32x2 y = xx * (acc[i] + zz * bias);
    O[((size_t)(rowbase + t) * D + 384 + c) >> 1] = (unsigned)f2bf(y.x) | ((unsigned)f2bf(y.y) << 16);
  }
}

constexpr int LDS_GLA = 98304, LDS_FLAGS = 147456, LDS_XB = 147584;
__device__ __forceinline__ void phase_mixers(const Params& p, int l, int cidx) {
  const int wave = otid() >> 6, lane = otid() & 63;
  const int bid = obid();
  volatile unsigned* fl = (volatile unsigned*)(smem + LDS_FLAGS);
  if (otid() < 32) fl[otid()] = 0u;
  __syncthreads();
  __builtin_amdgcn_s_setprio(3);
  if (bid < 192) {
    if (wave < 4) rwkv_scan_la(p, l, bid >> 1, wave, (bid & 1) * 32, smem, fl);
    else rwkv_scan<4, 2, 32>(p, l, 96 + bid, wave - 4, 0, smem + 98304, fl + 16);
  } else if (wave < 3) {
    const int g = (bid - 192) * 3 + wave;
    gla_scan<2>(p, l, g >> 1, g & 1, smem + wave * 24576);
  } else if (wave < 6) {
    gla_scan<4>(p, l, 96 + (bid - 192) * 3 + (wave - 3), 0, smem + wave * 24576);
  }
  __builtin_amdgcn_s_setprio(0);
  int* cnt = (int*)(p.ws + OFF_CNT) + cidx;
  const int ntask = HY_TASKS + (l < DEPTH - 1 ? 5312 : 0);
  while (true) {
    int t = 0;
    if (lane == 0) t = atomicAdd(cnt, 1);
    t = __shfl(t, 0);
    if (t >= ntask) break;
    if (t < HY_TASKS) hyena_task(p, l, t);
    else wconv_wave(p, l + 1, (l + 1) & 1, t - HY_TASKS);
  }
}

__device__ __forceinline__ void phase_post(const Params& p, int l) {
  const int wave = otid() >> 6, lane = otid() & 63;
  const float* GO = (const float*)(p.ws + OFF_GO);
  const float* RO = (const float*)(p.ws + OFF_RO);
  const float* grec = (const float*)(p.ws + OFF_GREC);
  const float* rec = (const float*)(p.ws + OFF_REC);
  unsigned short* O = (unsigned short*)(p.ws + OFF_H);
  const float gn = p.in[I_GN][l * 64 + lane];
  float lw[6], lb[6], rk[6];
#pragma unroll
  for (int h = 0; h < 6; ++h) { lw[h] = p.in[I_RLW][l * 384 + h * 64 + lane]; lb[h] = p.in[I_RLB][l * 384 + h * 64 + lane]; rk[h] = p.in[I_RRK][l * 384 + h * 64 + lane]; }
  for (int R = obid() * 8 + wave; R < NTOK; R += gridDim.x * 8) {
    const int tokr = scan2tok(R);
    float go[6], gg[6], ro[6], r_[6], k_[6], v_[6], g_[6];
#pragma unroll
    for (int h = 0; h < 6; ++h) {
      go[h] = GO[(size_t)R * 384 + h * 64 + lane] + GO[(size_t)(NTOK + R) * 384 + h * 64 + lane];
      gg[h] = grec[((size_t)R * 6 + h) * 256 + 192 + lane];
      ro[h] = RO[(size_t)R * 384 + h * 64 + lane] + RO[(size_t)(NTOK + R) * 384 + h * 64 + lane];
      const float* rr = rec + ((size_t)R * 6 + h) * 512 + lane;
      r_[h] = rr[0]; k_[h] = rr[64]; v_[h] = rr[128]; g_[h] = rr[448];
    }
    __builtin_amdgcn_sched_barrier(0);
#pragma unroll
    for (int h = 0; h < 6; ++h) {
      const float o = go[h];
      float ms = wave_sum(o * o) * (1.f / 64.f);
      float y = o * rsqrtf(ms + 1e-6f) * gn;
      O[(size_t)R * D + h * 64 + lane] = f2bf(y * siluf_(gg[h]));
    }
#pragma unroll
    for (int h = 0; h < 6; ++h) {
      const int c = h * 64 + lane;
      const float o = ro[h];
      float mean = wave_sum(o) * (1.f / 64.f);
      float dlt = o - mean;
      float var = wave_sum(dlt * dlt) * (1.f / 64.f);
      float y = dlt * rsqrtf(var + 64e-5f) * lw[h] + lb[h];
      float bonus = wave_sum(r_[h] * k_[h] * rk[h]) * v_[h];
      O[(size_t)tokr * D + 640 + c] = f2bf((y + bonus) * g_[h]);
    }
  }
}

#define XB_TMO      128
#define XB_XCNT(j)  (256  + 64 * (j))
#define XB_XSUB(j)  (1280 + 64 * (j))
#define XB_XGEN(j)  (2304 + 64 * (j))
#define XB_TOP      3328
#define XB_TOPGEN   3392
#define XCD_BAR_WORDS 3456
#define XB_SPIN_CAP (1u << 18)
#define LAS __attribute__((address_space(3)))

__device__ __forceinline__ unsigned xb_ld(unsigned* p)              { return __hip_atomic_load(p, __ATOMIC_RELAXED, __HIP_MEMORY_SCOPE_AGENT); }
__device__ __forceinline__ unsigned xb_add(unsigned* p, unsigned v) { return __hip_atomic_fetch_add(p, v, __ATOMIC_RELAXED, __HIP_MEMORY_SCOPE_AGENT); }
__device__ __forceinline__ unsigned xb_xcc_id() { return (unsigned)__builtin_amdgcn_s_getreg((3 << 11) | 20) & 0xFu; }
#define XB_SPIN(cond, bar) do { unsigned _sp = 0; while (cond) { __builtin_amdgcn_s_sleep(1); \
    if ((++_sp & 255u) == 0u) { if (xb_ld(&(bar)[XB_TMO])) break; if (_sp > XB_SPIN_CAP) { atomicAdd(&(bar)[XB_TMO], 1u); break; } } } } while (0)

struct XcdBarrier {
    unsigned* bar; unsigned x;
    volatile LAS unsigned* st;
};

__device__ __forceinline__ XcdBarrier xcd_barrier_post(unsigned* bar, volatile LAS unsigned* st) {
    XcdBarrier b; b.bar = bar; b.x = xb_xcc_id(); b.st = st;
    if (threadIdx.x == 0) (void)xb_add(&bar[XB_XCNT(b.x)], 1u);
    return b;
}
__device__ __forceinline__ void xcd_barrier_complete(unsigned* bar, unsigned x, unsigned& nloc, unsigned& nx) {
    const unsigned G = gridDim.x * gridDim.y * gridDim.z;
    unsigned sum, cnt, mine, sp = 0u;
    for (;;) {
        sum = 0u; cnt = 0u; mine = 0u;
#pragma unroll
        for (unsigned j = 0; j < 16; ++j) { const unsigned c = xb_ld(&bar[XB_XCNT(j)]); sum += c; cnt += (c > 0u) ? 1u : 0u; mine = (j == x) ? c : mine; }
        if (sum == G) break;
        __builtin_amdgcn_s_sleep(1);
        if ((++sp & 255u) == 0u) { if (xb_ld(&bar[XB_TMO])) break; if (sp > XB_SPIN_CAP) { atomicAdd(&bar[XB_TMO], 1u); break; } }
    }
    nloc = mine > 0u ? mine : 1u; nx = cnt > 0u ? cnt : 1u;
}

__device__ __forceinline__ void xcd_barrier(const XcdBarrier& b) {
    asm volatile("s_waitcnt vmcnt(0)" ::: "memory");
    __syncthreads();
    if (threadIdx.x == 0) {
        unsigned* bar = b.bar;
        __builtin_amdgcn_s_waitcnt(0);
        unsigned nloc = b.st[0], nx = b.st[1];
        if (nloc == 0u) { xcd_barrier_complete(bar, b.x, nloc, nx); b.st[0] = nloc; b.st[1] = nx; }
        const unsigned old = xb_add(&bar[XB_XSUB(b.x)], 1u);
        const unsigned gen = old / nloc;
        if (old + 1u == (gen + 1u) * nloc) {
            __builtin_amdgcn_fence(__ATOMIC_RELEASE, "agent");
            asm volatile("s_waitcnt vmcnt(0)" ::: "memory");
            const unsigned og = xb_add(&bar[XB_TOP], 1u);
            const unsigned tg = og / nx;
            if (og + 1u == (tg + 1u) * nx) xb_add(&bar[XB_TOPGEN], 1u);
            else XB_SPIN(xb_ld(&bar[XB_TOPGEN]) == tg, bar);
            __builtin_amdgcn_fence(__ATOMIC_ACQUIRE, "agent");
            xb_add(&bar[XB_XGEN(b.x)], 1u);
            asm volatile("s_waitcnt vmcnt(0)" ::: "memory");
        } else {
            XB_SPIN(xb_ld(&bar[XB_XGEN(b.x)]) == gen, bar);
            __builtin_amdgcn_fence(__ATOMIC_ACQUIRE, "agent");
            asm volatile("s_waitcnt vmcnt(0)" ::: "memory");
        }
    }
    __syncthreads();
}

__global__ void __launch_bounds__(NTHR) fwd_megakernel(Params p) {
  cg::grid_group grid = cg::this_grid();
  if (threadIdx.x == 0) *(uint4*)(smem + 147584) = make_uint4(0u, 0u, 0u, 0u);
  __syncthreads();
  XcdBarrier xb = xcd_barrier_post((unsigned*)(p.ws + OFF_BAR), (volatile LAS unsigned*)(smem + 147584));
  if (obid() == 0 && otid() < 64) ((int*)(p.ws + OFF_CNT))[otid()] = 0;
  p0_copy_x(p);
  p0_filters(p);
  p0_mod(p);
  __syncthreads();
  phase_wconv(p, 0, 0);
  bf16* hbuf = (bf16*)(p.ws + OFF_H);
  bf16* hmid = (bf16*)(p.ws + OFF_HMID);
  float* xw = (float*)(p.ws + OFF_X);
  float* Pw = (float*)(p.ws + OFF_P);
  for (int l = 0; l < DEPTH; ++l) {
    const float* modl = (const float*)(p.ws + OFF_MOD) + (size_t)l * 9 * 9216;
    const size_t wset = (size_t)(l & 1) * WSET;
    if (l == 0) grid.sync();
    phase_norm(p, p.in[I_F1N] + l * D, modl, 0, 1);
    xcd_barrier(xb);
    phase_gemm(hbuf, p.ws + OFF_W1I + wset, 5632, 1024, EpiSwiglu{(unsigned short*)hmid});
    xcd_barrier(xb);
    phase_gemm(hmid, p.ws + OFF_W1O + wset, 1024, 2816, EpiResid{xw, modl, 2, 0.5f});
    xcd_barrier(xb);
    phase_norm(p, p.in[I_MN] + l * D, modl, 3, 4);
    xcd_barrier(xb);
    phase_gemm(hbuf, p.ws + OFF_WMI + wset, INCP, 1024, EpiP{Pw});
    xcd_barrier(xb);
    prep_rwkv(p, l);
    prep_gla(p, l);
    prep_hyena(p, l);
    xcd_barrier(xb);
    phase_mixers(p, l, l);
    xcd_barrier(xb);
    phase_post(p, l);
    xcd_barrier(xb);
    phase_gemm(hbuf, p.ws + OFF_WMO + wset, 1024, 1024, EpiResid{xw, modl, 5, 1.0f});
    xcd_barrier(xb);
    phase_norm(p, p.in[I_F2N] + l * D, modl, 6, 7);
    xcd_barrier(xb);
    phase_gemm(hbuf, p.ws + OFF_W2I + wset, 5632, 1024, EpiSwiglu{(unsigned short*)hmid});
    xcd_barrier(xb);
    phase_gemm(hmid, p.ws + OFF_W2O + wset, 1024, 2816, EpiResid{xw, modl, 8, 0.5f});
    xcd_barrier(xb);
  }
  phase_final_norm(p);
}

extern "C" void kernel_launch(void* const* d_in, const int* in_sizes, int n_in, void* d_out, int out_size, void* d_ws,
                              size_t ws_size, hipStream_t stream) {
  static int grid_blocks = 0;
  if (!grid_blocks) {
    int dev = 0, cus = 0, per_cu = 0;
    (void)hipGetDevice(&dev);
    (void)hipDeviceGetAttribute(&cus, hipDeviceAttributeMultiprocessorCount, dev);
    (void)hipFuncSetAttribute((const void*)fwd_megakernel, hipFuncAttributeMaxDynamicSharedMemorySize, LDS_BYTES);
    (void)hipOccupancyMaxActiveBlocksPerMultiprocessor(&per_cu, fwd_megakernel, NTHR, LDS_BYTES);
    if (per_cu < 1) per_cu = 1;
    grid_blocks = cus * per_cu;
    if (grid_blocks > 256) grid_blocks = 256;
  }
  if (ws_size < WS_NEED) fprintf(stderr, "workspace too small: %zu < %zu\n", ws_size, (size_t)WS_NEED);
  (void)hipMemsetAsync((char*)d_ws + OFF_BAR, 0, 16384, stream);
  Params p{};
  for (int i = 0; i < 41; ++i) p.in[i] = (const float*)d_in[i];
  p.out = (float*)d_out;
  p.ws = (char*)d_ws;
  void* args[] = {&p};
  hipError_t e = hipLaunchCooperativeKernel((void*)fwd_megakernel, dim3(grid_blocks), dim3(NTHR), args, LDS_BYTES, stream);
  if (e != hipSuccess) fprintf(stderr, "cooperative launch failed: %s (grid %d)\n", hipGetErrorString(e), grid_blocks);
}
```

```cpp
#include <hip/hip_runtime.h>
#include <hip/hip_bf16.h>
#include <hip/hip_cooperative_groups.h>
#include <cstdio>
namespace cg = cooperative_groups;

typedef __hip_bfloat16 bf16;
typedef __attribute__((ext_vector_type(8))) short bf16x8;
typedef __attribute__((ext_vector_type(4))) float f32x4;
typedef __attribute__((ext_vector_type(2))) float f32x2;

constexpr int D = 1024, NTOK = 12288, NCTX = 4096, DEPTH = 4, FH = 2816;
constexpr int INC = 3264, INCP = 3328;
constexpr int C_HY = 1184, C_RW = 1952;
constexpr int NTHR = 512;

constexpr size_t al256(size_t x) { return (x + 255) & ~(size_t)255; }
constexpr size_t OFF_CNT = 0;
constexpr size_t OFF_BAR = 4096;
constexpr size_t OFF_MOD = 4096 + 16384;
constexpr size_t SZ_MOD = (size_t)DEPTH * 9 * 9216 * 4;
constexpr size_t OFF_FT = al256(OFF_MOD + SZ_MOD);
constexpr size_t FT_L0 = 511 * 256, FT_L1 = 2047 * 256;
constexpr size_t FT_LAYER = FT_L0 + FT_L1;
constexpr size_t OFF_X = al256(OFF_FT + DEPTH * FT_LAYER * 4);
constexpr size_t OFF_H = al256(OFF_X + (size_t)NTOK * D * 4);
constexpr size_t OFF_W1I = al256(OFF_H + (size_t)NTOK * D * 2);
constexpr size_t OFF_W1O = al256(OFF_W1I + (size_t)5632 * 1024 * 2);
constexpr size_t OFF_WMI = al256(OFF_W1O + (size_t)1024 * 2816 * 2);
constexpr size_t OFF_WMO = al256(OFF_WMI + (size_t)INCP * 1024 * 2);
constexpr size_t OFF_W2I = al256(OFF_WMO + (size_t)1024 * 1024 * 2);
constexpr size_t OFF_W2O = al256(OFF_W2I + (size_t)5632 * 1024 * 2);
constexpr size_t WSET = al256(OFF_W2O + (size_t)1024 * 2816 * 2) - OFF_W1I;
constexpr size_t OFF_P = OFF_W1I + 2 * WSET;
constexpr size_t SZ_P = (size_t)NTOK * INC * 4;
constexpr size_t SZ_GO = (size_t)2 * NTOK * 384 * 4;
constexpr size_t OFF_GO = OFF_P;
constexpr size_t OFF_RO = OFF_P + SZ_GO;
constexpr size_t OFF_REC = al256(OFF_P + SZ_P);
constexpr size_t SZ_REC = (size_t)NTOK * 6 * 512 * 4;
constexpr size_t OFF_HMID = OFF_REC;
constexpr size_t OFF_GREC = al256(OFF_REC + SZ_REC);
constexpr size_t SZ_GREC = (size_t)NTOK * 6 * 256 * 4;
constexpr size_t OFF_HYZ = al256(OFF_GREC + SZ_GREC);
constexpr size_t OFF_HYX = al256(OFF_HYZ + (size_t)NTOK * 256 * 4);
constexpr size_t OFF_HZB = al256(OFF_HYX + (size_t)NTOK * 256 * 4);
constexpr size_t OFF_FTB = al256(OFF_HZB + (size_t)NTOK * 256 * 2);
constexpr size_t WS_NEED = al256(OFF_FTB + DEPTH * FT_LAYER * 2);

struct Params {
  const float* in[41];
  float* out;
  char* ws;
};

enum { I_XP = 0, I_XS, I_SG, I_SR, I_C, I_CCTX, I_ADAW, I_ADAB, I_F1N, I_F1WI, I_F1WO, I_MN, I_MWI, I_MWO,
       I_GW2, I_GB, I_GN, I_HCW, I_HCB, I_HW1, I_HB1, I_HW2, I_HB2, I_HFQ, I_HW3, I_HBIAS,
       I_RMU, I_RW0, I_RW2, I_RA0, I_RA2, I_RG2, I_RKK, I_RKA, I_RRK, I_RLW, I_RLB, I_F2N, I_F2WI, I_F2WO, I_FN };

extern __shared__ __attribute__((aligned(16))) char smem[];
constexpr int LDS_BYTES = 147600;

__device__ __forceinline__ int otid() { int t = (int)__builtin_amdgcn_workitem_id_x(); asm volatile("" : "+v"(t)); return t; }
__device__ __forceinline__ int obid() { int b = (int)__builtin_amdgcn_workgroup_id_x(); asm volatile("" : "+s"(b)); return b; }
__device__ __forceinline__ unsigned short f2bf(float f) {
  unsigned u = __float_as_uint(f);
  u += 0x7fffu + ((u >> 16) & 1u);
  return (unsigned short)(u >> 16);
}
__device__ __forceinline__ float dpp_f(float x, const int ctrl_sel) {
  int xi = __float_as_int(x), r;
  if (ctrl_sel == 0) r = __builtin_amdgcn_update_dpp(0, xi, 0xB1, 0xF, 0xF, true);
  else if (ctrl_sel == 1) r = __builtin_amdgcn_update_dpp(0, xi, 0x4E, 0xF, 0xF, true);
  else if (ctrl_sel == 2) r = __builtin_amdgcn_update_dpp(0, xi, 0x141, 0xF, 0xF, true);
  else r = __builtin_amdgcn_update_dpp(0, xi, 0x140, 0xF, 0xF, true);
  return __int_as_float(r);
}
__device__ __forceinline__ float wave_sum(float v) {
  v += dpp_f(v, 0); v += dpp_f(v, 1); v += dpp_f(v, 2); v += dpp_f(v, 3);
  const int vi = __float_as_int(v);
  return __int_as_float(__builtin_amdgcn_readlane(vi, 0)) + __int_as_float(__builtin_amdgcn_readlane(vi, 16)) +
         __int_as_float(__builtin_amdgcn_readlane(vi, 32)) + __int_as_float(__builtin_amdgcn_readlane(vi, 48));
}
__device__ __forceinline__ float sigmoidf_(float x) { return __builtin_amdgcn_rcpf(1.f + __builtin_amdgcn_exp2f(x * -1.4426950408889634f)); }
__device__ __forceinline__ float siluf_(float x) { return x * sigmoidf_(x); }
__device__ __forceinline__ int modrow(int row) { return row < NCTX ? 0 : 1 + ((row - NCTX) >> 10); }

__device__ __forceinline__ void p0_copy_x(const Params& p) {
  float4* x = (float4*)(p.ws + OFF_X);
  const float4* a = (const float4*)p.in[I_XP];
  const float4* b = (const float4*)p.in[I_XS];
  const size_t n4 = (size_t)NTOK * D / 4, nc4 = (size_t)NCTX * D / 4;
  for (size_t i = (size_t)obid() * NTHR + otid(); i < n4; i += (size_t)gridDim.x * NTHR)
    x[i] = i < nc4 ? a[i] : b[i - nc4];
}

__device__ __forceinline__ void p0_mod(const Params& p) {
  float* scond = (float*)smem;
  float* red = (float*)(smem + 40960);
  for (int i = otid(); i < 9 * 1024; i += NTHR) {
    int r = i >> 10, d = i & 1023;
    float c = r == 0 ? p.in[I_CCTX][d] : p.in[I_C][(r - 1) * 1024 + d];
    scond[i] = siluf_(c);
  }
  __syncthreads();
  float* mod = (float*)(p.ws + OFF_MOD);
  const int col = otid() & 63, ks = otid() >> 6;
  for (int task = obid(); task < DEPTH * 144; task += gridDim.x) {
    int l = task / 144, cg_ = task % 144;
    const float* w = p.in[I_ADAW] + (size_t)l * 1024 * 9216 + cg_ * 64 + col;
    float acc[9];
#pragma unroll
    for (int r = 0; r < 9; ++r) acc[r] = 0.f;
    for (int d0 = ks * 128; d0 < ks * 128 + 128; d0 += 8) {
      float wv[8];
#pragma unroll
      for (int u = 0; u < 8; ++u) wv[u] = w[(size_t)(d0 + u) * 9216];
#pragma unroll
      for (int u = 0; u < 8; ++u)
#pragma unroll
        for (int r = 0; r < 9; ++r) acc[r] += scond[r * 1024 + d0 + u] * wv[u];
    }
#pragma unroll
    for (int r = 0; r < 9; ++r) red[(ks * 9 + r) * 64 + col] = acc[r];
    __syncthreads();
    for (int i = otid(); i < 576; i += NTHR) {
      int r = i >> 6, c = i & 63;
      float s = 0.f;
#pragma unroll
      for (int k = 0; k < 8; ++k) s += red[(k * 9 + r) * 64 + c];
      int j = cg_ * 64 + c;
      mod[((size_t)l * 9 + r) * 9216 + j] = s + p.in[I_ADAB][l * 9216 + j];
    }
    __syncthreads();
  }
}

__device__ __forceinline__ void p0_filters(const Params& p) {
  const int wave = otid() >> 6, lane = otid() & 63;
  float* FT = (float*)(p.ws + OFF_FT);
  for (int task = obid() * 8 + wave; task < DEPTH * 1280; task += gridDim.x * 8) {
    int l = task / 1280, rem = task % 1280;
    int sel = rem >= 256, i = sel ? rem - 256 : rem, L = sel ? 1024 : 256;
    float t = (float)i / (float)(L - 1);
    float w = 6.283185307179586f * (float)i / (float)L;
    float zval = 0.f;
    {
      const float fstep = (15.f - 1e-4f) / 15.f;
      if (lane == 0) zval = t;
      else if (lane <= 16) zval = cosf((1e-4f + (float)(lane - 1) * fstep) * w);
      else if (lane <= 32) zval = -sinf((1e-4f + (float)(lane - 17) * fstep) * w);
    }
    const float* w1 = p.in[I_HW1] + l * 33 * 64;
    const float* w2 = p.in[I_HW2] + l * 64 * 64;
    const float* w3 = p.in[I_HW3] + l * 64 * 512;
    const float* fq = p.in[I_HFQ] + l * 128;
    float h1 = p.in[I_HB1][l * 64 + lane];
    for (int e = 0; e < 33; ++e) h1 += __shfl(zval, e) * w1[e * 64 + lane];
    h1 = sinf(fq[lane] * h1);
    float h2 = p.in[I_HB2][l * 64 + lane];
    for (int e = 0; e < 64; ++e) h2 += __shfl(h1, e) * w2[e * 64 + lane];
    h2 = sinf(fq[64 + lane] * h2);
    float acc[8];
#pragma unroll
    for (int m = 0; m < 8; ++m) acc[m] = 0.f;
    for (int e = 0; e < 64; ++e) {
      float hv = __shfl(h2, e);
#pragma unroll
      for (int m = 0; m < 8; ++m) acc[m] += hv * w3[e * 512 + m * 64 + lane];
    }
    float* ft = FT + (size_t)l * FT_LAYER + (sel ? FT_L0 : 0);
    const float a0 = -3.0701134573253945f, a1 = -15.350567286626973f;
#pragma unroll
    for (int m = 0; m < 8; ++m) {
      int cp = m * 64 + lane, c = cp & 255;
      float delta = fabsf(a0 + (float)c * ((a1 - a0) / 255.f));
      float val = acc[m] * expf(-t * delta);
      unsigned short* ftb = (unsigned short*)(p.ws + OFF_FTB) + (size_t)l * FT_LAYER + (sel ? FT_L0 : 0);
      if (cp < 256) { ft[(size_t)(L - 1 + i) * 256 + c] = val; ftb[(size_t)(L - 1 + i) * 256 + c] = f2bf(val); }
      else if (i >= 1) { ft[(size_t)(L - 1 - i) * 256 + c] = val; ftb[(size_t)(L - 1 - i) * 256 + c] = f2bf(val); }
    }
  }
}

__device__ __forceinline__ void conv_tile(const float* src, int srcN, int k0, int srccol0, bool zero, bf16* dst, int dstK, int n0) {
  float* tile = (float*)smem;
  const int tid = otid();
  {
    int r = tid >> 4, c4 = (tid & 15) * 4;
#pragma unroll
    for (int rr = 0; rr < 2; ++rr) {
      int row = r + rr * 32;
      float4 v = zero ? make_float4(0.f, 0.f, 0.f, 0.f)
                      : *(const float4*)(src + (size_t)(k0 + row) * srcN + srccol0 + c4);
      tile[row * 65 + c4 + 0] = v.x; tile[row * 65 + c4 + 1] = v.y;
      tile[row * 65 + c4 + 2] = v.z; tile[row * 65 + c4 + 3] = v.w;
    }
  }
  __syncthreads();
  {
    int nn = tid >> 3, ks = (tid & 7) * 8;
    unsigned short v[8];
#pragma unroll
    for (int j = 0; j < 8; ++j) v[j] = f2bf(tile[(ks + j) * 65 + nn]);
    uint4 o;
    o.x = v[0] | ((unsigned)v[1] << 16); o.y = v[2] | ((unsigned)v[3] << 16);
    o.z = v[4] | ((unsigned)v[5] << 16); o.w = v[6] | ((unsigned)v[7] << 16);
    *(uint4*)(dst + (size_t)(n0 + nn) * dstK + k0 + ks) = o;
  }
  __syncthreads();
}

__device__ __forceinline__ unsigned cvt_pk_bf16_(float lo, float hi) { unsigned r; asm volatile("v_cvt_pk_bf16_f32 %0, %1, %2" : "=v"(r) : "v"(lo), "v"(hi)); return r; }
struct WTile { const float* src; int srcN, k0, srccol, dstK, n0; bool zero; size_t dstoff; };
__device__ __forceinline__ WTile wtile_decode(const Params& p, int l, int u) {
  WTile w;
  w.zero = false;
  if (u < 1408 || (u >= 3200 && u < 4608)) {
    const bool second = u >= 3200;
    if (second) u -= 3200;
    w.src = p.in[second ? I_F2WI : I_F1WI] + (size_t)l * 1024 * 5632;
    w.dstoff = second ? OFF_W2I : OFF_W1I;
    const int tn = u % 88, tk = u / 88;
    const int n0 = tn * 64, pn = n0 >> 8, within = n0 & 255;
    w.srccol = within < 128 ? pn * 128 + within : 2816 + pn * 128 + (within - 128);
    w.srcN = 5632; w.k0 = tk * 64; w.dstK = 1024; w.n0 = n0;
  } else if ((u >= 1408 && u < 2112) || u >= 4608) {
    const bool second = u >= 4608;
    u -= second ? 4608 : 1408;
    w.src = p.in[second ? I_F2WO : I_F1WO] + (size_t)l * 2816 * 1024;
    w.dstoff = second ? OFF_W2O : OFF_W1O;
    const int tn = u % 16, tk = u / 16;
    w.srcN = 1024; w.k0 = tk * 64; w.srccol = tn * 64; w.dstK = 2816; w.n0 = tn * 64;
  } else if (u < 2944) {
    u -= 2112;
    w.src = p.in[I_MWI] + (size_t)l * 1024 * INC;
    w.dstoff = OFF_WMI;
    const int tn = u % 52, tk = u / 52;
    w.srcN = INC; w.k0 = tk * 64; w.srccol = tn * 64; w.dstK = 1024; w.n0 = tn * 64; w.zero = tn == 51;
  } else {
    u -= 2944;
    w.src = p.in[I_MWO] + (size_t)l * 1024 * 1024;
    w.dstoff = OFF_WMO;
    const int tn = u % 16, tk = u / 16;
    w.srcN = 1024; w.k0 = tk * 64; w.srccol = tn * 64; w.dstK = 1024; w.n0 = tn * 64;
  }
  return w;
}
__device__ __forceinline__ void phase_wconv(const Params& p, int l, int set) {
  for (int t = obid(); t < 5312; t += gridDim.x) {
    const WTile w = wtile_decode(p, l, t);
    conv_tile(w.src, w.srcN, w.k0, w.srccol, w.zero, (bf16*)(p.ws + w.dstoff + (size_t)set * WSET), w.dstK, w.n0);
  }
}
__device__ __forceinline__ void wconv_wave(const Params& p, int l, int set, int u) {
  const int lane = otid() & 63;
  const WTile w = wtile_decode(p, l, u);
  unsigned pk[32];
  if (!w.zero) {
    const float* s = w.src + (size_t)w.k0 * w.srcN + w.srccol + lane;
#pragma unroll
    for (int kk = 0; kk < 64; kk += 2) pk[kk >> 1] = cvt_pk_bf16_(s[(size_t)kk * w.srcN], s[(size_t)(kk + 1) * w.srcN]);
  } else {
#pragma unroll
    for (int i = 0; i < 32; ++i) pk[i] = 0u;
  }
  uint4* d = (uint4*)((unsigned short*)(p.ws + w.dstoff + (size_t)set * WSET) + (size_t)(w.n0 + lane) * w.dstK + w.k0);
#pragma unroll
  for (int i = 0; i < 8; ++i) d[i] = make_uint4(pk[4 * i], pk[4 * i + 1], pk[4 * i + 2], pk[4 * i + 3]);
}

__device__ __forceinline__ void phase_norm(const Params& p, const float* gain, const float* modl, int shi, int sci) {
  const int wave = otid() >> 6, lane = otid() & 63;
  const float* x = (const float*)(p.ws + OFF_X);
  bf16* h = (bf16*)(p.ws + OFF_H);
  const int nw = gridDim.x * 8;
  float4 g4[4];
#pragma unroll
  for (int i = 0; i < 4; ++i) g4[i] = ((const float4*)gain)[i * 64 + lane];
  constexpr int NR = 3;
  for (int row0 = obid() * 8 + wave; row0 < NTOK; row0 += NR * nw) {
    float4 v[NR][4], sc[NR][4], sh[NR][4];
    int rows[NR];
#pragma unroll
    for (int q = 0; q < NR; ++q) {
      const int row = (row0 + q * nw < NTOK) ? row0 + q * nw : row0;
      rows[q] = row;
      const float4* xr = (const float4*)(x + (size_t)row * D);
      const float* mr = modl + (size_t)modrow(row) * 9216;
#pragma unroll
      for (int i = 0; i < 4; ++i) {
        v[q][i] = xr[i * 64 + lane];
        sc[q][i] = ((const float4*)(mr + sci * 1024))[i * 64 + lane];
        sh[q][i] = ((const float4*)(mr + shi * 1024))[i * 64 + lane];
      }
    }
    __builtin_amdgcn_sched_barrier(0);
#pragma unroll
    for (int q = 0; q < NR; ++q) {
      if (q >= 1 && row0 + q * nw >= NTOK) break;
      float ss = 0.f;
#pragma unroll
      for (int i = 0; i < 4; ++i) ss += v[q][i].x * v[q][i].x + v[q][i].y * v[q][i].y + v[q][i].z * v[q][i].z + v[q][i].w * v[q][i].w;
      ss = wave_sum(ss);
      const float rstd = rsqrtf(ss * (1.f / 1024.f) + 1e-6f);
#pragma unroll
      for (int i = 0; i < 4; ++i) {
        const float4 g = g4[i], s = sc[q][i], bq = sh[q][i];
        float y0 = v[q][i].x * rstd * g.x * (1.f + s.x) + bq.x;
        float y1 = v[q][i].y * rstd * g.y * (1.f + s.y) + bq.y;
        float y2 = v[q][i].z * rstd * g.z * (1.f + s.z) + bq.z;
        float y3 = v[q][i].w * rstd * g.w * (1.f + s.w) + bq.w;
        uint2 o;
        o.x = f2bf(y0) | ((unsigned)f2bf(y1) << 16);
        o.y = f2bf(y2) | ((unsigned)f2bf(y3) << 16);
        *(uint2*)(h + (size_t)rows[q] * D + (i * 64 + lane) * 4) = o;
      }
    }
  }
}

__device__ __forceinline__ void phase_final_norm(const Params& p) {
  const int wave = otid() >> 6, lane = otid() & 63;
  const float* x = (const float*)(p.ws + OFF_X);
  const float4* g4 = (const float4*)p.in[I_FN];
  for (int row = obid() * 8 + wave; row < NTOK; row += gridDim.x * 8) {
    const float4* xr = (const float4*)(x + (size_t)row * D);
    float4 v[4];
    float ss = 0.f;
#pragma unroll
    for (int i = 0; i < 4; ++i) {
      v[i] = xr[i * 64 + lane];
      ss += v[i].x * v[i].x + v[i].y * v[i].y + v[i].z * v[i].z + v[i].w * v[i].w;
    }
    ss = wave_sum(ss);
    float rstd = rsqrtf(ss * (1.f / 1024.f) + 1e-6f);
    float4* o = (float4*)(p.out + (size_t)row * D);
#pragma unroll
    for (int i = 0; i < 4; ++i) {
      float4 g = g4[i * 64 + lane];
      o[i * 64 + lane] = make_float4(v[i].x * rstd * g.x, v[i].y * rstd * g.y, v[i].z * rstd * g.z, v[i].w * rstd * g.w);
    }
  }
}

namespace pg8 {
#define PG8_LAS __attribute__((address_space(3)))
typedef unsigned short bf16_t;
typedef short bf16x8 __attribute__((ext_vector_type(8)));
typedef float f32x4 __attribute__((ext_vector_type(4)));
typedef unsigned u32x4 __attribute__((ext_vector_type(4)));
constexpr int BM = 256, BK = 64, HALF = 128, HTB = HALF * BK * 2  , STAGE_BYTES = 8 * HTB, NXCD = 8, WGM = 8;

__host__ __device__ __forceinline__ int lds_byte(int r, int c) { const int st = (r >> 4) * 2 + (c >> 5), rr = r & 15, cc = c & 31, ob = rr * 64 + cc * 2; return st * 1024 + (ob ^ (((ob >> 9) & 1) << 5)); }
__host__ __device__ __forceinline__ void stage_rc(int b, int& R, int& C) { const int st = b / 1024, sb = b % 1024, swz = sb ^ (((sb >> 9) & 1) << 5); R = (st >> 1) * 16 + swz / 64; C = (st & 1) * 32 + (swz % 64) / 2; }
__host__ __device__ __forceinline__ int perm32(int rho) { const int n = rho >> 4, i = rho & 15; return 8 * (i >> 2) + 4 * n + (i & 3); }

struct Unit { int pm, pn; };
struct Gemm { const bf16_t* A; const bf16_t* Bt; int M, N, K; };

struct StaticOrder {
    int nM, nN, nwg, G, c;
    __host__ __device__ void init(int M, int N, int G_, int c_) { nM = M / BM; nN = N / BM; nwg = nM * nN; G = G_; c = c_; }
    __host__ __device__ bool next(int i, Unit& u) const {
        const long L = (long)i * G + c; if (L >= nwg) return false;
        int wgid = (int)L; { const int q = nwg / NXCD, r = nwg % NXCD, xcd = wgid % NXCD, off = wgid / NXCD; wgid = (xcd < r ? xcd * (q + 1) : r * (q + 1) + (xcd - r) * q) + off; }
        const int nig = WGM * nN, gid = wgid / nig, fm = gid * WGM, gsz = (nM - fm) < WGM ? (nM - fm) : WGM;
        u.pm = fm + ((wgid % nig) % gsz); u.pn = (wgid % nig) / gsz; return true;
    }
    __device__ __forceinline__ void a_ready(const Unit&) const {}
    __device__ __forceinline__ void done(const Unit&) const {}
};
__device__ __forceinline__ unsigned cvt_pk_bf16(float lo, float hi) { unsigned r; asm volatile("v_cvt_pk_bf16_f32 %0, %1, %2" : "=v"(r) : "v"(lo), "v"(hi)); return r; }

template <class Epi, class Sched, bool STAMP = false>
__device__ __forceinline__ void gemm_phase(PG8_LAS unsigned char* lds, const Gemm g, const Sched& S, const Epi& E, unsigned long long* stamps) {
    const int tid = otid(), wid = __builtin_amdgcn_readfirstlane(tid >> 6), lane = tid & 63, wr = wid >> 2, wc = wid & 3, fr = lane & 15, fq = lane >> 4;
    const int K = g.K, nt = K / BK;
    int ts_lo = 0, ts_hi = 0, nts = 0; const unsigned long long rt_entry = STAMP ? (unsigned long long)wall_clock64() : 0ull;
#define PG8_STAMP() do { if (STAMP && wid == 0 && nts < 64) { const unsigned long long _c = (unsigned long long)clock64(); \
        ts_lo = (lane == nts) ? (int)(unsigned)_c : ts_lo; ts_hi = (lane == nts) ? (int)(unsigned)(_c >> 32) : ts_hi; ++nts; } } while (0)
    PG8_STAMP();
    unsigned voffA[2], voffB[2];
#pragma unroll
    for (int i = 0; i < 2; ++i) { int R, C; stage_rc(tid * 16 + i * 8192, R, C); const int Rb = Epi::PERM ? ((R & ~31) + perm32(R & 31)) : R;
        voffA[i] = (unsigned)(R * K + C) * 2u; voffB[i] = (unsigned)(Rb * K + C) * 2u; }
    const size_t kstep = (size_t)(BK * 2);
    const size_t hstep = (size_t)HALF * K * 2;
    const size_t tstep = 2 * hstep;
    const unsigned ldsw = (unsigned)wid * 1024u;
    const int aoff = lds_byte(wr * 64 + fr, fq * 8), boff = lds_byte(wc * 32 + fr, fq * 8);
#define PG8_SA(b, h) (((b) * 2 + (h)) * HTB)
#define PG8_SB(b, h) ((4 + (b) * 2 + (h)) * HTB)
#define PG8_STAGE(bufoff, gbase, voff) do { _Pragma("unroll") for (int _i = 0; _i < 2; ++_i) \
        __builtin_amdgcn_global_load_lds((const unsigned*)((const char*)(gbase) + (voff)[_i]), (PG8_LAS unsigned*)(lds + (bufoff) + ldsw + _i * 8192), 16, 0, 0); } while (0)
#define PG8_LDA(dst, b, h) do { _Pragma("unroll") for (int m = 0; m < 4; ++m) _Pragma("unroll") for (int k = 0; k < 2; ++k) dst[m][k] = *(const PG8_LAS bf16x8*)(lds + PG8_SA(b, h) + aoff + m * 2048 + k * 1024); } while (0)
#define PG8_LDB(dst, b, h) do { _Pragma("unroll") for (int n = 0; n < 2; ++n) _Pragma("unroll") for (int k = 0; k < 2; ++k) dst[n][k] = *(const PG8_LAS bf16x8*)(lds + PG8_SB(b, h) + boff + n * 2048 + k * 1024); } while (0)
#define PG8_MMA(ai, bj, At, Bt) do { __builtin_amdgcn_s_setprio(1); _Pragma("unroll") for (int m = 0; m < 4; ++m) _Pragma("unroll") for (int n = 0; n < 2; ++n) _Pragma("unroll") for (int k = 0; k < 2; ++k) \
        acc[ai][bj][m][n] = __builtin_amdgcn_mfma_f32_16x16x32_bf16(Bt[n][k], At[m][k], acc[ai][bj][m][n], 0, 0, 0); __builtin_amdgcn_s_setprio(0); } while (0)
#define PG8_WAIT_V(n) asm volatile("s_waitcnt vmcnt(" #n ")" ::: "memory")
#define PG8_WAIT_L(n) asm volatile("s_waitcnt lgkmcnt(" #n ")" ::: "memory")
#define PG8_BAR __builtin_amdgcn_s_barrier()
#define PG8_SCHED __builtin_amdgcn_sched_barrier(0)
    Unit cur, nxt; int ui = 0;
    if (!S.next(0, cur)) return;
    f32x4 acc[2][2][4][2];
#pragma unroll
    for (int a = 0; a < 2; ++a)
#pragma unroll
        for (int b = 0; b < 2; ++b)
#pragma unroll
            for (int m = 0; m < 4; ++m)
#pragma unroll
                for (int n = 0; n < 2; ++n) acc[a][b][m][n] = (f32x4){0.f, 0.f, 0.f, 0.f};
    bf16x8 At[4][2], B0[2][2], B1[2][2];
    const char* cA = (const char*)g.A + (size_t)cur.pm * tstep; const char* cB = (const char*)g.Bt + (size_t)cur.pn * tstep;
    S.a_ready(cur);
    PG8_STAGE(PG8_SB(0, 0), cB, voffB); PG8_STAGE(PG8_SA(0, 0), cA, voffA); PG8_STAGE(PG8_SB(0, 1), cB + hstep, voffB); PG8_STAGE(PG8_SA(0, 1), cA + hstep, voffA);
    if (wr == 1) PG8_BAR;
    PG8_WAIT_V(4); PG8_BAR;
    PG8_STAGE(PG8_SB(1, 0), cB + kstep, voffB); PG8_STAGE(PG8_SA(1, 0), cA + kstep, voffA); PG8_STAGE(PG8_SB(1, 1), cB + hstep + kstep, voffB);
    PG8_WAIT_V(6); PG8_BAR;
    PG8_STAMP();
    for (;;) {
        const bool has_next = S.next(ui + 1, nxt);
        const char* nA = has_next ? (const char*)g.A + (size_t)nxt.pm * tstep : cA; const char* nB = has_next ? (const char*)g.Bt + (size_t)nxt.pn * tstep : cB;
        for (int t = 0; t < nt; t += 2) {
            const bool last = (t == nt - 2);
            const char* a1 = cA + (size_t)(t + 1) * kstep;
            const char* a2 = last ? nA : cA + (size_t)(t + 2) * kstep; const char* b2 = last ? nB : cB + (size_t)(t + 2) * kstep;
            const char* a3 = a2 + kstep; const char* b3 = b2 + kstep;
            if (last && has_next) S.a_ready(nxt);
            PG8_LDB(B0, 0, 0); PG8_SCHED; PG8_LDA(At, 0, 0); PG8_STAGE(PG8_SA(1, 1), a1 + hstep, voffA);
            PG8_WAIT_L(8); PG8_BAR; PG8_WAIT_L(0); PG8_MMA(0, 0, At, B0); PG8_BAR; PG8_SCHED;
            PG8_LDB(B1, 0, 1); PG8_STAGE(PG8_SB(0, 0), b2, voffB);
            PG8_BAR; PG8_WAIT_L(0); PG8_MMA(0, 1, At, B1); PG8_BAR;
            PG8_LDA(At, 0, 1); PG8_STAGE(PG8_SA(0, 0), a2, voffA);
            PG8_BAR; PG8_WAIT_L(0); PG8_MMA(1, 0, At, B0); PG8_BAR; PG8_SCHED;
            PG8_STAGE(PG8_SB(0, 1), b2 + hstep, voffB);
            PG8_WAIT_V(6); PG8_BAR; PG8_MMA(1, 1, At, B1); PG8_BAR;
            PG8_LDB(B0, 1, 0); PG8_SCHED; PG8_LDA(At, 1, 0); PG8_STAGE(PG8_SA(0, 1), a2 + hstep, voffA);
            PG8_WAIT_L(8); PG8_BAR; PG8_WAIT_L(0); PG8_MMA(0, 0, At, B0); PG8_BAR; PG8_SCHED;
            PG8_LDB(B1, 1, 1); PG8_STAGE(PG8_SB(1, 0), b3, voffB);
            PG8_BAR; PG8_WAIT_L(0); PG8_MMA(0, 1, At, B1); PG8_BAR;
            PG8_LDA(At, 1, 1); PG8_STAGE(PG8_SA(1, 0), a3, voffA);
            PG8_BAR; PG8_WAIT_L(0); PG8_MMA(1, 0, At, B0); PG8_BAR; PG8_SCHED;
            PG8_STAGE(PG8_SB(1, 1), b3 + hstep, voffB);
            PG8_WAIT_V(6); PG8_BAR; PG8_MMA(1, 1, At, B1); PG8_BAR;
        }
        PG8_STAMP();
        if constexpr (!Epi::AFTER_DRAIN) { E(acc, cur, wr, wc, fr, fq); S.done(cur); }
        PG8_STAMP();
        if (!has_next) break;
#pragma unroll
        for (int a = 0; a < 2; ++a)
#pragma unroll
            for (int b = 0; b < 2; ++b)
#pragma unroll
                for (int m = 0; m < 4; ++m)
#pragma unroll
                    for (int n = 0; n < 2; ++n) acc[a][b][m][n] = (f32x4){0.f, 0.f, 0.f, 0.f};
        cur = nxt; cA = nA; cB = nB; ++ui;
    }
    PG8_WAIT_V(0);
    if (wr == 0) PG8_BAR;
    PG8_BAR;
    if constexpr (Epi::AFTER_DRAIN) { E.fused(acc, cur, wr, wc, fr, fq, lds, wid, lane); S.done(cur); }
    PG8_STAMP();
    if (STAMP && wid == 0) { stamps[lane] = lane < nts ? (((unsigned long long)(unsigned)ts_hi << 32) | (unsigned)ts_lo) : 0ull;
        if (lane == 62) stamps[62] = rt_entry; if (lane == 63) stamps[63] = (unsigned long long)wall_clock64(); }
#undef PG8_STAMP
#undef PG8_SA
#undef PG8_SB
#undef PG8_STAGE
#undef PG8_LDA
#undef PG8_LDB
#undef PG8_MMA
#undef PG8_WAIT_V
#undef PG8_WAIT_L
#undef PG8_BAR
#undef PG8_SCHED
}
}

struct EpiSwiglu {
  static constexpr bool PERM = true, AFTER_DRAIN = false;
  unsigned short* H;
  __device__ __forceinline__ void operator()(const pg8::f32x4 (&acc)[2][2][4][2], const pg8::Unit& u, int wr, int wc, int fr, int fq) const {
    const int row0 = u.pm * 256 + wr * 64 + fr, hc0 = u.pn * 128 + wc * 32 + 8 * fq;
#pragma unroll
    for (int ai = 0; ai < 2; ++ai)
#pragma unroll
      for (int m = 0; m < 4; ++m) {
        unsigned short* rowp = H + (size_t)(row0 + ai * 128 + m * 16) * FH + hc0;
        float v[8];
#pragma unroll
        for (int n = 0; n < 2; ++n)
#pragma unroll
          for (int i = 0; i < 4; ++i) v[n * 4 + i] = siluf_(acc[ai][0][m][n][i]) * acc[ai][1][m][n][i];
        pg8::u32x4 o;
        o[0] = pg8::cvt_pk_bf16(v[0], v[1]); o[1] = pg8::cvt_pk_bf16(v[2], v[3]);
        o[2] = pg8::cvt_pk_bf16(v[4], v[5]); o[3] = pg8::cvt_pk_bf16(v[6], v[7]);
        *(pg8::u32x4*)rowp = o;
      }
  }
};
struct EpiResid {
  static constexpr bool PERM = false, AFTER_DRAIN = false;
  float* X; const float* modl; int gidx; float scale;
  __device__ __forceinline__ void operator()(const pg8::f32x4 (&acc)[2][2][4][2], const pg8::Unit& u, int wr, int wc, int fr, int fq) const {
    const int row0 = u.pm * 256 + wr * 64 + fr, col0 = u.pn * 256 + wc * 32 + 4 * fq;
#pragma unroll
    for (int ai = 0; ai < 2; ++ai)
#pragma unroll
      for (int m = 0; m < 4; ++m) {
        const int row = row0 + ai * 128 + m * 16;
        const float* gt = modl + (size_t)modrow(row) * 9216 + gidx * 1024 + col0;
        float* xp = X + (size_t)row * D + col0;
        pg8::f32x4 gv[2][2], xv[2][2];
#pragma unroll
        for (int bj = 0; bj < 2; ++bj)
#pragma unroll
          for (int n = 0; n < 2; ++n) {
            gv[bj][n] = *(const pg8::f32x4*)(gt + bj * 128 + n * 16);
            xv[bj][n] = *(const pg8::f32x4*)(xp + bj * 128 + n * 16);
          }
#pragma unroll
        for (int bj = 0; bj < 2; ++bj)
#pragma unroll
          for (int n = 0; n < 2; ++n) *(pg8::f32x4*)(xp + bj * 128 + n * 16) = xv[bj][n] + (gv[bj][n] * scale) * acc[ai][bj][m][n];
      }
  }
};
struct EpiP {
  static constexpr bool PERM = false, AFTER_DRAIN = false;
  float* P;
  __device__ __forceinline__ void operator()(const pg8::f32x4 (&acc)[2][2][4][2], const pg8::Unit& u, int wr, int wc, int fr, int fq) const {
    const int row0 = u.pm * 256 + wr * 64 + fr, col0 = u.pn * 256 + wc * 32 + 4 * fq;
#pragma unroll
    for (int ai = 0; ai < 2; ++ai)
#pragma unroll
      for (int m = 0; m < 4; ++m) {
        float* rp = P + (size_t)(row0 + ai * 128 + m * 16) * INC;
#pragma unroll
        for (int bj = 0; bj < 2; ++bj)
#pragma unroll
          for (int n = 0; n < 2; ++n) {
            const int col = col0 + bj * 128 + n * 16;
            if (col < INC) *(pg8::f32x4*)(rp + col) = acc[ai][bj][m][n];
          }
      }
  }
};

template <class Epi>
__device__ __forceinline__ void phase_gemm(const void* A, const void* Bt, int N, int K, const Epi& E) {
  pg8::Gemm g; g.A = (const pg8::bf16_t*)A; g.Bt = (const pg8::bf16_t*)Bt; g.M = NTOK; g.N = N; g.K = K;
  int c_ = obid(), G_ = (int)gridDim.x;
  asm volatile("" : "+s"(c_), "+s"(G_));
  pg8::StaticOrder S; S.init(NTOK, N, G_, c_);
  pg8::gemm_phase<Epi, pg8::StaticOrder, false>((PG8_LAS unsigned char*)smem, g, S, E, nullptr);
  __syncthreads();
}

__device__ __forceinline__ int scan2tok(int R) {
  if (R < NCTX) return R;
  int q = R - NCTX, b = q >> 10, n = q & 1023;
  return NCTX + b * 1024 + (n & 15) * 64 + (n >> 4);
}

__device__ __forceinline__ float rw_shift(const float* P, int R, int n, int L, int c, float mu) {
  float pc = P[(size_t)scan2tok(R) * INC + C_RW + c];
  float pp = n > 0 ? P[(size_t)scan2tok(R - 1) * INC + C_RW + c] : 0.f;
  float pn = n < L - 1 ? P[(size_t)scan2tok(R + 1) * INC + C_RW + c] : 0.f;
  return pc + (0.5f * (pp + pn) - pc) * mu;
}

__device__ __forceinline__ float rdlane(float v, int l) { return __int_as_float(__builtin_amdgcn_readlane(__float_as_int(v), l)); }

__device__ __forceinline__ void prep_rwkv(const Params& p, int l) {
  const int wave = otid() >> 6, lane = otid() & 63;
  const float* P = (const float*)(p.ws + OFF_P);
  float* rec = (float*)(p.ws + OFF_REC);
  const float* mu = p.in[I_RMU] + l * 1312;
  const float* w0 = p.in[I_RW0] + l * 768;
  const float* w2 = p.in[I_RW2] + (size_t)l * 64 * 384;
  const float* a0 = p.in[I_RA0] + l * 384;
  const float* a2 = p.in[I_RA2] + (size_t)l * 32 * 384;
  const float* g2 = p.in[I_RG2] + (size_t)l * 64 * 384;
  const float* kkw = p.in[I_RKK] + l * 384;
  const float* kaw = p.in[I_RKA] + l * 384;
  float* wl = (float*)smem;
#pragma unroll 1
  for (int hp = 0; hp < 2; ++hp) {
    const int hb = hp * 3;
    __syncthreads();
    for (int i = otid(); i < 160 * 48; i += NTHR) {
      const int r = i / 48, c4 = (i % 48) * 4;
      const float* src = (r < 64 ? w2 + r * 384 : (r < 96 ? a2 + (r - 64) * 384 : g2 + (r - 96) * 384)) + hb * 64 + c4;
      *(float4*)(wl + r * 192 + c4) = *(const float4*)src;
    }
    __syncthreads();
    for (int task = obid() * 8 + wave; task < NTOK / 6; task += gridDim.x * 8) {
      const int R0 = task * 6;
      int nn[6], LL[6];
#pragma unroll
      for (int tp = 0; tp < 6; ++tp) {
        const int R = R0 + tp;
        if (R < NCTX) { nn[tp] = R & 255; LL[tp] = 256; } else { nn[tp] = (R - NCTX) & 1023; LL[tp] = 1024; }
      }
      float x0[6], x1[6], x2[6];
#pragma unroll
      for (int tp = 0; tp < 6; ++tp) {
        x0[tp] = rw_shift(P, R0 + tp, nn[tp], LL[tp], 1152 + lane, mu[1152 + lane]);
        x1[tp] = rw_shift(P, R0 + tp, nn[tp], LL[tp], 1216 + lane, mu[1216 + lane]);
        const int c2 = 1280 + (lane & 31);
        x2[tp] = rw_shift(P, R0 + tp, nn[tp], LL[tp], c2, mu[c2]);
        if (tp & 1) __builtin_amdgcn_sched_barrier(0);
      }
      float kx[3][6];
#pragma unroll
      for (int h = 0; h < 3; ++h) {
        const int c = (hb + h) * 64 + lane;
#pragma unroll
        for (int tp = 0; tp < 6; ++tp) {
          kx[h][tp] = rw_shift(P, R0 + tp, nn[tp], LL[tp], 384 + c, mu[384 + c]);
        }
      }
#pragma unroll
      for (int tp = 0; tp < 6; ++tp) {
        x0[tp] = tanhf(x0[tp]);
        x1[tp] = lane < 32 ? x1[tp] : sigmoidf_(x1[tp]);
        x2[tp] = sigmoidf_(x2[tp]);
      }
      float af[3][6], ab[3][6], aa[3][6], ag[3][6];
#pragma unroll
      for (int h = 0; h < 3; ++h)
#pragma unroll
        for (int tp = 0; tp < 6; ++tp) { af[h][tp] = 0.f; ab[h][tp] = 0.f; aa[h][tp] = 0.f; ag[h][tp] = 0.f; }
      const float* wlp = wl + lane;
      for (int j = 0; j < 32; ++j) {
        float wc[15];
#pragma unroll
        for (int h = 0; h < 3; ++h) {
          wc[h] = wlp[j * 192 + h * 64]; wc[3 + h] = wlp[(32 + j) * 192 + h * 64];
          wc[6 + h] = wlp[(64 + j) * 192 + h * 64]; wc[9 + h] = wlp[(96 + j) * 192 + h * 64]; wc[12 + h] = wlp[(128 + j) * 192 + h * 64];
        }
#pragma unroll
        for (int tp = 0; tp < 6; ++tp) {
          const float sf = rdlane(x0[tp], j), sb = rdlane(x0[tp], 32 + j), sA = rdlane(x1[tp], j), sg = rdlane(x1[tp], 32 + j), sh = rdlane(x2[tp], j);
#pragma unroll
          for (int h = 0; h < 3; ++h) {
            af[h][tp] += sf * wc[h]; ab[h][tp] += sb * wc[3 + h]; aa[h][tp] += sA * wc[6 + h];
            ag[h][tp] += sg * wc[9 + h]; ag[h][tp] += sh * wc[12 + h];
          }
        }
      }
      int R0e = R0;
      asm volatile("" : "+v"(R0e));
#pragma unroll
      for (int h = 0; h < 3; ++h) {
        const int c = (hb + h) * 64 + lane;
#pragma unroll
        for (int tp = 0; tp < 6; ++tp) {
          const int R = R0e + tp;
          const float kxv = kx[h][tp];
          const float aav = aa[h][tp], afv = af[h][tp], abv = ab[h][tp], agv = ag[h][tp];
          float a = sigmoidf_(a0[c] + aav);
          float kk = kxv * kkw[c];
          float ss = wave_sum(kk * kk);
          kk = kk * rsqrtf(fmaxf(ss, 1e-24f));
          float k2 = kxv * (1.f + (a - 1.f) * kaw[c]);
          float uf = w0[c] + afv, ub = w0[384 + c] + abv;
          float df = expf(-0.6065306597126334f * sigmoidf_(uf));
          float db = expf(-0.6065306597126334f * sigmoidf_(ub));
          const float r_ = rw_shift(P, R, nn[tp], LL[tp], c, mu[c]);
          const float v_ = rw_shift(P, R, nn[tp], LL[tp], 768 + c, mu[768 + c]);
          float* o = rec + ((size_t)R * 6 + hb + h) * 512 + lane;
          o[0] = r_; o[128] = v_;
          o[64] = k2; o[192] = -kk; o[256] = kk * a; o[320] = df; o[384] = db; o[448] = agv;
        }
      }
    }
  }
  __syncthreads();
}

__device__ __forceinline__ float logsigmoidf_(float x) { return fminf(x, 0.f) - log1pf(expf(-fabsf(x))); }

__device__ __forceinline__ void prep_gla(const Params& p, int l) {
  const int wave = otid() >> 6, lane = otid() & 63;
  const float* P = (const float*)(p.ws + OFF_P);
  float* grec = (float*)(p.ws + OFF_GREC);
  const float* w2 = p.in[I_GW2] + (size_t)l * 2 * 16 * 192;
  const float* ab = p.in[I_GB] + l * 384;
  const int z = lane >> 5, d = lane & 31;
  float wreg[6][16], breg[6];
#pragma unroll
  for (int h = 0; h < 6; ++h) {
    breg[h] = ab[z * 192 + h * 32 + d];
#pragma unroll
    for (int r = 0; r < 16; ++r) wreg[h][r] = w2[(z * 16 + r) * 192 + h * 32 + d];
  }
  for (int tok = obid() * 8 + wave; tok < NTOK; tok += gridDim.x * 8) {
    const float* pr = P + (size_t)tok * INC;
    float lr[16];
#pragma unroll
    for (int r4 = 0; r4 < 4; ++r4) {
      float4 v = *(const float4*)(pr + 1152 + z * 16 + r4 * 4);
      lr[r4 * 4 + 0] = v.x; lr[r4 * 4 + 1] = v.y; lr[r4 * 4 + 2] = v.z; lr[r4 * 4 + 3] = v.w;
    }
    float qk[6], vv[6], gg[6];
#pragma unroll
    for (int h = 0; h < 6; ++h) {
      qk[h] = lane < 32 ? pr[h * 32 + lane] : pr[192 + h * 32 + (lane - 32)];
      vv[h] = pr[384 + h * 64 + lane];
      gg[h] = pr[768 + h * 64 + lane];
    }
    __builtin_amdgcn_sched_barrier(0);
#pragma unroll
    for (int h = 0; h < 6; ++h) {
      float acc = breg[h];
#pragma unroll
      for (int r = 0; r < 16; ++r) acc += lr[r] * wreg[h][r];
      float alpha = expf(logsigmoidf_(acc) * (1.f / 16.f));
      float* o = grec + ((size_t)tok * 6 + h) * 256 + lane;
      o[0] = lane < 32 ? qk[h] * 0.17677669529663687f : qk[h];
      o[64] = alpha; o[128] = vv[h]; o[192] = gg[h];
    }
  }
}

__device__ __forceinline__ void prep_hyena(const Params& p, int l) {
  const float* P = (const float*)(p.ws + OFF_P);
  float* hz = (float*)(p.ws + OFF_HYZ);
  float* hx = (float*)(p.ws + OFF_HYX);
  const float* cw = p.in[I_HCW] + l * 3 * 768;
  const float* cb = p.in[I_HCB] + l * 768;
  const int c = otid() & 255, rsub = otid() >> 8;
  float w_[3][3], b_[3];
#pragma unroll
  for (int s = 0; s < 3; ++s) { b_[s] = cb[s * 256 + c]; for (int t = 0; t < 3; ++t) w_[s][t] = cw[t * 768 + s * 256 + c]; }
  for (int r0 = obid() * 8; r0 < NTOK; r0 += gridDim.x * 8) {
    float pv[4][3][3];
    int rows[4];
#pragma unroll
    for (int q = 0; q < 4; ++q) {
      const int row = r0 + q * 2 + rsub;
      rows[q] = row;
      int t, L;
      if (row < NCTX) { t = row & 255; L = 256; } else { t = (row - NCTX) & 1023; L = 1024; }
      const float* pc = P + (size_t)row * INC + C_HY + c;
#pragma unroll
      for (int s = 0; s < 3; ++s) {
        pv[q][s][1] = pc[s * 256];
        pv[q][s][0] = t > 0 ? pc[s * 256 - INC] : 0.f;
        pv[q][s][2] = t < L - 1 ? pc[s * 256 + INC] : 0.f;
      }
    }
#pragma unroll
    for (int q = 0; q < 4; ++q) {
      float u[3];
#pragma unroll
      for (int s = 0; s < 3; ++s) u[s] = pv[q][s][0] * w_[s][0] + pv[q][s][1] * w_[s][1] + pv[q][s][2] * w_[s][2] + b_[s];
      hx[(size_t)rows[q] * 256 + c] = u[0];
      hz[(size_t)rows[q] * 256 + c] = u[1] * u[2];
      ((unsigned short*)(p.ws + OFF_HZB))[(size_t)rows[q] * 256 + c] = f2bf(u[1] * u[2]);
    }
  }
}

__device__ __forceinline__ void glds16(const void* g, void* l) {
  __builtin_amdgcn_global_load_lds((const unsigned*)g, (unsigned*)l, 16, 0, 0);
}

#define VMW(n) asm volatile("s_waitcnt vmcnt(" #n ")" ::: "memory")
#define LGKM0 __builtin_amdgcn_s_waitcnt(0xC07F)
__device__ __forceinline__ float quad_sum(float x) {
  x += __int_as_float(__builtin_amdgcn_update_dpp(0, __float_as_int(x), 0xB1, 0xF, 0xF, true));
  x += __int_as_float(__builtin_amdgcn_update_dpp(0, __float_as_int(x), 0x4E, 0xF, 0xF, true));
  return x;
}

template <int R> struct RwOps { f32x4 A[2], B[2], K[2], W[2], Rr[2]; float v[R]; };
constexpr int RW_SLOT = 1536;
__device__ __forceinline__ void rw_fill(const float* recg, char* slot, int lane, int dir) {
  glds16((const char*)recg + lane * 16, slot);
  if (lane < 32) {
    const char* g2 = (const char*)recg + (lane < 16 ? 1024 + lane * 16 : (5 + dir) * 256 + (lane - 16) * 16);
    glds16(g2, slot + 1024);
  }
}
template <int R>
__device__ __forceinline__ void rw_load(RwOps<R>& o, const char* rec, int k8, int vrow) {
  const f32x4* q = (const f32x4*)rec + k8 * 2;
#pragma unroll
  for (int i = 0; i < 2; ++i) { o.Rr[i] = q[i]; o.K[i] = q[16 + i]; o.A[i] = q[48 + i]; o.B[i] = q[64 + i]; o.W[i] = q[80 + i]; }
  if (R == 2) { f32x2 t = *(const f32x2*)((const float*)rec + 128 + vrow); o.v[0] = t.x; o.v[R - 1] = t.y; }
  else o.v[0] = ((const float*)rec)[128 + vrow];
}
template <int R>
__device__ __forceinline__ void rw_step(f32x2 (&S)[R][4], const RwOps<R>& o, float (&res)[R]) {
  const f32x2 A0 = {o.A[0][0], o.A[0][1]}, A1 = {o.A[0][2], o.A[0][3]}, A2 = {o.A[1][0], o.A[1][1]}, A3 = {o.A[1][2], o.A[1][3]};
  float sa[R];
#pragma unroll
  for (int r = 0; r < R; ++r) {
    f32x2 p0 = S[r][0] * A0, q0 = S[r][1] * A1;
    p0 += S[r][2] * A2; q0 += S[r][3] * A3;
    p0 += q0;
    sa[r] = p0.x + p0.y;
  }
#pragma unroll
  for (int r = 0; r < R; ++r) sa[r] += dpp_f(sa[r], 0);
#pragma unroll
  for (int r = 0; r < R; ++r) sa[r] += dpp_f(sa[r], 1);
#pragma unroll
  for (int r = 0; r < R; ++r) sa[r] += dpp_f(sa[r], 2);
#pragma unroll
  for (int i = 0; i < 4; ++i) {
    const f32x2 W = {o.W[i >> 1][(i & 1) * 2], o.W[i >> 1][(i & 1) * 2 + 1]};
    const f32x2 B = {o.B[i >> 1][(i & 1) * 2], o.B[i >> 1][(i & 1) * 2 + 1]};
    const f32x2 K = {o.K[i >> 1][(i & 1) * 2], o.K[i >> 1][(i & 1) * 2 + 1]};
#pragma unroll
    for (int r = 0; r < R; ++r) S[r][i] = S[r][i] * W + (f32x2{sa[r], sa[r]} * B + f32x2{o.v[r], o.v[r]} * K);
  }
  const f32x2 R0 = {o.Rr[0][0], o.Rr[0][1]}, R1 = {o.Rr[0][2], o.Rr[0][3]}, R2 = {o.Rr[1][0], o.Rr[1][1]}, R3 = {o.Rr[1][2], o.Rr[1][3]};
#pragma unroll
  for (int r = 0; r < R; ++r) {
    f32x2 u0 = S[r][0] * R0, w0 = S[r][1] * R1;
    u0 += S[r][2] * R2; w0 += S[r][3] * R3;
    u0 += w0;
    res[r] = u0.x + u0.y;
  }
#pragma unroll
  for (int r = 0; r < R; ++r) res[r] += dpp_f(res[r], 0);
#pragma unroll
  for (int r = 0; r < R; ++r) res[r] += dpp_f(res[r], 1);
#pragma unroll
  for (int r = 0; r < R; ++r) res[r] += dpp_f(res[r], 2);
}

template <int NW>
__device__ __forceinline__ void rw_poll(volatile unsigned* f, unsigned target) {
  for (unsigned sp = 0; sp < (1u << 20); ++sp) {
    unsigned m = min(min(f[0], f[1]), min(f[2], f[3]));
    if (NW == 8) m = min(m, min(min(f[4], f[5]), min(f[6], f[7])));
    if ((unsigned)__builtin_amdgcn_readfirstlane((int)m) >= target) break;
    __builtin_amdgcn_s_sleep(1);
  }
  asm volatile("" ::: "memory");
}

constexpr int RQ_STEPS = 64;
template <int NW, int R, int RING>
__device__ __forceinline__ void rwkv_scan(const Params& p, int l, int scan, int w, int rowoff, char* ring, volatile unsigned* fl) {
  constexpr int LPC = 8 / NW;
  constexpr int NCHR = RING / 8;
  static_assert(NW == 4 && (RING == 64 || RING == 32), "vmcnt immediates below are written for these cases");
  const int lane = otid() & 63;
  scan = __builtin_amdgcn_readfirstlane(scan);
  w = __builtin_amdgcn_readfirstlane(w);
  int b, hd, L, rowbase;
  const bool lat = scan < 96;
  if (lat) { b = scan / 12; hd = scan % 12; L = 1024; rowbase = NCTX + b * 1024; }
  else { int t2 = scan - 96; b = t2 / 12; hd = t2 % 12; L = 256; rowbase = b * 256; }
  const int h = hd >> 1, dir = hd & 1;
  const int k8 = lane & 7, vrow = rowoff + w * (8 * R) + (lane >> 3) * R;
  const float* rec = (const float*)(p.ws + OFF_REC);
  float* RO = (float*)(p.ws + OFF_RO) + (size_t)dir * NTOK * 384 + h * 64 + vrow + (R == 2 ? (k8 & 1) : 0);
  f32x2 S[R][4];
  if (lat) {
    const float* sb = p.in[I_SR] + ((((size_t)b * DEPTH + l) * 2 + dir) * 6 + h) * 4096 + vrow * 64 + k8 * 8;
#pragma unroll
    for (int r = 0; r < R; ++r)
#pragma unroll
      for (int i = 0; i < 2; ++i) { float4 v = *(const float4*)(sb + r * 64 + i * 4); S[r][2 * i] = f32x2{v.x, v.y}; S[r][2 * i + 1] = f32x2{v.z, v.w}; }
  } else {
#pragma unroll
    for (int r = 0; r < R; ++r)
#pragma unroll
      for (int i = 0; i < 4; ++i) S[r][i] = f32x2{0.f, 0.f};
  }
  VMW(0);
  const int NCH = L >> 3;
#define RW_REC(st) (rec + ((size_t)(rowbase + (dir ? L - 1 - (st) : (st))) * 6 + h) * 512)
#define RW_SLOTP(st) (ring + ((st) & (RING - 1)) * RW_SLOT)
#pragma unroll
  for (int c = 0; c < NCHR - 1; ++c)
#pragma unroll
    for (int t = 0; t < LPC; ++t) { const int s = 8 * c + NW * t + w; rw_fill(RW_REC(s), RW_SLOTP(s), lane, dir); }
  RwOps<R> oa{};
  float osel = 0.f;
  for (int c = 0; c < NCH; ++c) {
    if (c + NCHR - 2 <= NCH - 1) { if (RING == 64) VMW(20); else VMW(4); } else VMW(0);
    if (lane == 0) fl[w] = (unsigned)(c + 2);
    rw_poll<NW>(fl, (unsigned)(c + 2));
    if (c == 0) rw_load<R>(oa, RW_SLOTP(0), k8, vrow);
    for (int j = 0; j < 8; j += 2) {
      const int s = 8 * c + j;
      RwOps<R> ob;
      LGKM0;
      rw_load<R>(ob, RW_SLOTP(s + 1), k8, vrow);
      __builtin_amdgcn_sched_barrier(0);
      {
        float o[R];
        rw_step<R>(S, oa, o);
        if (R == 2) osel = ((s & 3) == (k8 >> 1)) ? ((k8 & 1) ? o[R - 1] : o[0]) : osel;
        else osel = ((s & 7) == k8) ? o[0] : osel;
      }
      __builtin_amdgcn_sched_barrier(0);
      LGKM0;
      rw_load<R>(oa, RW_SLOTP(s + 2), k8, vrow);
      __builtin_amdgcn_sched_barrier(0);
      {
        float o[R];
        rw_step<R>(S, ob, o);
        if (R == 2) {
          osel = (((s + 1) & 3) == (k8 >> 1)) ? ((k8 & 1) ? o[R - 1] : o[0]) : osel;
          if (((s + 1) & 3) == 3) {
            const int st = s - 2 + (k8 >> 1);
            const int n = dir ? L - 1 - st : st;
            RO[(size_t)(rowbase + n) * 384] = osel;
          }
        } else {
          osel = (((s + 1) & 7) == k8) ? o[0] : osel;
          if (((s + 1) & 7) == 7) {
            const int st = s - 6 + k8;
            const int n = dir ? L - 1 - st : st;
            RO[(size_t)(rowbase + n) * 384] = osel;
          }
        }
      }
      __builtin_amdgcn_sched_barrier(0);
    }
    asm volatile("" ::: "memory");
    if (lane == 0) fl[8 + w] = (unsigned)(c + 1);
    if (c + NCHR - 1 < NCH) {
      rw_poll<NW>(fl + 8, (unsigned)c);
#pragma unroll
      for (int t = 0; t < LPC; ++t) { const int s = 8 * (c + NCHR - 1) + NW * t + w; rw_fill(RW_REC(s), RW_SLOTP(s), lane, dir); }
    }
  }
#undef RW_REC
#undef RW_SLOTP
  if (!lat) {
    float* so = p.out + (size_t)NTOK * D + (size_t)16 * DEPTH * 2 * 6 * 2048 +
                ((((size_t)b * DEPTH + l) * 2 + dir) * 6 + h) * 4096 + vrow * 64 + k8 * 8;
#pragma unroll
    for (int r = 0; r < R; ++r)
#pragma unroll
      for (int i = 0; i < 2; ++i) *(float4*)(so + r * 64 + i * 4) = make_float4(S[r][2 * i].x, S[r][2 * i].y, S[r][2 * i + 1].x, S[r][2 * i + 1].y);
  }
  VMW(0);
}

struct RwOpsLa { f32x4 An[2], B[2], K[2], W[2], Rr[2]; float v; };
__device__ __forceinline__ void rw_load_la(RwOpsLa& o, const char* rec, const char* recn, int k8, int vrow) {
  const f32x4* q = (const f32x4*)rec + k8 * 2;
  const f32x4* qn = (const f32x4*)recn + k8 * 2;
#pragma unroll
  for (int i = 0; i < 2; ++i) { o.Rr[i] = q[i]; o.K[i] = q[16 + i]; o.B[i] = q[64 + i]; o.W[i] = q[80 + i]; o.An[i] = qn[48 + i]; }
  o.v = ((const float*)rec)[128 + vrow];
}
__device__ __forceinline__ float rw_step_la(f32x2 (&S)[4], float& sa, const RwOpsLa& o) {
  f32x2 W2[4], B2[4], K2[4], A2[4], R2[4];
#pragma unroll
  for (int i = 0; i < 4; ++i) {
    const int a = i >> 1, c = (i & 1) * 2;
    W2[i] = f32x2{o.W[a][c], o.W[a][c + 1]}; B2[i] = f32x2{o.B[a][c], o.B[a][c + 1]}; K2[i] = f32x2{o.K[a][c], o.K[a][c + 1]};
    A2[i] = f32x2{o.An[a][c], o.An[a][c + 1]}; R2[i] = f32x2{o.Rr[a][c], o.Rr[a][c + 1]};
  }
  const f32x2 vv = {o.v, o.v};
  f32x2 T[4];
#pragma unroll
  for (int i = 0; i < 4; ++i) T[i] = S[i] * W2[i] + vv * K2[i];
  f32x2 g0 = T[0] * A2[0], g1 = T[1] * A2[1];
  g0 += T[2] * A2[2]; g1 += T[3] * A2[3]; g0 += g1;
  f32x2 b0 = B2[0] * A2[0], b1 = B2[1] * A2[1];
  b0 += B2[2] * A2[2]; b1 += B2[3] * A2[3]; b0 += b1;
  float gp = g0.x + g0.y, bp = b0.x + b0.y;
  gp += dpp_f(gp, 0); bp += dpp_f(bp, 0);
  gp += dpp_f(gp, 1); bp += dpp_f(bp, 1);
  gp += dpp_f(gp, 2); bp += dpp_f(bp, 2);
  const f32x2 sav = {sa, sa};
#pragma unroll
  for (int i = 0; i < 4; ++i) S[i] = sav * B2[i] + T[i];
  f32x2 u0 = S[0] * R2[0], u1 = S[1] * R2[1];
  u0 += S[2] * R2[2]; u1 += S[3] * R2[3]; u0 += u1;
  float ov = u0.x + u0.y;
  ov += dpp_f(ov, 0); ov += dpp_f(ov, 1); ov += dpp_f(ov, 2);
  sa = sa * bp + gp;
  return ov;
}

__device__ __forceinline__ void rwkv_scan_la(const Params& p, int l, int scan, int w, int rowoff, char* ring, volatile unsigned* fl) {
  constexpr int NW = 4, R = 1, RING = 64;
  constexpr int LPC = 8 / NW;
  constexpr int NCHR = RING / 8;
  static_assert(NW == 4 && (RING == 64 || RING == 32), "vmcnt immediates below are written for these cases");
  const int lane = otid() & 63;
  scan = __builtin_amdgcn_readfirstlane(scan);
  w = __builtin_amdgcn_readfirstlane(w);
  int b, hd, L, rowbase;
  const bool lat = scan < 96;
  if (lat) { b = scan / 12; hd = scan % 12; L = 1024; rowbase = NCTX + b * 1024; }
  else { int t2 = scan - 96; b = t2 / 12; hd = t2 % 12; L = 256; rowbase = b * 256; }
  const int h = hd >> 1, dir = hd & 1;
  const int k8 = lane & 7, vrow = rowoff + w * (8 * R) + (lane >> 3) * R;
  const float* rec = (const float*)(p.ws + OFF_REC);
  float* RO = (float*)(p.ws + OFF_RO) + (size_t)dir * NTOK * 384 + h * 64 + vrow + (R == 2 ? (k8 & 1) : 0);
  f32x2 S[R][4];
  if (lat) {
    const float* sb = p.in[I_SR] + ((((size_t)b * DEPTH + l) * 2 + dir) * 6 + h) * 4096 + vrow * 64 + k8 * 8;
#pragma unroll
    for (int r = 0; r < R; ++r)
#pragma unroll
      for (int i = 0; i < 2; ++i) { float4 v = *(const float4*)(sb + r * 64 + i * 4); S[r][2 * i] = f32x2{v.x, v.y}; S[r][2 * i + 1] = f32x2{v.z, v.w}; }
  } else {
#pragma unroll
    for (int r = 0; r < R; ++r)
#pragma unroll
      for (int i = 0; i < 4; ++i) S[r][i] = f32x2{0.f, 0.f};
  }
  VMW(0);
  const int NCH = L >> 3;
#define RW_REC(st) (rec + ((size_t)(rowbase + (dir ? L - 1 - (st) : (st))) * 6 + h) * 512)
#define RW_SLOTP(st) (ring + ((st) & (RING - 1)) * RW_SLOT)
#pragma unroll
  for (int c = 0; c < NCHR - 1; ++c)
#pragma unroll
    for (int t = 0; t < LPC; ++t) { const int s = 8 * c + NW * t + w; rw_fill(RW_REC(s), RW_SLOTP(s), lane, dir); }
  RwOpsLa oa{};
  float sa = 0.f;
  float osel = 0.f;
  for (int c = 0; c < NCH; ++c) {
    if (c + NCHR - 2 <= NCH - 1) { if (RING == 64) VMW(20); else VMW(4); } else VMW(0);
    if (lane == 0) fl[w] = (unsigned)(c + 2);
    rw_poll<NW>(fl, (unsigned)(c + 2));
    if (c == 0) {
      const f32x4* q0 = (const f32x4*)RW_SLOTP(0) + k8 * 2;
      const f32x4 a0 = q0[48], a1 = q0[49];
      f32x2 d0 = S[0][0] * f32x2{a0[0], a0[1]}, d1 = S[0][1] * f32x2{a0[2], a0[3]};
      d0 += S[0][2] * f32x2{a1[0], a1[1]}; d1 += S[0][3] * f32x2{a1[2], a1[3]};
      d0 += d1;
      sa = d0.x + d0.y;
      sa += dpp_f(sa, 0); sa += dpp_f(sa, 1); sa += dpp_f(sa, 2);
      rw_load_la(oa, RW_SLOTP(0), RW_SLOTP(1), k8, vrow);
    }
    for (int j = 0; j < 8; j += 2) {
      const int s = 8 * c + j;
      RwOpsLa ob;
      LGKM0;
      rw_load_la(ob, RW_SLOTP(s + 1), RW_SLOTP(s + 2), k8, vrow);
      __builtin_amdgcn_sched_barrier(0);
      {
        float o[R];
        o[0] = rw_step_la(S[0], sa, oa);
        if (R == 2) osel = ((s & 3) == (k8 >> 1)) ? ((k8 & 1) ? o[R - 1] : o[0]) : osel;
        else osel = ((s & 7) == k8) ? o[0] : osel;
      }
      __builtin_amdgcn_sched_barrier(0);
      LGKM0;
      rw_load_la(oa, RW_SLOTP(s + 2), RW_SLOTP(s + 3), k8, vrow);
      __builtin_amdgcn_sched_barrier(0);
      {
        float o[R];
        o[0] = rw_step_la(S[0], sa, ob);
        if (R == 2) {
          osel = (((s + 1) & 3) == (k8 >> 1)) ? ((k8 & 1) ? o[R - 1] : o[0]) : osel;
          if (((s + 1) & 3) == 3) {
            const int st = s - 2 + (k8 >> 1);
            const int n = dir ? L - 1 - st : st;
            RO[(size_t)(rowbase + n) * 384] = osel;
          }
        } else {
          osel = (((s + 1) & 7) == k8) ? o[0] : osel;
          if (((s + 1) & 7) == 7) {
            const int st = s - 6 + k8;
            const int n = dir ? L - 1 - st : st;
            RO[(size_t)(rowbase + n) * 384] = osel;
          }
        }
      }
      __builtin_amdgcn_sched_barrier(0);
    }
    asm volatile("" ::: "memory");
    if (lane == 0) fl[8 + w] = (unsigned)(c + 1);
    if (c + NCHR - 1 < NCH) {
      rw_poll<NW>(fl + 8, (unsigned)c);
#pragma unroll
      for (int t = 0; t < LPC; ++t) { const int s = 8 * (c + NCHR - 1) + NW * t + w; rw_fill(RW_REC(s), RW_SLOTP(s), lane, dir); }
    }
  }
#undef RW_REC
#undef RW_SLOTP
  if (!lat) {
    float* so = p.out + (size_t)NTOK * D + (size_t)16 * DEPTH * 2 * 6 * 2048 +
                ((((size_t)b * DEPTH + l) * 2 + dir) * 6 + h) * 4096 + vrow * 64 + k8 * 8;
#pragma unroll
    for (int r = 0; r < R; ++r)
#pragma unroll
      for (int i = 0; i < 2; ++i) *(float4*)(so + r * 64 + i * 4) = make_float4(S[r][2 * i].x, S[r][2 * i].y, S[r][2 * i + 1].x, S[r][2 * i + 1].y);
  }
  VMW(0);
}

template <int NE> struct GlOps { f32x4 Q[2], K[2], A[2]; float v[NE]; };
constexpr int GL_RING = 32, GL_SLOT = 768;
template <int NE>
__device__ __forceinline__ void gl_load(GlOps<NE>& o, const char* rec, int dir, int dq, int ecol) {
  const f32x4* q = (const f32x4*)rec;
#pragma unroll
  for (int i = 0; i < 2; ++i) { o.Q[i] = q[dq * 2 + i]; o.K[i] = q[8 + dq * 2 + i]; o.A[i] = q[16 + dir * 8 + dq * 2 + i]; }
  if (NE == 4) { f32x4 t = *(const f32x4*)((const float*)rec + 128 + ecol); o.v[0] = t[0]; o.v[1] = t[1]; o.v[NE - 2] = t[2]; o.v[NE - 1] = t[3]; }
  else { f32x2 t = *(const f32x2*)((const float*)rec + 128 + ecol); o.v[0] = t.x; o.v[1] = t.y; }
}
template <int NE>
__device__ __forceinline__ float gl_step(f32x2 (&S)[8][NE / 2], const GlOps<NE>& o, int dq) {
  f32x2 vv[NE / 2], acc[NE / 2];
#pragma unroll
  for (int e = 0; e < NE / 2; ++e) { vv[e] = f32x2{o.v[2 * e], o.v[2 * e + 1]}; acc[e] = f32x2{0.f, 0.f}; }
#pragma unroll
  for (int d = 0; d < 8; ++d) {
    const float a = o.A[d >> 2][d & 3], kk = o.K[d >> 2][d & 3], qq = o.Q[d >> 2][d & 3];
    const f32x2 av = {a, a}, kv = {kk, kk}, qv = {qq, qq};
#pragma unroll
    for (int e = 0; e < NE / 2; ++e) { S[d][e] = av * S[d][e] + kv * vv[e]; acc[e] += qv * S[d][e]; }
  }
  if (NE == 4) {
    const float r0 = quad_sum(acc[0].x), r1 = quad_sum(acc[0].y), r2 = quad_sum(acc[NE / 2 - 1].x), r3 = quad_sum(acc[NE / 2 - 1].y);
    return dq == 0 ? r0 : (dq == 1 ? r1 : (dq == 2 ? r2 : r3));
  } else {
    const float r0 = quad_sum(acc[0].x), r1 = quad_sum(acc[0].y);
    return (dq & 1) ? r1 : r0;
  }
}
template <int NE>
__device__ __forceinline__ void gla_scan(const Params& p, int l, int task, int eh, char* ring  ) {
  const int lane = otid() & 63;
  task = __builtin_amdgcn_readfirstlane(task);
  int b, hd, L, rowbase;
  const bool lat = task < 96;
  if (lat) { b = task / 12; hd = task % 12; L = 1024; rowbase = NCTX + b * 1024; }
  else { int t2 = task - 96; b = t2 / 12; hd = t2 % 12; L = 256; rowbase = b * 256; }
  const int h = hd >> 1, dir = hd & 1;
  const int dq = lane & 3, eg = lane >> 2;
  const int ecol = (NE == 4) ? eg * 4 : eh * 32 + eg * 2;
  const bool owner = (NE == 4) || dq < 2;
  const float* grec = (const float*)(p.ws + OFF_GREC);
  float* GO = (float*)(p.ws + OFF_GO) + (size_t)dir * NTOK * 384 + h * 64 + ecol + (NE == 4 ? dq : (dq & 1));
  f32x2 S[8][NE / 2];
  if (lat) {
    const float* s0 = p.in[I_SG] + ((((size_t)b * DEPTH + l) * 2 + dir) * 6 + h) * 2048 + (dq * 8) * 64 + ecol;
#pragma unroll
    for (int d = 0; d < 8; ++d)
#pragma unroll
      for (int e = 0; e < NE / 2; ++e) { f32x2 v = *(const f32x2*)(s0 + d * 64 + 2 * e); S[d][e] = v; }
  } else {
#pragma unroll
    for (int d = 0; d < 8; ++d)
#pragma unroll
      for (int e = 0; e < NE / 2; ++e) S[d][e] = f32x2{0.f, 0.f};
  }
  VMW(0);
#define GL_REC(st) ((const char*)(grec + ((size_t)(rowbase + (dir ? L - 1 - (st) : (st))) * 6 + h) * 256))
#pragma unroll
  for (int s = 0; s < GL_RING; ++s) { if (lane < 48) glds16(GL_REC(s) + lane * 16, ring + s * GL_SLOT); }
  GlOps<NE> oa{};
  VMW(31);
  gl_load<NE>(oa, ring, dir, dq, ecol);
  for (int s = 0; s < L; s += 2) {
    GlOps<NE> ob;
    LGKM0; if (s + GL_RING >= L) VMW(0); else VMW(30);
    gl_load<NE>(ob, ring + ((s + 1) & (GL_RING - 1)) * GL_SLOT, dir, dq, ecol);
    __builtin_amdgcn_sched_barrier(0);
    {
      float o = gl_step<NE>(S, oa, dq);
      const int n = dir ? L - 1 - s : s;
      if (owner) GO[(size_t)(rowbase + n) * 384] = o;
    }
    asm volatile("" ::: "memory");
    if (s + GL_RING < L && lane < 48) glds16(GL_REC(s + GL_RING) + lane * 16, ring + (s & (GL_RING - 1)) * GL_SLOT);
    __builtin_amdgcn_sched_barrier(0);
    LGKM0; if (s + 1 + GL_RING >= L) VMW(0); else VMW(30);
    gl_load<NE>(oa, ring + ((s + 2) & (GL_RING - 1)) * GL_SLOT, dir, dq, ecol);
    __builtin_amdgcn_sched_barrier(0);
    {
      float o = gl_step<NE>(S, ob, dq);
      const int n = dir ? L - 2 - s : s + 1;
      if (owner) GO[(size_t)(rowbase + n) * 384] = o;
    }
    asm volatile("" ::: "memory");
    if (s + 1 + GL_RING < L && lane < 48) glds16(GL_REC(s + 1 + GL_RING) + lane * 16, ring + ((s + 1) & (GL_RING - 1)) * GL_SLOT);
    __builtin_amdgcn_sched_barrier(0);
  }
#undef GL_REC
  if (!lat) {
    float* so = p.out + (size_t)NTOK * D + ((((size_t)b * DEPTH + l) * 2 + dir) * 6 + h) * 2048 + (dq * 8) * 64 + ecol;
#pragma unroll
    for (int d = 0; d < 8; ++d)
#pragma unroll
      for (int e = 0; e < NE / 2; ++e) *(f32x2*)(so + d * 64 + 2 * e) = S[d][e];
  }
  VMW(0);
}

constexpr int HY_TASKS = 768;
__device__ __forceinline__ void hyena_task(const Params& p, int l, int task) {
  const int lane = otid() & 63;
  int b, cgp, tb, L, rowbase;
  const float* ft = (const float*)(p.ws + OFF_FT) + (size_t)l * FT_LAYER;
  if (task < 512) { b = task >> 6; cgp = (task >> 5) & 1; tb = task & 31; L = 1024; rowbase = NCTX + b * 1024; ft += FT_L0; }
  else { int t2 = task - 512; b = t2 >> 4; cgp = (t2 >> 3) & 1; tb = t2 & 7; L = 256; rowbase = b * 256; }
  const int c = cgp * 128 + lane * 2;
  const int t0 = tb * 32;
  const float* hz = (const float*)(p.ws + OFF_HYZ) + (size_t)rowbase * 256 + c;
  const float* hx = (const float*)(p.ws + OFF_HYX) + (size_t)rowbase * 256 + c;
  const float* fc = ft + c;
  const unsigned short* hzb = (const unsigned short*)(p.ws + OFF_HZB) + (size_t)rowbase * 256 + c;
  const unsigned short* fcb = (const unsigned short*)(p.ws + OFF_FTB) + (size_t)(ft - (const float*)(p.ws + OFF_FT)) + c;
  f32x2 acc[32];
#pragma unroll
  for (int i = 0; i < 32; ++i) acc[i] = f32x2{0.f, 0.f};
  for (int s0 = 0; s0 < L; s0 += 16) {
    f32x2 z[16], f[47];
#pragma unroll
    for (int j = 0; j < 16; ++j) { const unsigned u = *(const unsigned*)(hzb + (size_t)(s0 + j) * 256); z[j] = f32x2{__uint_as_float(u << 16), __uint_as_float(u & 0xffff0000u)}; }
    const unsigned short* fb = fcb + (size_t)(t0 - s0 - 15 + L - 1) * 256;
#pragma unroll
    for (int m = 0; m < 47; ++m) { const unsigned u = *(const unsigned*)(fb + (size_t)m * 256); f[m] = f32x2{__uint_as_float(u << 16), __uint_as_float(u & 0xffff0000u)}; }
#pragma unroll
    for (int i = 0; i < 32; ++i)
#pragma unroll
      for (int j = 0; j < 16; ++j) acc[i] += f[i - j + 15] * z[j];
  }
  const f32x2 bias = *(const f32x2*)(p.in[I_HBIAS] + l * 256 + c);
  unsigned* O = (unsigned*)(p.ws + OFF_H);
#pragma unroll
  for (int i = 0; i < 32; ++i) {
    int t = t0 + i;
    f32x2 zz = *(const f32x2*)(hz + (size_t)t * 256), xx = *(const f32x2*)(hx + (size_t)t * 256);
    f32x2 y = xx * (acc[i] + zz * bias);
    O[((size_t)(rowbase + t) * D + 384 + c) >> 1] = (unsigned)f2bf(y.x) | ((unsigned)f2bf(y.y) << 16);
  }
}

constexpr int LDS_GLA = 98304, LDS_FLAGS = 147456, LDS_XB = 147584;
__device__ __forceinline__ void phase_mixers(const Params& p, int l, int cidx) {
  const int wave = otid() >> 6, lane = otid() & 63;
  const int bid = obid();
  volatile unsigned* fl = (volatile unsigned*)(smem + LDS_FLAGS);
  if (otid() < 32) fl[otid()] = 0u;
  __syncthreads();
  __builtin_amdgcn_s_setprio(3);
  if (bid < 192) {
    if (wave < 4) rwkv_scan_la(p, l, bid >> 1, wave, (bid & 1) * 32, smem, fl);
    else rwkv_scan<4, 2, 32>(p, l, 96 + bid, wave - 4, 0, smem + 98304, fl + 16);
  } else if (wave < 3) {
    const int g = (bid - 192) * 3 + wave;
    gla_scan<2>(p, l, g >> 1, g & 1, smem + wave * 24576);
  } else if (wave < 6) {
    gla_scan<4>(p, l, 96 + (bid - 192) * 3 + (wave - 3), 0, smem + wave * 24576);
  }
  __builtin_amdgcn_s_setprio(0);
  int* cnt = (int*)(p.ws + OFF_CNT) + cidx;
  const int ntask = HY_TASKS + (l < DEPTH - 1 ? 5312 : 0);
  while (true) {
    int t = 0;
    if (lane == 0) t = atomicAdd(cnt, 1);
    t = __shfl(t, 0);
    if (t >= ntask) break;
    if (t < HY_TASKS) hyena_task(p, l, t);
    else wconv_wave(p, l + 1, (l + 1) & 1, t - HY_TASKS);
  }
}

__device__ __forceinline__ void phase_post(const Params& p, int l) {
  const int wave = otid() >> 6, lane = otid() & 63;
  const float* GO = (const float*)(p.ws + OFF_GO);
  const float* RO = (const float*)(p.ws + OFF_RO);
  const float* grec = (const float*)(p.ws + OFF_GREC);
  const float* rec = (const float*)(p.ws + OFF_REC);
  unsigned short* O = (unsigned short*)(p.ws + OFF_H);
  const float gn = p.in[I_GN][l * 64 + lane];
  float lw[6], lb[6], rk[6];
#pragma unroll
  for (int h = 0; h < 6; ++h) { lw[h] = p.in[I_RLW][l * 384 + h * 64 + lane]; lb[h] = p.in[I_RLB][l * 384 + h * 64 + lane]; rk[h] = p.in[I_RRK][l * 384 + h * 64 + lane]; }
  for (int R = obid() * 8 + wave; R < NTOK; R += gridDim.x * 8) {
    const int tokr = scan2tok(R);
    float go[6], gg[6], ro[6], r_[6], k_[6], v_[6], g_[6];
#pragma unroll
    for (int h = 0; h < 6; ++h) {
      go[h] = GO[(size_t)R * 384 + h * 64 + lane] + GO[(size_t)(NTOK + R) * 384 + h * 64 + lane];
      gg[h] = grec[((size_t)R * 6 + h) * 256 + 192 + lane];
      ro[h] = RO[(size_t)R * 384 + h * 64 + lane] + RO[(size_t)(NTOK + R) * 384 + h * 64 + lane];
      const float* rr = rec + ((size_t)R * 6 + h) * 512 + lane;
      r_[h] = rr[0]; k_[h] = rr[64]; v_[h] = rr[128]; g_[h] = rr[448];
    }
    __builtin_amdgcn_sched_barrier(0);
#pragma unroll
    for (int h = 0; h < 6; ++h) {
      const float o = go[h];
      float ms = wave_sum(o * o) * (1.f / 64.f);
      float y = o * rsqrtf(ms + 1e-6f) * gn;
      O[(size_t)R * D + h * 64 + lane] = f2bf(y * siluf_(gg[h]));
    }
#pragma unroll
    for (int h = 0; h < 6; ++h) {
      const int c = h * 64 + lane;
      const float o = ro[h];
      float mean = wave_sum(o) * (1.f / 64.f);
      float dlt = o - mean;
      float var = wave_sum(dlt * dlt) * (1.f / 64.f);
      float y = dlt * rsqrtf(var + 64e-5f) * lw[h] + lb[h];
      float bonus = wave_sum(r_[h] * k_[h] * rk[h]) * v_[h];
      O[(size_t)tokr * D + 640 + c] = f2bf((y + bonus) * g_[h]);
    }
  }
}

#define XB_TMO      128
#define XB_XCNT(j)  (256  + 64 * (j))
#define XB_XSUB(j)  (1280 + 64 * (j))
#define XB_XGEN(j)  (2304 + 64 * (j))
#define XB_TOP      3328
#define XB_TOPGEN   3392
#define XCD_BAR_WORDS 3456
#define XB_SPIN_CAP (1u << 18)
#define LAS __attribute__((address_space(3)))

__device__ __forceinline__ unsigned xb_ld(unsigned* p)              { return __hip_atomic_load(p, __ATOMIC_RELAXED, __HIP_MEMORY_SCOPE_AGENT); }
__device__ __forceinline__ unsigned xb_add(unsigned* p, unsigned v) { return __hip_atomic_fetch_add(p, v, __ATOMIC_RELAXED, __HIP_MEMORY_SCOPE_AGENT); }
__device__ __forceinline__ unsigned xb_xcc_id() { return (unsigned)__builtin_amdgcn_s_getreg((3 << 11) | 20) & 0xFu; }
#define XB_SPIN(cond, bar) do { unsigned _sp = 0; while (cond) { __builtin_amdgcn_s_sleep(1); \
    if ((++_sp & 255u) == 0u) { if (xb_ld(&(bar)[XB_TMO])) break; if (_sp > XB_SPIN_CAP) { atomicAdd(&(bar)[XB_TMO], 1u); break; } } } } while (0)

struct XcdBarrier {
    unsigned* bar; unsigned x;
    volatile LAS unsigned* st;
};

__device__ __forceinline__ XcdBarrier xcd_barrier_post(unsigned* bar, volatile LAS unsigned* st) {
    XcdBarrier b; b.bar = bar; b.x = xb_xcc_id(); b.st = st;
    if (threadIdx.x == 0) (void)xb_add(&bar[XB_XCNT(b.x)], 1u);
    return b;
}
__device__ __forceinline__ void xcd_barrier_complete(unsigned* bar, unsigned x, unsigned& nloc, unsigned& nx) {
    const unsigned G = gridDim.x * gridDim.y * gridDim.z;
    unsigned sum, cnt, mine, sp = 0u;
    for (;;) {
        sum = 0u; cnt = 0u; mine = 0u;
#pragma unroll
        for (unsigned j = 0; j < 16; ++j) { const unsigned c = xb_ld(&bar[XB_XCNT(j)]); sum += c; cnt += (c > 0u) ? 1u : 0u; mine = (j == x) ? c : mine; }
        if (sum == G) break;
        __builtin_amdgcn_s_sleep(1);
        if ((++sp & 255u) == 0u) { if (xb_ld(&bar[XB_TMO])) break; if (sp > XB_SPIN_CAP) { atomicAdd(&bar[XB_TMO], 1u); break; } }
    }
    nloc = mine > 0u ? mine : 1u; nx = cnt > 0u ? cnt : 1u;
}

__device__ __forceinline__ void xcd_barrier(const XcdBarrier& b) {
    asm volatile("s_waitcnt vmcnt(0)" ::: "memory");
    __syncthreads();
    if (threadIdx.x == 0) {
        unsigned* bar = b.bar;
        __builtin_amdgcn_s_waitcnt(0);
        unsigned nloc = b.st[0], nx = b.st[1];
        if (nloc == 0u) { xcd_barrier_complete(bar, b.x, nloc, nx); b.st[0] = nloc; b.st[1] = nx; }
        const unsigned old = xb_add(&bar[XB_XSUB(b.x)], 1u);
        const unsigned gen = old / nloc;
        if (old + 1u == (gen + 1u) * nloc) {
            __builtin_amdgcn_fence(__ATOMIC_RELEASE, "agent");
            asm volatile("s_waitcnt vmcnt(0)" ::: "memory");
            const unsigned og = xb_add(&bar[XB_TOP], 1u);
            const unsigned tg = og / nx;
            if (og + 1u == (tg + 1u) * nx) xb_add(&bar[XB_TOPGEN], 1u);
            else XB_SPIN(xb_ld(&bar[XB_TOPGEN]) == tg, bar);
            __builtin_amdgcn_fence(__ATOMIC_ACQUIRE, "agent");
            xb_add(&bar[XB_XGEN(b.x)], 1u);
            asm volatile("s_waitcnt vmcnt(0)" ::: "memory");
        } else {
            XB_SPIN(xb_ld(&bar[XB_XGEN(b.x)]) == gen, bar);
            __builtin_amdgcn_fence(__ATOMIC_ACQUIRE, "agent");
            asm volatile("s_waitcnt vmcnt(0)" ::: "memory");
        }
    }
    __syncthreads();
}

__global__ void __launch_bounds__(NTHR) fwd_megakernel(Params p) {
  cg::grid_group grid = cg::this_grid();
  if (threadIdx.x == 0) *(uint4*)(smem + 147584) = make_uint4(0u, 0u, 0u, 0u);
  __syncthreads();
  XcdBarrier xb = xcd_barrier_post((unsigned*)(p.ws + OFF_BAR), (volatile LAS unsigned*)(smem + 147584));
  if (obid() == 0 && otid() < 64) ((int*)(p.ws + OFF_CNT))[otid()] = 0;
  p0_copy_x(p);
  p0_filters(p);
  p0_mod(p);
  __syncthreads();
  phase_wconv(p, 0, 0);
  bf16* hbuf = (bf16*)(p.ws + OFF_H);
  bf16* hmid = (bf16*)(p.ws + OFF_HMID);
  float* xw = (float*)(p.ws + OFF_X);
  float* Pw = (float*)(p.ws + OFF_P);
  for (int l = 0; l < DEPTH; ++l) {
    const float* modl = (const float*)(p.ws + OFF_MOD) + (size_t)l * 9 * 9216;
    const size_t wset = (size_t)(l & 1) * WSET;
    if (l == 0) grid.sync();
    phase_norm(p, p.in[I_F1N] + l * D, modl, 0, 1);
    xcd_barrier(xb);
    phase_gemm(hbuf, p.ws + OFF_W1I + wset, 5632, 1024, EpiSwiglu{(unsigned short*)hmid});
    xcd_barrier(xb);
    phase_gemm(hmid, p.ws + OFF_W1O + wset, 1024, 2816, EpiResid{xw, modl, 2, 0.5f});
    xcd_barrier(xb);
    phase_norm(p, p.in[I_MN] + l * D, modl, 3, 4);
    xcd_barrier(xb);
    phase_gemm(hbuf, p.ws + OFF_WMI + wset, INCP, 1024, EpiP{Pw});
    xcd_barrier(xb);
    prep_rwkv(p, l);
    prep_gla(p, l);
    prep_hyena(p, l);
    xcd_barrier(xb);
    phase_mixers(p, l, l);
    xcd_barrier(xb);
    phase_post(p, l);
    xcd_barrier(xb);
    phase_gemm(hbuf, p.ws + OFF_WMO + wset, 1024, 1024, EpiResid{xw, modl, 5, 1.0f});
    xcd_barrier(xb);
    phase_norm(p, p.in[I_F2N] + l * D, modl, 6, 7);
    xcd_barrier(xb);
    phase_gemm(hbuf, p.ws + OFF_W2I + wset, 5632, 1024, EpiSwiglu{(unsigned short*)hmid});
    xcd_barrier(xb);
    phase_gemm(hmid, p.ws + OFF_W2O + wset, 1024, 2816, EpiResid{xw, modl, 8, 0.5f});
    xcd_barrier(xb);
  }
  phase_final_norm(p);
}

extern "C" void kernel_launch(void* const* d_in, const int* in_sizes, int n_in, void* d_out, int out_size, void* d_ws,
                              size_t ws_size, hipStream_t stream) {
  static int grid_blocks = 0;
  if (!grid_blocks) {
    int dev = 0, cus = 0, per_cu = 0;
    (void)hipGetDevice(&dev);
    (void)hipDeviceGetAttribute(&cus, hipDeviceAttributeMultiprocessorCount, dev);
    (void)hipFuncSetAttribute((const void*)fwd_megakernel, hipFuncAttributeMaxDynamicSharedMemorySize, LDS_BYTES);
    (void)hipOccupancyMaxActiveBlocksPerMultiprocessor(&per_cu, fwd_megakernel, NTHR, LDS_BYTES);
    if (per_cu < 1) per_cu = 1;
    grid_blocks = cus * per_cu;
    if (grid_blocks > 256) grid_blocks = 256;
  }
  if (ws_size < WS_NEED) fprintf(stderr, "workspace too small: %zu < %zu\n", ws_size, (size_t)WS_NEED);
  (void)hipMemsetAsync((char*)d_ws + OFF_BAR, 0, 16384, stream);
  Params p{};
  for (int i = 0; i < 41; ++i) p.in[i] = (const float*)d_in[i];
  p.out = (float*)d_out;
  p.ws = (char*)d_ws;
  void* args[] = {&p};
  hipError_t e = hipLaunchCooperativeKernel((void*)fwd_megakernel, dim3(grid_blocks), dim3(NTHR), args, LDS_BYTES, stream);
  if (e != hipSuccess) fprintf(stderr, "cooperative launch failed: %s (grid %d)\n", hipGetErrorString(e), grid_blocks);
}
```

```cpp
#include <hip/hip_runtime.h>
#include <hip/hip_bf16.h>
#include <hip/hip_cooperative_groups.h>
#include <cstdio>
namespace cg = cooperative_groups;

typedef __hip_bfloat16 bf16;
typedef __attribute__((ext_vector_type(8))) short bf16x8;
typedef __attribute__((ext_vector_type(4))) float f32x4;
typedef __attribute__((ext_vector_type(2))) float f32x2;

constexpr int D = 1024, NTOK = 12288, NCTX = 4096, DEPTH = 4, FH = 2816;
constexpr int INC = 3264, INCP = 3328;
constexpr int C_HY = 1184, C_RW = 1952;
constexpr int NTHR = 512;

constexpr size_t al256(size_t x) { return (x + 255) & ~(size_t)255; }
constexpr size_t OFF_CNT = 0;
constexpr size_t OFF_BAR = 4096;
constexpr size_t OFF_MOD = 4096 + 16384;
constexpr size_t SZ_MOD = (size_t)DEPTH * 9 * 9216 * 4;
constexpr size_t OFF_FT = al256(OFF_MOD + SZ_MOD);
constexpr size_t FT_L0 = 511 * 256, FT_L1 = 2047 * 256;
constexpr size_t FT_LAYER = FT_L0 + FT_L1;
constexpr size_t OFF_X = al256(OFF_FT + DEPTH * FT_LAYER * 4);
constexpr size_t OFF_H = al256(OFF_X + (size_t)NTOK * D * 4);
constexpr size_t OFF_W1I = al256(OFF_H + (size_t)NTOK * D * 2);
constexpr size_t OFF_W1O = al256(OFF_W1I + (size_t)5632 * 1024 * 2);
constexpr size_t OFF_WMI = al256(OFF_W1O + (size_t)1024 * 2816 * 2);
constexpr size_t OFF_WMO = al256(OFF_WMI + (size_t)INCP * 1024 * 2);
constexpr size_t OFF_W2I = al256(OFF_WMO + (size_t)1024 * 1024 * 2);
constexpr size_t OFF_W2O = al256(OFF_W2I + (size_t)5632 * 1024 * 2);
constexpr size_t WSET = al256(OFF_W2O + (size_t)1024 * 2816 * 2) - OFF_W1I;
constexpr size_t OFF_P = OFF_W1I + 2 * WSET;
constexpr size_t SZ_P = (size_t)NTOK * INC * 4;
constexpr size_t SZ_GO = (size_t)2 * NTOK * 384 * 4;
constexpr size_t OFF_GO = OFF_P;
constexpr size_t OFF_RO = OFF_P + SZ_GO;
constexpr size_t OFF_REC = al256(OFF_P + SZ_P);
constexpr size_t SZ_REC = (size_t)NTOK * 6 * 512 * 4;
constexpr size_t OFF_HMID = OFF_REC;
constexpr size_t OFF_GREC = al256(OFF_REC + SZ_REC);
constexpr size_t SZ_GREC = (size_t)NTOK * 6 * 256 * 4;
constexpr size_t OFF_HYZ = al256(OFF_GREC + SZ_GREC);
constexpr size_t OFF_HYX = al256(OFF_HYZ + (size_t)NTOK * 256 * 4);
constexpr size_t OFF_HZB = al256(OFF_HYX + (size_t)NTOK * 256 * 4);
constexpr size_t OFF_FTB = al256(OFF_HZB + (size_t)NTOK * 256 * 2);
constexpr size_t WS_NEED = al256(OFF_FTB + DEPTH * FT_LAYER * 2);

struct Params {
  const float* in[41];
  float* out;
  char* ws;
};

enum { I_XP = 0, I_XS, I_SG, I_SR, I_C, I_CCTX, I_ADAW, I_ADAB, I_F1N, I_F1WI, I_F1WO, I_MN, I_MWI, I_MWO,
       I_GW2, I_GB, I_GN, I_HCW, I_HCB, I_HW1, I_HB1, I_HW2, I_HB2, I_HFQ, I_HW3, I_HBIAS,
       I_RMU, I_RW0, I_RW2, I_RA0, I_RA2, I_RG2, I_RKK, I_RKA, I_RRK, I_RLW, I_RLB, I_F2N, I_F2WI, I_F2WO, I_FN };

extern __shared__ __attribute__((aligned(16))) char smem[];
constexpr int LDS_BYTES = 147600;

__device__ __forceinline__ int otid() { int t = (int)__builtin_amdgcn_workitem_id_x(); asm volatile("" : "+v"(t)); return t; }
__device__ __forceinline__ int obid() { int b = (int)__builtin_amdgcn_workgroup_id_x(); asm volatile("" : "+s"(b)); return b; }
__device__ __forceinline__ unsigned short f2bf(float f) {
  unsigned u = __float_as_uint(f);
  u += 0x7fffu + ((u >> 16) & 1u);
  return (unsigned short)(u >> 16);
}
__device__ __forceinline__ float dpp_f(float x, const int ctrl_sel) {
  int xi = __float_as_int(x), r;
  if (ctrl_sel == 0) r = __builtin_amdgcn_update_dpp(0, xi, 0xB1, 0xF, 0xF, true);
  else if (ctrl_sel == 1) r = __builtin_amdgcn_update_dpp(0, xi, 0x4E, 0xF, 0xF, true);
  else if (ctrl_sel == 2) r = __builtin_amdgcn_update_dpp(0, xi, 0x141, 0xF, 0xF, true);
  else r = __builtin_amdgcn_update_dpp(0, xi, 0x140, 0xF, 0xF, true);
  return __int_as_float(r);
}
__device__ __forceinline__ float wave_sum(float v) {
  v += dpp_f(v, 0); v += dpp_f(v, 1); v += dpp_f(v, 2); v += dpp_f(v, 3);
  const int vi = __float_as_int(v);
  return __int_as_float(__builtin_amdgcn_readlane(vi, 0)) + __int_as_float(__builtin_amdgcn_readlane(vi, 16)) +
         __int_as_float(__builtin_amdgcn_readlane(vi, 32)) + __int_as_float(__builtin_amdgcn_readlane(vi, 48));
}
__device__ __forceinline__ float sigmoidf_(float x) { return __builtin_amdgcn_rcpf(1.f + __builtin_amdgcn_exp2f(x * -1.4426950408889634f)); }
__device__ __forceinline__ float siluf_(float x) { return x * sigmoidf_(x); }
__device__ __forceinline__ int modrow(int row) { return row < NCTX ? 0 : 1 + ((row - NCTX) >> 10); }

__device__ __forceinline__ void p0_copy_x(const Params& p) {
  float4* x = (float4*)(p.ws + OFF_X);
  const float4* a = (const float4*)p.in[I_XP];
  const float4* b = (const float4*)p.in[I_XS];
  const size_t n4 = (size_t)NTOK * D / 4, nc4 = (size_t)NCTX * D / 4;
  for (size_t i = (size_t)obid() * NTHR + otid(); i < n4; i += (size_t)gridDim.x * NTHR)
    x[i] = i < nc4 ? a[i] : b[i - nc4];
}

__device__ __forceinline__ void p0_mod(const Params& p) {
  float* scond = (float*)smem;
  float* red = (float*)(smem + 40960);
  for (int i = otid(); i < 9 * 1024; i += NTHR) {
    int r = i >> 10, d = i & 1023;
    float c = r == 0 ? p.in[I_CCTX][d] : p.in[I_C][(r - 1) * 1024 + d];
    scond[i] = siluf_(c);
  }
  __syncthreads();
  float* mod = (float*)(p.ws + OFF_MOD);
  const int col = otid() & 63, ks = otid() >> 6;
  for (int task = obid(); task < DEPTH * 144; task += gridDim.x) {
    int l = task / 144, cg_ = task % 144;
    const float* w = p.in[I_ADAW] + (size_t)l * 1024 * 9216 + cg_ * 64 + col;
    float acc[9];
#pragma unroll
    for (int r = 0; r < 9; ++r) acc[r] = 0.f;
    for (int d0 = ks * 128; d0 < ks * 128 + 128; d0 += 8) {
      float wv[8];
#pragma unroll
      for (int u = 0; u < 8; ++u) wv[u] = w[(size_t)(d0 + u) * 9216];
#pragma unroll
      for (int u = 0; u < 8; ++u)
#pragma unroll
        for (int r = 0; r < 9; ++r) acc[r] += scond[r * 1024 + d0 + u] * wv[u];
    }
#pragma unroll
    for (int r = 0; r < 9; ++r) red[(ks * 9 + r) * 64 + col] = acc[r];
    __syncthreads();
    for (int i = otid(); i < 576; i += NTHR) {
      int r = i >> 6, c = i & 63;
      float s = 0.f;
#pragma unroll
      for (int k = 0; k < 8; ++k) s += red[(k * 9 + r) * 64 + c];
      int j = cg_ * 64 + c;
      mod[((size_t)l * 9 + r) * 9216 + j] = s + p.in[I_ADAB][l * 9216 + j];
    }
    __syncthreads();
  }
}

__device__ __forceinline__ void p0_filters(const Params& p) {
  const int wave = otid() >> 6, lane = otid() & 63;
  float* FT = (float*)(p.ws + OFF_FT);
  for (int task = obid() * 8 + wave; task < DEPTH * 1280; task += gridDim.x * 8) {
    int l = task / 1280, rem = task % 1280;
    int sel = rem >= 256, i = sel ? rem - 256 : rem, L = sel ? 1024 : 256;
    float t = (float)i / (float)(L - 1);
    float w = 6.283185307179586f * (float)i / (float)L;
    float zval = 0.f;
    {
      const float fstep = (15.f - 1e-4f) / 15.f;
      if (lane == 0) zval = t;
      else if (lane <= 16) zval = cosf((1e-4f + (float)(lane - 1) * fstep) * w);
      else if (lane <= 32) zval = -sinf((1e-4f + (float)(lane - 17) * fstep) * w);
    }
    const float* w1 = p.in[I_HW1] + l * 33 * 64;
    const float* w2 = p.in[I_HW2] + l * 64 * 64;
    const float* w3 = p.in[I_HW3] + l * 64 * 512;
    const float* fq = p.in[I_HFQ] + l * 128;
    float h1 = p.in[I_HB1][l * 64 + lane];
    for (int e = 0; e < 33; ++e) h1 += __shfl(zval, e) * w1[e * 64 + lane];
    h1 = sinf(fq[lane] * h1);
    float h2 = p.in[I_HB2][l * 64 + lane];
    for (int e = 0; e < 64; ++e) h2 += __shfl(h1, e) * w2[e * 64 + lane];
    h2 = sinf(fq[64 + lane] * h2);
    float acc[8];
#pragma unroll
    for (int m = 0; m < 8; ++m) acc[m] = 0.f;
    for (int e = 0; e < 64; ++e) {
      float hv = __shfl(h2, e);
#pragma unroll
      for (int m = 0; m < 8; ++m) acc[m] += hv * w3[e * 512 + m * 64 + lane];
    }
    float* ft = FT + (size_t)l * FT_LAYER + (sel ? FT_L0 : 0);
    const float a0 = -3.0701134573253945f, a1 = -15.350567286626973f;
#pragma unroll
    for (int m = 0; m < 8; ++m) {
      int cp = m * 64 + lane, c = cp & 255;
      float delta = fabsf(a0 + (float)c * ((a1 - a0) / 255.f));
      float val = acc[m] * expf(-t * delta);
      unsigned short* ftb = (unsigned short*)(p.ws + OFF_FTB) + (size_t)l * FT_LAYER + (sel ? FT_L0 : 0);
      if (cp < 256) { ft[(size_t)(L - 1 + i) * 256 + c] = val; ftb[(size_t)(L - 1 + i) * 256 + c] = f2bf(val); }
      else if (i >= 1) { ft[(size_t)(L - 1 - i) * 256 + c] = val; ftb[(size_t)(L - 1 - i) * 256 + c] = f2bf(val); }
    }
  }
}

__device__ __forceinline__ void conv_tile(const float* src, int srcN, int k0, int srccol0, bool zero, bf16* dst, int dstK, int n0) {
  float* tile = (float*)smem;
  const int tid = otid();
  {
    int r = tid >> 4, c4 = (tid & 15) * 4;
#pragma unroll
    for (int rr = 0; rr < 2; ++rr) {
      int row = r + rr * 32;
      float4 v = zero ? make_float4(0.f, 0.f, 0.f, 0.f)
                      : *(const float4*)(src + (size_t)(k0 + row) * srcN + srccol0 + c4);
      tile[row * 65 + c4 + 0] = v.x; tile[row * 65 + c4 + 1] = v.y;
      tile[row * 65 + c4 + 2] = v.z; tile[row * 65 + c4 + 3] = v.w;
    }
  }
  __syncthreads();
  {
    int nn = tid >> 3, ks = (tid & 7) * 8;
    unsigned short v[8];
#pragma unroll
    for (int j = 0; j < 8; ++j) v[j] = f2bf(tile[(ks + j) * 65 + nn]);
    uint4 o;
    o.x = v[0] | ((unsigned)v[1] << 16); o.y = v[2] | ((unsigned)v[3] << 16);
    o.z = v[4] | ((unsigned)v[5] << 16); o.w = v[6] | ((unsigned)v[7] << 16);
    *(uint4*)(dst + (size_t)(n0 + nn) * dstK + k0 + ks) = o;
  }
  __syncthreads();
}

__device__ __forceinline__ unsigned cvt_pk_bf16_(float lo, float hi) { unsigned r; asm volatile("v_cvt_pk_bf16_f32 %0, %1, %2" : "=v"(r) : "v"(lo), "v"(hi)); return r; }
struct WTile { const float* src; int srcN, k0, srccol, dstK, n0; bool zero; size_t dstoff; };
__device__ __forceinline__ WTile wtile_decode(const Params& p, int l, int u) {
  WTile w;
  w.zero = false;
  if (u < 1408 || (u >= 3200 && u < 4608)) {
    const bool second = u >= 3200;
    if (second) u -= 3200;
    w.src = p.in[second ? I_F2WI : I_F1WI] + (size_t)l * 1024 * 5632;
    w.dstoff = second ? OFF_W2I : OFF_W1I;
    const int tn = u % 88, tk = u / 88;
    const int n0 = tn * 64, pn = n0 >> 8, within = n0 & 255;
    w.srccol = within < 128 ? pn * 128 + within : 2816 + pn * 128 + (within - 128);
    w.srcN = 5632; w.k0 = tk * 64; w.dstK = 1024; w.n0 = n0;
  } else if ((u >= 1408 && u < 2112) || u >= 4608) {
    const bool second = u >= 4608;
    u -= second ? 4608 : 1408;
    w.src = p.in[second ? I_F2WO : I_F1WO] + (size_t)l * 2816 * 1024;
    w.dstoff = second ? OFF_W2O : OFF_W1O;
    const int tn = u % 16, tk = u / 16;
    w.srcN = 1024; w.k0 = tk * 64; w.srccol = tn * 64; w.dstK = 2816; w.n0 = tn * 64;
  } else if (u < 2944) {
    u -= 2112;
    w.src = p.in[I_MWI] + (size_t)l * 1024 * INC;
    w.dstoff = OFF_WMI;
    const int tn = u % 52, tk = u / 52;
    w.srcN = INC; w.k0 = tk * 64; w.srccol = tn * 64; w.dstK = 1024; w.n0 = tn * 64; w.zero = tn == 51;
  } else {
    u -= 2944;
    w.src = p.in[I_MWO] + (size_t)l * 1024 * 1024;
    w.dstoff = OFF_WMO;
    const int tn = u % 16, tk = u / 16;
    w.srcN = 1024; w.k0 = tk * 64; w.srccol = tn * 64; w.dstK = 1024; w.n0 = tn * 64;
  }
  return w;
}
__device__ __forceinline__ void phase_wconv(const Params& p, int l, int set) {
  for (int t = obid(); t < 5312; t += gridDim.x) {
    const WTile w = wtile_decode(p, l, t);
    conv_tile(w.src, w.srcN, w.k0, w.srccol, w.zero, (bf16*)(p.ws + w.dstoff + (size_t)set * WSET), w.dstK, w.n0);
  }
}
__device__ __forceinline__ void wconv_wave(const Params& p, int l, int set, int u) {
  const int lane = otid() & 63;
  const WTile w = wtile_decode(p, l, u);
  unsigned pk[32];
  if (!w.zero) {
    const float* s = w.src + (size_t)w.k0 * w.srcN + w.srccol + lane;
#pragma unroll
    for (int kk = 0; kk < 64; kk += 2) pk[kk >> 1] = cvt_pk_bf16_(s[(size_t)kk * w.srcN], s[(size_t)(kk + 1) * w.srcN]);
  } else {
#pragma unroll
    for (int i = 0; i < 32; ++i) pk[i] = 0u;
  }
  uint4* d = (uint4*)((unsigned short*)(p.ws + w.dstoff + (size_t)set * WSET) + (size_t)(w.n0 + lane) * w.dstK + w.k0);
#pragma unroll
  for (int i = 0; i < 8; ++i) d[i] = make_uint4(pk[4 * i], pk[4 * i + 1], pk[4 * i + 2], pk[4 * i + 3]);
}

__device__ __forceinline__ void phase_norm(const Params& p, const float* gain, const float* modl, int shi, int sci) {
  const int wave = otid() >> 6, lane = otid() & 63;
  const float* x = (const float*)(p.ws + OFF_X);
  bf16* h = (bf16*)(p.ws + OFF_H);
  const int nw = gridDim.x * 8;
  float4 g4[4];
#pragma unroll
  for (int i = 0; i < 4; ++i) g4[i] = ((const float4*)gain)[i * 64 + lane];
  constexpr int NR = 3;
  for (int row0 = obid() * 8 + wave; row0 < NTOK; row0 += NR * nw) {
    float4 v[NR][4], sc[NR][4], sh[NR][4];
    int rows[NR];
#pragma unroll
    for (int q = 0; q < NR; ++q) {
      const int row = (row0 + q * nw < NTOK) ? row0 + q * nw : row0;
      rows[q] = row;
      const float4* xr = (const float4*)(x + (size_t)row * D);
      const float* mr = modl + (size_t)modrow(row) * 9216;
#pragma unroll
      for (int i = 0; i < 4; ++i) {
        v[q][i] = xr[i * 64 + lane];
        sc[q][i] = ((const float4*)(mr + sci * 1024))[i * 64 + lane];
        sh[q][i] = ((const float4*)(mr + shi * 1024))[i * 64 + lane];
      }
    }
    __builtin_amdgcn_sched_barrier(0);
#pragma unroll
    for (int q = 0; q < NR; ++q) {
      if (q >= 1 && row0 + q * nw >= NTOK) break;
      float ss = 0.f;
#pragma unroll
      for (int i = 0; i < 4; ++i) ss += v[q][i].x * v[q][i].x + v[q][i].y * v[q][i].y + v[q][i].z * v[q][i].z + v[q][i].w * v[q][i].w;
      ss = wave_sum(ss);
      const float rstd = rsqrtf(ss * (1.f / 1024.f) + 1e-6f);
#pragma unroll
      for (int i = 0; i < 4; ++i) {
        const float4 g = g4[i], s = sc[q][i], bq = sh[q][i];
        float y0 = v[q][i].x * rstd * g.x * (1.f + s.x) + bq.x;
        float y1 = v[q][i].y * rstd * g.y * (1.f + s.y) + bq.y;
        float y2 = v[q][i].z * rstd * g.z * (1.f + s.z) + bq.z;
        float y3 = v[q][i].w * rstd * g.w * (1.f + s.w) + bq.w;
        uint2 o;
        o.x = f2bf(y0) | ((unsigned)f2bf(y1) << 16);
        o.y = f2bf(y2) | ((unsigned)f2bf(y3) << 16);
        *(uint2*)(h + (size_t)rows[q] * D + (i * 64 + lane) * 4) = o;
      }
    }
  }
}

__device__ __forceinline__ void phase_final_norm(const Params& p) {
  const int wave = otid() >> 6, lane = otid() & 63;
  const float* x = (const float*)(p.ws + OFF_X);
  const float4* g4 = (const float4*)p.in[I_FN];
  for (int row = obid() * 8 + wave; row < NTOK; row += gridDim.x * 8) {
    const float4* xr = (const float4*)(x + (size_t)row * D);
    float4 v[4];
    float ss = 0.f;
#pragma unroll
    for (int i = 0; i < 4; ++i) {
      v[i] = xr[i * 64 + lane];
      ss += v[i].x * v[i].x + v[i].y * v[i].y + v[i].z * v[i].z + v[i].w * v[i].w;
    }
    ss = wave_sum(ss);
    float rstd = rsqrtf(ss * (1.f / 1024.f) + 1e-6f);
    float4* o = (float4*)(p.out + (size_t)row * D);
#pragma unroll
    for (int i = 0; i < 4; ++i) {
      float4 g = g4[i * 64 + lane];
      o[i * 64 + lane] = make_float4(v[i].x * rstd * g.x, v[i].y * rstd * g.y, v[i].z * rstd * g.z, v[i].w * rstd * g.w);
    }
  }
}

namespace pg8 {
#define PG8_LAS __attribute__((address_space(3)))
typedef unsigned short bf16_t;
typedef short bf16x8 __attribute__((ext_vector_type(8)));
typedef float f32x4 __attribute__((ext_vector_type(4)));
typedef unsigned u32x4 __attribute__((ext_vector_type(4)));
constexpr int BM = 256, BK = 64, HALF = 128, HTB = HALF * BK * 2  , STAGE_BYTES = 8 * HTB, NXCD = 8, WGM = 8;

__host__ __device__ __forceinline__ int lds_byte(int r, int c) { const int st = (r >> 4) * 2 + (c >> 5), rr = r & 15, cc = c & 31, ob = rr * 64 + cc * 2; return st * 1024 + (ob ^ (((ob >> 9) & 1) << 5)); }
__host__ __device__ __forceinline__ void stage_rc(int b, int& R, int& C) { const int st = b / 1024, sb = b % 1024, swz = sb ^ (((sb >> 9) & 1) << 5); R = (st >> 1) * 16 + swz / 64; C = (st & 1) * 32 + (swz % 64) / 2; }
__host__ __device__ __forceinline__ int perm32(int rho) { const int n = rho >> 4, i = rho & 15; return 8 * (i >> 2) + 4 * n + (i & 3); }

struct Unit { int pm, pn; };
struct Gemm { const bf16_t* A; const bf16_t* Bt; int M, N, K; };

struct StaticOrder {
    int nM, nN, nwg, G, c;
    __host__ __device__ void init(int M, int N, int G_, int c_) { nM = M / BM; nN = N / BM; nwg = nM * nN; G = G_; c = c_; }
    __host__ __device__ bool next(int i, Unit& u) const {
        const long L = (long)i * G + c; if (L >= nwg) return false;
        int wgid = (int)L; { const int q = nwg / NXCD, r = nwg % NXCD, xcd = wgid % NXCD, off = wgid / NXCD; wgid = (xcd < r ? xcd * (q + 1) : r * (q + 1) + (xcd - r) * q) + off; }
        const int nig = WGM * nN, gid = wgid / nig, fm = gid * WGM, gsz = (nM - fm) < WGM ? (nM - fm) : WGM;
        u.pm = fm + ((wgid % nig) % gsz); u.pn = (wgid % nig) / gsz; return true;
    }
    __device__ __forceinline__ void a_ready(const Unit&) const {}
    __device__ __forceinline__ void done(const Unit&) const {}
};
__device__ __forceinline__ unsigned cvt_pk_bf16(float lo, float hi) { unsigned r; asm volatile("v_cvt_pk_bf16_f32 %0, %1, %2" : "=v"(r) : "v"(lo), "v"(hi)); return r; }

template <class Epi, class Sched, bool STAMP = false>
__device__ __forceinline__ void gemm_phase(PG8_LAS unsigned char* lds, const Gemm g, const Sched& S, const Epi& E, unsigned long long* stamps) {
    const int tid = otid(), wid = __builtin_amdgcn_readfirstlane(tid >> 6), lane = tid & 63, wr = wid >> 2, wc = wid & 3, fr = lane & 15, fq = lane >> 4;
    const int K = g.K, nt = K / BK;
    int ts_lo = 0, ts_hi = 0, nts = 0; const unsigned long long rt_entry = STAMP ? (unsigned long long)wall_clock64() : 0ull;
#define PG8_STAMP() do { if (STAMP && wid == 0 && nts < 64) { const unsigned long long _c = (unsigned long long)clock64(); \
        ts_lo = (lane == nts) ? (int)(unsigned)_c : ts_lo; ts_hi = (lane == nts) ? (int)(unsigned)(_c >> 32) : ts_hi; ++nts; } } while (0)
    PG8_STAMP();
    unsigned voffA[2], voffB[2];
#pragma unroll
    for (int i = 0; i < 2; ++i) { int R, C; stage_rc(tid * 16 + i * 8192, R, C); const int Rb = Epi::PERM ? ((R & ~31) + perm32(R & 31)) : R;
        voffA[i] = (unsigned)(R * K + C) * 2u; voffB[i] = (unsigned)(Rb * K + C) * 2u; }
    const size_t kstep = (size_t)(BK * 2);
    const size_t hstep = (size_t)HALF * K * 2;
    const size_t tstep = 2 * hstep;
    const unsigned ldsw = (unsigned)wid * 1024u;
    const int aoff = lds_byte(wr * 64 + fr, fq * 8), boff = lds_byte(wc * 32 + fr, fq * 8);
#define PG8_SA(b, h) (((b) * 2 + (h)) * HTB)
#define PG8_SB(b, h) ((4 + (b) * 2 + (h)) * HTB)
#define PG8_STAGE(bufoff, gbase, voff) do { _Pragma("unroll") for (int _i = 0; _i < 2; ++_i) \
        __builtin_amdgcn_global_load_lds((const unsigned*)((const char*)(gbase) + (voff)[_i]), (PG8_LAS unsigned*)(lds + (bufoff) + ldsw + _i * 8192), 16, 0, 0); } while (0)
#define PG8_LDA(dst, b, h) do { _Pragma("unroll") for (int m = 0; m < 4; ++m) _Pragma("unroll") for (int k = 0; k < 2; ++k) dst[m][k] = *(const PG8_LAS bf16x8*)(lds + PG8_SA(b, h) + aoff + m * 2048 + k * 1024); } while (0)
#define PG8_LDB(dst, b, h) do { _Pragma("unroll") for (int n = 0; n < 2; ++n) _Pragma("unroll") for (int k = 0; k < 2; ++k) dst[n][k] = *(const PG8_LAS bf16x8*)(lds + PG8_SB(b, h) + boff + n * 2048 + k * 1024); } while (0)
#define PG8_MMA(ai, bj, At, Bt) do { __builtin_amdgcn_s_setprio(1); _Pragma("unroll") for (int m = 0; m < 4; ++m) _Pragma("unroll") for (int n = 0; n < 2; ++n) _Pragma("unroll") for (int k = 0; k < 2; ++k) \
        acc[ai][bj][m][n] = __builtin_amdgcn_mfma_f32_16x16x32_bf16(Bt[n][k], At[m][k], acc[ai][bj][m][n], 0, 0, 0); __builtin_amdgcn_s_setprio(0); } while (0)
#define PG8_WAIT_V(n) asm volatile("s_waitcnt vmcnt(" #n ")" ::: "memory")
#define PG8_WAIT_L(n) asm volatile("s_waitcnt lgkmcnt(" #n ")" ::: "memory")
#define PG8_BAR __builtin_amdgcn_s_barrier()
#define PG8_SCHED __builtin_amdgcn_sched_barrier(0)
    Unit cur, nxt; int ui = 0;
    if (!S.next(0, cur)) return;
    f32x4 acc[2][2][4][2];
#pragma unroll
    for (int a = 0; a < 2; ++a)
#pragma unroll
        for (int b = 0; b < 2; ++b)
#pragma unroll
            for (int m = 0; m < 4; ++m)
#pragma unroll
                for (int n = 0; n < 2; ++n) acc[a][b][m][n] = (f32x4){0.f, 0.f, 0.f, 0.f};
    bf16x8 At[4][2], B0[2][2], B1[2][2];
    const char* cA = (const char*)g.A + (size_t)cur.pm * tstep; const char* cB = (const char*)g.Bt + (size_t)cur.pn * tstep;
    S.a_ready(cur);
    PG8_STAGE(PG8_SB(0, 0), cB, voffB); PG8_STAGE(PG8_SA(0, 0), cA, voffA); PG8_STAGE(PG8_SB(0, 1), cB + hstep, voffB); PG8_STAGE(PG8_SA(0, 1), cA + hstep, voffA);
    if (wr == 1) PG8_BAR;
    PG8_WAIT_V(4); PG8_BAR;
    PG8_STAGE(PG8_SB(1, 0), cB + kstep, voffB); PG8_STAGE(PG8_SA(1, 0), cA + kstep, voffA); PG8_STAGE(PG8_SB(1, 1), cB + hstep + kstep, voffB);
    PG8_WAIT_V(6); PG8_BAR;
    PG8_STAMP();
    for (;;) {
        const bool has_next = S.next(ui + 1, nxt);
        const char* nA = has_next ? (const char*)g.A + (size_t)nxt.pm * tstep : cA; const char* nB = has_next ? (const char*)g.Bt + (size_t)nxt.pn * tstep : cB;
        for (int t = 0; t < nt; t += 2) {
            const bool last = (t == nt - 2);
            const char* a1 = cA + (size_t)(t + 1) * kstep;
            const char* a2 = last ? nA : cA + (size_t)(t + 2) * kstep; const char* b2 = last ? nB : cB + (size_t)(t + 2) * kstep;
            const char* a3 = a2 + kstep; const char* b3 = b2 + kstep;
            if (last && has_next) S.a_ready(nxt);
            PG8_LDB(B0, 0, 0); PG8_SCHED; PG8_LDA(At, 0, 0); PG8_STAGE(PG8_SA(1, 1), a1 + hstep, voffA);
            PG8_WAIT_L(8); PG8_BAR; PG8_WAIT_L(0); PG8_MMA(0, 0, At, B0); PG8_BAR; PG8_SCHED;
            PG8_LDB(B1, 0, 1); PG8_STAGE(PG8_SB(0, 0), b2, voffB);
            PG8_BAR; PG8_WAIT_L(0); PG8_MMA(0, 1, At, B1); PG8_BAR;
            PG8_LDA(At, 0, 1); PG8_STAGE(PG8_SA(0, 0), a2, voffA);
            PG8_BAR; PG8_WAIT_L(0); PG8_MMA(1, 0, At, B0); PG8_BAR; PG8_SCHED;
            PG8_STAGE(PG8_SB(0, 1), b2 + hstep, voffB);
            PG8_WAIT_V(6); PG8_BAR; PG8_MMA(1, 1, At, B1); PG8_BAR;
            PG8_LDB(B0, 1, 0); PG8_SCHED; PG8_LDA(At, 1, 0); PG8_STAGE(PG8_SA(0, 1), a2 + hstep, voffA);
            PG8_WAIT_L(8); PG8_BAR; PG8_WAIT_L(0); PG8_MMA(0, 0, At, B0); PG8_BAR; PG8_SCHED;
            PG8_LDB(B1, 1, 1); PG8_STAGE(PG8_SB(1, 0), b3, voffB);
            PG8_BAR; PG8_WAIT_L(0); PG8_MMA(0, 1, At, B1); PG8_BAR;
            PG8_LDA(At, 1, 1); PG8_STAGE(PG8_SA(1, 0), a3, voffA);
            PG8_BAR; PG8_WAIT_L(0); PG8_MMA(1, 0, At, B0); PG8_BAR; PG8_SCHED;
            PG8_STAGE(PG8_SB(1, 1), b3 + hstep, voffB);
            PG8_WAIT_V(6); PG8_BAR; PG8_MMA(1, 1, At, B1); PG8_BAR;
        }
        PG8_STAMP();
        if constexpr (!Epi::AFTER_DRAIN) { E(acc, cur, wr, wc, fr, fq); S.done(cur); }
        PG8_STAMP();
        if (!has_next) break;
#pragma unroll
        for (int a = 0; a < 2; ++a)
#pragma unroll
            for (int b = 0; b < 2; ++b)
#pragma unroll
                for (int m = 0; m < 4; ++m)
#pragma unroll
                    for (int n = 0; n < 2; ++n) acc[a][b][m][n] = (f32x4){0.f, 0.f, 0.f, 0.f};
        cur = nxt; cA = nA; cB = nB; ++ui;
    }
    PG8_WAIT_V(0);
    if (wr == 0) PG8_BAR;
    PG8_BAR;
    if constexpr (Epi::AFTER_DRAIN) { E.fused(acc, cur, wr, wc, fr, fq, lds, wid, lane); S.done(cur); }
    PG8_STAMP();
    if (STAMP && wid == 0) { stamps[lane] = lane < nts ? (((unsigned long long)(unsigned)ts_hi << 32) | (unsigned)ts_lo) : 0ull;
        if (lane == 62) stamps[62] = rt_entry; if (lane == 63) stamps[63] = (unsigned long long)wall_clock64(); }
#undef PG8_STAMP
#undef PG8_SA
#undef PG8_SB
#undef PG8_STAGE
#undef PG8_LDA
#undef PG8_LDB
#undef PG8_MMA
#undef PG8_WAIT_V
#undef PG8_WAIT_L
#undef PG8_BAR
#undef PG8_SCHED
}
}

struct EpiSwiglu {
  static constexpr bool PERM = true, AFTER_DRAIN = false;
  unsigned short* H;
  __device__ __forceinline__ void operator()(const pg8::f32x4 (&acc)[2][2][4][2], const pg8::Unit& u, int wr, int wc, int fr, int fq) const {
    const int row0 = u.pm * 256 + wr * 64 + fr, hc0 = u.pn * 128 + wc * 32 + 8 * fq;
#pragma unroll
    for (int ai = 0; ai < 2; ++ai)
#pragma unroll
      for (int m = 0; m < 4; ++m) {
        unsigned short* rowp = H + (size_t)(row0 + ai * 128 + m * 16) * FH + hc0;
        float v[8];
#pragma unroll
        for (int n = 0; n < 2; ++n)
#pragma unroll
          for (int i = 0; i < 4; ++i) v[n * 4 + i] = siluf_(acc[ai][0][m][n][i]) * acc[ai][1][m][n][i];
        pg8::u32x4 o;
        o[0] = pg8::cvt_pk_bf16(v[0], v[1]); o[1] = pg8::cvt_pk_bf16(v[2], v[3]);
        o[2] = pg8::cvt_pk_bf16(v[4], v[5]); o[3] = pg8::cvt_pk_bf16(v[6], v[7]);
        *(pg8::u32x4*)rowp = o;
      }
  }
};
struct EpiResid {
  static constexpr bool PERM = false, AFTER_DRAIN = false;
  float* X; const float* modl; int gidx; float scale;
  __device__ __forceinline__ void operator()(const pg8::f32x4 (&acc)[2][2][4][2], const pg8::Unit& u, int wr, int wc, int fr, int fq) const {
    const int row0 = u.pm * 256 + wr * 64 + fr, col0 = u.pn * 256 + wc * 32 + 4 * fq;
#pragma unroll
    for (int ai = 0; ai < 2; ++ai)
#pragma unroll
      for (int m = 0; m < 4; ++m) {
        const int row = row0 + ai * 128 + m * 16;
        const float* gt = modl + (size_t)modrow(row) * 9216 + gidx * 1024 + col0;
        float* xp = X + (size_t)row * D + col0;
        pg8::f32x4 gv[2][2], xv[2][2];
#pragma unroll
        for (int bj = 0; bj < 2; ++bj)
#pragma unroll
          for (int n = 0; n < 2; ++n) {
            gv[bj][n] = *(const pg8::f32x4*)(gt + bj * 128 + n * 16);
            xv[bj][n] = *(const pg8::f32x4*)(xp + bj * 128 + n * 16);
          }
#pragma unroll
        for (int bj = 0; bj < 2; ++bj)
#pragma unroll
          for (int n = 0; n < 2; ++n) *(pg8::f32x4*)(xp + bj * 128 + n * 16) = xv[bj][n] + (gv[bj][n] * scale) * acc[ai][bj][m][n];
      }
  }
};
struct EpiP {
  static constexpr bool PERM = false, AFTER_DRAIN = false;
  float* P;
  __device__ __forceinline__ void operator()(const pg8::f32x4 (&acc)[2][2][4][2], const pg8::Unit& u, int wr, int wc, int fr, int fq) const {
    const int row0 = u.pm * 256 + wr * 64 + fr, col0 = u.pn * 256 + wc * 32 + 4 * fq;
#pragma unroll
    for (int ai = 0; ai < 2; ++ai)
#pragma unroll
      for (int m = 0; m < 4; ++m) {
        float* rp = P + (size_t)(row0 + ai * 128 + m * 16) * INC;
#pragma unroll
        for (int bj = 0; bj < 2; ++bj)
#pragma unroll
          for (int n = 0; n < 2; ++n) {
            const int col = col0 + bj * 128 + n * 16;
            if (col < INC) *(pg8::f32x4*)(rp + col) = acc[ai][bj][m][n];
          }
      }
  }
};

template <class Epi>
__device__ __forceinline__ void phase_gemm(const void* A, const void* Bt, int N, int K, const Epi& E) {
  pg8::Gemm g; g.A = (const pg8::bf16_t*)A; g.Bt = (const pg8::bf16_t*)Bt; g.M = NTOK; g.N = N; g.K = K;
  int c_ = obid(), G_ = (int)gridDim.x;
  asm volatile("" : "+s"(c_), "+s"(G_));
  pg8::StaticOrder S; S.init(NTOK, N, G_, c_);
  pg8::gemm_phase<Epi, pg8::StaticOrder, false>((PG8_LAS unsigned char*)smem, g, S, E, nullptr);
  __syncthreads();
}

__device__ __forceinline__ int scan2tok(int R) {
  if (R < NCTX) return R;
  int q = R - NCTX, b = q >> 10, n = q & 1023;
  return NCTX + b * 1024 + (n & 15) * 64 + (n >> 4);
}

__device__ __forceinline__ float rw_shift(const float* P, int R, int n, int L, int c, float mu) {
  float pc = P[(size_t)scan2tok(R) * INC + C_RW + c];
  float pp = n > 0 ? P[(size_t)scan2tok(R - 1) * INC + C_RW + c] : 0.f;
  float pn = n < L - 1 ? P[(size_t)scan2tok(R + 1) * INC + C_RW + c] : 0.f;
  return pc + (0.5f * (pp + pn) - pc) * mu;
}

__device__ __forceinline__ float rdlane(float v, int l) { return __int_as_float(__builtin_amdgcn_readlane(__float_as_int(v), l)); }

__device__ __forceinline__ void prep_rwkv(const Params& p, int l) {
  const int wave = otid() >> 6, lane = otid() & 63;
  const float* P = (const float*)(p.ws + OFF_P);
  float* rec = (float*)(p.ws + OFF_REC);
  const float* mu = p.in[I_RMU] + l * 1312;
  const float* w0 = p.in[I_RW0] + l * 768;
  const float* w2 = p.in[I_RW2] + (size_t)l * 64 * 384;
  const float* a0 = p.in[I_RA0] + l * 384;
  const float* a2 = p.in[I_RA2] + (size_t)l * 32 * 384;
  const float* g2 = p.in[I_RG2] + (size_t)l * 64 * 384;
  const float* kkw = p.in[I_RKK] + l * 384;
  const float* kaw = p.in[I_RKA] + l * 384;
  float* wl = (float*)smem;
#pragma unroll 1
  for (int hp = 0; hp < 2; ++hp) {
    const int hb = hp * 3;
    __syncthreads();
    for (int i = otid(); i < 160 * 48; i += NTHR) {
      const int r = i / 48, c4 = (i % 48) * 4;
      const float* src = (r < 64 ? w2 + r * 384 : (r < 96 ? a2 + (r - 64) * 384 : g2 + (r - 96) * 384)) + hb * 64 + c4;
      *(float4*)(wl + r * 192 + c4) = *(const float4*)src;
    }
    __syncthreads();
    for (int task = obid() * 8 + wave; task < NTOK / 6; task += gridDim.x * 8) {
      const int R0 = task * 6;
      int nn[6], LL[6];
#pragma unroll
      for (int tp = 0; tp < 6; ++tp) {
        const int R = R0 + tp;
        if (R < NCTX) { nn[tp] = R & 255; LL[tp] = 256; } else { nn[tp] = (R - NCTX) & 1023; LL[tp] = 1024; }
      }
      float x0[6], x1[6], x2[6];
#pragma unroll
      for (int tp = 0; tp < 6; ++tp) {
        x0[tp] = rw_shift(P, R0 + tp, nn[tp], LL[tp], 1152 + lane, mu[1152 + lane]);
        x1[tp] = rw_shift(P, R0 + tp, nn[tp], LL[tp], 1216 + lane, mu[1216 + lane]);
        const int c2 = 1280 + (lane & 31);
        x2[tp] = rw_shift(P, R0 + tp, nn[tp], LL[tp], c2, mu[c2]);
        if (tp & 1) __builtin_amdgcn_sched_barrier(0);
      }
      float kx[3][6];
#pragma unroll
      for (int h = 0; h < 3; ++h) {
        const int c = (hb + h) * 64 + lane;
#pragma unroll
        for (int tp = 0; tp < 6; ++tp) {
          kx[h][tp] = rw_shift(P, R0 + tp, nn[tp], LL[tp], 384 + c, mu[384 + c]);
        }
      }
#pragma unroll
      for (int tp = 0; tp < 6; ++tp) {
        x0[tp] = tanhf(x0[tp]);
        x1[tp] = lane < 32 ? x1[tp] : sigmoidf_(x1[tp]);
        x2[tp] = sigmoidf_(x2[tp]);
      }
      float af[3][6], ab[3][6], aa[3][6], ag[3][6];
#pragma unroll
      for (int h = 0; h < 3; ++h)
#pragma unroll
        for (int tp = 0; tp < 6; ++tp) { af[h][tp] = 0.f; ab[h][tp] = 0.f; aa[h][tp] = 0.f; ag[h][tp] = 0.f; }
      const float* wlp = wl + lane;
      for (int j = 0; j < 32; ++j) {
        float wc[15];
#pragma unroll
        for (int h = 0; h < 3; ++h) {
          wc[h] = wlp[j * 192 + h * 64]; wc[3 + h] = wlp[(32 + j) * 192 + h * 64];
          wc[6 + h] = wlp[(64 + j) * 192 + h * 64]; wc[9 + h] = wlp[(96 + j) * 192 + h * 64]; wc[12 + h] = wlp[(128 + j) * 192 + h * 64];
        }
#pragma unroll
        for (int tp = 0; tp < 6; ++tp) {
          const float sf = rdlane(x0[tp], j), sb = rdlane(x0[tp], 32 + j), sA = rdlane(x1[tp], j), sg = rdlane(x1[tp], 32 + j), sh = rdlane(x2[tp], j);
#pragma unroll
          for (int h = 0; h < 3; ++h) {
            af[h][tp] += sf * wc[h]; ab[h][tp] += sb * wc[3 + h]; aa[h][tp] += sA * wc[6 + h];
            ag[h][tp] += sg * wc[9 + h]; ag[h][tp] += sh * wc[12 + h];
          }
        }
      }
      int R0e = R0;
      asm volatile("" : "+v"(R0e));
#pragma unroll
      for (int h = 0; h < 3; ++h) {
        const int c = (hb + h) * 64 + lane;
#pragma unroll
        for (int tp = 0; tp < 6; ++tp) {
          const int R = R0e + tp;
          const float kxv = kx[h][tp];
          const float aav = aa[h][tp], afv = af[h][tp], abv = ab[h][tp], agv = ag[h][tp];
          float a = sigmoidf_(a0[c] + aav);
          float kk = kxv * kkw[c];
          float ss = wave_sum(kk * kk);
          kk = kk * rsqrtf(fmaxf(ss, 1e-24f));
          float k2 = kxv * (1.f + (a - 1.f) * kaw[c]);
          float uf = w0[c] + afv, ub = w0[384 + c] + abv;
          float df = expf(-0.6065306597126334f * sigmoidf_(uf));
          float db = expf(-0.6065306597126334f * sigmoidf_(ub));
          const float r_ = rw_shift(P, R, nn[tp], LL[tp], c, mu[c]);
          const float v_ = rw_shift(P, R, nn[tp], LL[tp], 768 + c, mu[768 + c]);
          float* o = rec + ((size_t)R * 6 + hb + h) * 512 + lane;
          o[0] = r_; o[128] = v_;
          o[64] = k2; o[192] = -kk; o[256] = kk * a; o[320] = df; o[384] = db; o[448] = agv;
        }
      }
    }
  }
  __syncthreads();
}

__device__ __forceinline__ float logsigmoidf_(float x) { return fminf(x, 0.f) - log1pf(expf(-fabsf(x))); }

__device__ __forceinline__ void prep_gla(const Params& p, int l) {
  const int wave = otid() >> 6, lane = otid() & 63;
  const float* P = (const float*)(p.ws + OFF_P);
  float* grec = (float*)(p.ws + OFF_GREC);
  const float* w2 = p.in[I_GW2] + (size_t)l * 2 * 16 * 192;
  const float* ab = p.in[I_GB] + l * 384;
  const int z = lane >> 5, d = lane & 31;
  float wreg[6][16], breg[6];
#pragma unroll
  for (int h = 0; h < 6; ++h) {
    breg[h] = ab[z * 192 + h * 32 + d];
#pragma unroll
    for (int r = 0; r < 16; ++r) wreg[h][r] = w2[(z * 16 + r) * 192 + h * 32 + d];
  }
  for (int tok = obid() * 8 + wave; tok < NTOK; tok += gridDim.x * 8) {
    const float* pr = P + (size_t)tok * INC;
    float lr[16];
#pragma unroll
    for (int r4 = 0; r4 < 4; ++r4) {
      float4 v = *(const float4*)(pr + 1152 + z * 16 + r4 * 4);
      lr[r4 * 4 + 0] = v.x; lr[r4 * 4 + 1] = v.y; lr[r4 * 4 + 2] = v.z; lr[r4 * 4 + 3] = v.w;
    }
    float qk[6], vv[6], gg[6];
#pragma unroll
    for (int h = 0; h < 6; ++h) {
      qk[h] = lane < 32 ? pr[h * 32 + lane] : pr[192 + h * 32 + (lane - 32)];
      vv[h] = pr[384 + h * 64 + lane];
      gg[h] = pr[768 + h * 64 + lane];
    }
    __builtin_amdgcn_sched_barrier(0);
#pragma unroll
    for (int h = 0; h < 6; ++h) {
      float acc = breg[h];
#pragma unroll
      for (int r = 0; r < 16; ++r) acc += lr[r] * wreg[h][r];
      float alpha = expf(logsigmoidf_(acc) * (1.f / 16.f));
      float* o = grec + ((size_t)tok * 6 + h) * 256 + lane;
      o[0] = lane < 32 ? qk[h] * 0.17677669529663687f : qk[h];
      o[64] = alpha; o[128] = vv[h]; o[192] = gg[h];
    }
  }
}

__device__ __forceinline__ void prep_hyena(const Params& p, int l) {
  const float* P = (const float*)(p.ws + OFF_P);
  float* hz = (float*)(p.ws + OFF_HYZ);
  float* hx = (float*)(p.ws + OFF_HYX);
  const float* cw = p.in[I_HCW] + l * 3 * 768;
  const float* cb = p.in[I_HCB] + l * 768;
  const int c = otid() & 255, rsub = otid() >> 8;
  float w_[3][3], b_[3];
#pragma unroll
  for (int s = 0; s < 3; ++s) { b_[s] = cb[s * 256 + c]; for (int t = 0; t < 3; ++t) w_[s][t] = cw[t * 768 + s * 256 + c]; }
  for (int r0 = obid() * 8; r0 < NTOK; r0 += gridDim.x * 8) {
    float pv[4][3][3];
    int rows[4];
#pragma unroll
    for (int q = 0; q < 4; ++q) {
      const int row = r0 + q * 2 + rsub;
      rows[q] = row;
      int t, L;
      if (row < NCTX) { t = row & 255; L = 256; } else { t = (row - NCTX) & 1023; L = 1024; }
      const float* pc = P + (size_t)row * INC + C_HY + c;
#pragma unroll
      for (int s = 0; s < 3; ++s) {
        pv[q][s][1] = pc[s * 256];
        pv[q][s][0] = t > 0 ? pc[s * 256 - INC] : 0.f;
        pv[q][s][2] = t < L - 1 ? pc[s * 256 + INC] : 0.f;
      }
    }
#pragma unroll
    for (int q = 0; q < 4; ++q) {
      float u[3];
#pragma unroll
      for (int s = 0; s < 3; ++s) u[s] = pv[q][s][0] * w_[s][0] + pv[q][s][1] * w_[s][1] + pv[q][s][2] * w_[s][2] + b_[s];
      hx[(size_t)rows[q] * 256 + c] = u[0];
      hz[(size_t)rows[q] * 256 + c] = u[1] * u[2];
      ((unsigned short*)(p.ws + OFF_HZB))[(size_t)rows[q] * 256 + c] = f2bf(u[1] * u[2]);
    }
  }
}

__device__ __forceinline__ void glds16(const void* g, void* l) {
  __builtin_amdgcn_global_load_lds((const unsigned*)g, (unsigned*)l, 16, 0, 0);
}

#define VMW(n) asm volatile("s_waitcnt vmcnt(" #n ")" ::: "memory")
#define LGKM0 __builtin_amdgcn_s_waitcnt(0xC07F)
__device__ __forceinline__ float quad_sum(float x) {
  x += __int_as_float(__builtin_amdgcn_update_dpp(0, __float_as_int(x), 0xB1, 0xF, 0xF, true));
  x += __int_as_float(__builtin_amdgcn_update_dpp(0, __float_as_int(x), 0x4E, 0xF, 0xF, true));
  return x;
}

template <int R> struct RwOps { f32x4 A[2], B[2], K[2], W[2], Rr[2]; float v[R]; };
constexpr int RW_SLOT = 1536;
__device__ __forceinline__ void rw_fill(const float* recg, char* slot, int lane, int dir) {
  glds16((const char*)recg + lane * 16, slot);
  if (lane < 32) {
    const char* g2 = (const char*)recg + (lane < 16 ? 1024 + lane * 16 : (5 + dir) * 256 + (lane - 16) * 16);
    glds16(g2, slot + 1024);
  }
}
template <int R>
__device__ __forceinline__ void rw_load(RwOps<R>& o, const char* rec, int k8, int vrow) {
  const f32x4* q = (const f32x4*)rec + k8 * 2;
#pragma unroll
  for (int i = 0; i < 2; ++i) { o.Rr[i] = q[i]; o.K[i] = q[16 + i]; o.A[i] = q[48 + i]; o.B[i] = q[64 + i]; o.W[i] = q[80 + i]; }
  if (R == 2) { f32x2 t = *(const f32x2*)((const float*)rec + 128 + vrow); o.v[0] = t.x; o.v[R - 1] = t.y; }
  else o.v[0] = ((const float*)rec)[128 + vrow];
}
template <int R>
__device__ __forceinline__ void rw_step(f32x2 (&S)[R][4], const RwOps<R>& o, float (&res)[R]) {
  const f32x2 A0 = {o.A[0][0], o.A[0][1]}, A1 = {o.A[0][2], o.A[0][3]}, A2 = {o.A[1][0], o.A[1][1]}, A3 = {o.A[1][2], o.A[1][3]};
  float sa[R];
#pragma unroll
  for (int r = 0; r < R; ++r) {
    f32x2 p0 = S[r][0] * A0, q0 = S[r][1] * A1;
    p0 += S[r][2] * A2; q0 += S[r][3] * A3;
    p0 += q0;
    sa[r] = p0.x + p0.y;
  }
#pragma unroll
  for (int r = 0; r < R; ++r) sa[r] += dpp_f(sa[r], 0);
#pragma unroll
  for (int r = 0; r < R; ++r) sa[r] += dpp_f(sa[r], 1);
#pragma unroll
  for (int r = 0; r < R; ++r) sa[r] += dpp_f(sa[r], 2);
#pragma unroll
  for (int i = 0; i < 4; ++i) {
    const f32x2 W = {o.W[i >> 1][(i & 1) * 2], o.W[i >> 1][(i & 1) * 2 + 1]};
    const f32x2 B = {o.B[i >> 1][(i & 1) * 2], o.B[i >> 1][(i & 1) * 2 + 1]};
    const f32x2 K = {o.K[i >> 1][(i & 1) * 2], o.K[i >> 1][(i & 1) * 2 + 1]};
#pragma unroll
    for (int r = 0; r < R; ++r) S[r][i] = S[r][i] * W + (f32x2{sa[r], sa[r]} * B + f32x2{o.v[r], o.v[r]} * K);
  }
  const f32x2 R0 = {o.Rr[0][0], o.Rr[0][1]}, R1 = {o.Rr[0][2], o.Rr[0][3]}, R2 = {o.Rr[1][0], o.Rr[1][1]}, R3 = {o.Rr[1][2], o.Rr[1][3]};
#pragma unroll
  for (int r = 0; r < R; ++r) {
    f32x2 u0 = S[r][0] * R0, w0 = S[r][1] * R1;
    u0 += S[r][2] * R2; w0 += S[r][3] * R3;
    u0 += w0;
    res[r] = u0.x + u0.y;
  }
#pragma unroll
  for (int r = 0; r < R; ++r) res[r] += dpp_f(res[r], 0);
#pragma unroll
  for (int r = 0; r < R; ++r) res[r] += dpp_f(res[r], 1);
#pragma unroll
  for (int r = 0; r < R; ++r) res[r] += dpp_f(res[r], 2);
}

template <int NW>
__device__ __forceinline__ void rw_poll(volatile unsigned* f, unsigned target) {
  for (unsigned sp = 0; sp < (1u << 20); ++sp) {
    unsigned m = min(min(f[0], f[1]), min(f[2], f[3]));
    if (NW == 8) m = min(m, min(min(f[4], f[5]), min(f[6], f[7])));
    if ((unsigned)__builtin_amdgcn_readfirstlane((int)m) >= target) break;
    __builtin_amdgcn_s_sleep(1);
  }
  asm volatile("" ::: "memory");
}

constexpr int RQ_STEPS = 64;
template <int NW, int R, int RING>
__device__ __forceinline__ void rwkv_scan(const Params& p, int l, int scan, int w, int rowoff, char* ring, volatile unsigned* fl) {
  constexpr int LPC = 8 / NW;
  constexpr int NCHR = RING / 8;
  static_assert(NW == 4 && (RING == 64 || RING == 32), "vmcnt immediates below are written for these cases");
  const int lane = otid() & 63;
  scan = __builtin_amdgcn_readfirstlane(scan);
  w = __builtin_amdgcn_readfirstlane(w);
  int b, hd, L, rowbase;
  const bool lat = scan < 96;
  if (lat) { b = scan / 12; hd = scan % 12; L = 1024; rowbase = NCTX + b * 1024; }
  else { int t2 = scan - 96; b = t2 / 12; hd = t2 % 12; L = 256; rowbase = b * 256; }
  const int h = hd >> 1, dir = hd & 1;
  const int k8 = lane & 7, vrow = rowoff + w * (8 * R) + (lane >> 3) * R;
  const float* rec = (const float*)(p.ws + OFF_REC);
  float* RO = (float*)(p.ws + OFF_RO) + (size_t)dir * NTOK * 384 + h * 64 + vrow + (R == 2 ? (k8 & 1) : 0);
  f32x2 S[R][4];
  if (lat) {
    const float* sb = p.in[I_SR] + ((((size_t)b * DEPTH + l) * 2 + dir) * 6 + h) * 4096 + vrow * 64 + k8 * 8;
#pragma unroll
    for (int r = 0; r < R; ++r)
#pragma unroll
      for (int i = 0; i < 2; ++i) { float4 v = *(const float4*)(sb + r * 64 + i * 4); S[r][2 * i] = f32x2{v.x, v.y}; S[r][2 * i + 1] = f32x2{v.z, v.w}; }
  } else {
#pragma unroll
    for (int r = 0; r < R; ++r)
#pragma unroll
      for (int i = 0; i < 4; ++i) S[r][i] = f32x2{0.f, 0.f};
  }
  VMW(0);
  const int NCH = L >> 3;
#define RW_REC(st) (rec + ((size_t)(rowbase + (dir ? L - 1 - (st) : (st))) * 6 + h) * 512)
#define RW_SLOTP(st) (ring + ((st) & (RING - 1)) * RW_SLOT)
#pragma unroll
  for (int c = 0; c < NCHR - 1; ++c)
#pragma unroll
    for (int t = 0; t < LPC; ++t) { const int s = 8 * c + NW * t + w; rw_fill(RW_REC(s), RW_SLOTP(s), lane, dir); }
  RwOps<R> oa{};
  float osel = 0.f;
  for (int c = 0; c < NCH; ++c) {
    if (c + NCHR - 2 <= NCH - 1) { if (RING == 64) VMW(20); else VMW(4); } else VMW(0);
    if (lane == 0) fl[w] = (unsigned)(c + 2);
    rw_poll<NW>(fl, (unsigned)(c + 2));
    if (c == 0) rw_load<R>(oa, RW_SLOTP(0), k8, vrow);
    for (int j = 0; j < 8; j += 2) {
      const int s = 8 * c + j;
      RwOps<R> ob;
      LGKM0;
      rw_load<R>(ob, RW_SLOTP(s + 1), k8, vrow);
      __builtin_amdgcn_sched_barrier(0);
      {
        float o[R];
        rw_step<R>(S, oa, o);
        if (R == 2) osel = ((s & 3) == (k8 >> 1)) ? ((k8 & 1) ? o[R - 1] : o[0]) : osel;
        else osel = ((s & 7) == k8) ? o[0] : osel;
      }
      __builtin_amdgcn_sched_barrier(0);
      LGKM0;
      rw_load<R>(oa, RW_SLOTP(s + 2), k8, vrow);
      __builtin_amdgcn_sched_barrier(0);
      {
        float o[R];
        rw_step<R>(S, ob, o);
        if (R == 2) {
          osel = (((s + 1) & 3) == (k8 >> 1)) ? ((k8 & 1) ? o[R - 1] : o[0]) : osel;
          if (((s + 1) & 3) == 3) {
            const int st = s - 2 + (k8 >> 1);
            const int n = dir ? L - 1 - st : st;
            RO[(size_t)(rowbase + n) * 384] = osel;
          }
        } else {
          osel = (((s + 1) & 7) == k8) ? o[0] : osel;
          if (((s + 1) & 7) == 7) {
            const int st = s - 6 + k8;
            const int n = dir ? L - 1 - st : st;
            RO[(size_t)(rowbase + n) * 384] = osel;
          }
        }
      }
      __builtin_amdgcn_sched_barrier(0);
    }
    asm volatile("" ::: "memory");
    if (lane == 0) fl[8 + w] = (unsigned)(c + 1);
    if (c + NCHR - 1 < NCH) {
      rw_poll<NW>(fl + 8, (unsigned)c);
#pragma unroll
      for (int t = 0; t < LPC; ++t) { const int s = 8 * (c + NCHR - 1) + NW * t + w; rw_fill(RW_REC(s), RW_SLOTP(s), lane, dir); }
    }
  }
#undef RW_REC
#undef RW_SLOTP
  if (!lat) {
    float* so = p.out + (size_t)NTOK * D + (size_t)16 * DEPTH * 2 * 6 * 2048 +
                ((((size_t)b * DEPTH + l) * 2 + dir) * 6 + h) * 4096 + vrow * 64 + k8 * 8;
#pragma unroll
    for (int r = 0; r < R; ++r)
#pragma unroll
      for (int i = 0; i < 2; ++i) *(float4*)(so + r * 64 + i * 4) = make_float4(S[r][2 * i].x, S[r][2 * i].y, S[r][2 * i + 1].x, S[r][2 * i + 1].y);
  }
  VMW(0);
}

struct RwOpsLa { f32x4 An[2], B[2], K[2], W[2], Rr[2]; float v; };
__device__ __forceinline__ void rw_load_la(RwOpsLa& o, const char* rec, const char* recn, int k8, int vrow) {
  const f32x4* q = (const f32x4*)rec + k8 * 2;
  const f32x4* qn = (const f32x4*)recn + k8 * 2;
#pragma unroll
  for (int i = 0; i < 2; ++i) { o.Rr[i] = q[i]; o.K[i] = q[16 + i]; o.B[i] = q[64 + i]; o.W[i] = q[80 + i]; o.An[i] = qn[48 + i]; }
  o.v = ((const float*)rec)[128 + vrow];
}
__device__ __forceinline__ float rw_step_la(f32x2 (&S)[4], float& sa, const RwOpsLa& o) {
  f32x2 W2[4], B2[4], K2[4], A2[4], R2[4];
#pragma unroll
  for (int i = 0; i < 4; ++i) {
    const int a = i >> 1, c = (i & 1) * 2;
    W2[i] = f32x2{o.W[a][c], o.W[a][c + 1]}; B2[i] = f32x2{o.B[a][c], o.B[a][c + 1]}; K2[i] = f32x2{o.K[a][c], o.K[a][c + 1]};
    A2[i] = f32x2{o.An[a][c], o.An[a][c + 1]}; R2[i] = f32x2{o.Rr[a][c], o.Rr[a][c + 1]};
  }
  const f32x2 vv = {o.v, o.v};
  f32x2 T[4];
#pragma unroll
  for (int i = 0; i < 4; ++i) T[i] = S[i] * W2[i] + vv * K2[i];
  f32x2 g0 = T[0] * A2[0], g1 = T[1] * A2[1];
  g0 += T[2] * A2[2]; g1 += T[3] * A2[3]; g0 += g1;
  f32x2 b0 = B2[0] * A2[0], b1 = B2[1] * A2[1];
  b0 += B2[2] * A2[2]; b1 += B2[3] * A2[3]; b0 += b1;
  float gp = g0.x + g0.y, bp = b0.x + b0.y;
  gp += dpp_f(gp, 0); bp += dpp_f(bp, 0);
  gp += dpp_f(gp, 1); bp += dpp_f(bp, 1);
  gp += dpp_f(gp, 2); bp += dpp_f(bp, 2);
  const f32x2 sav = {sa, sa};
#pragma unroll
  for (int i = 0; i < 4; ++i) S[i] = sav * B2[i] + T[i];
  f32x2 u0 = S[0] * R2[0], u1 = S[1] * R2[1];
  u0 += S[2] * R2[2]; u1 += S[3] * R2[3]; u0 += u1;
  float ov = u0.x + u0.y;
  ov += dpp_f(ov, 0); ov += dpp_f(ov, 1); ov += dpp_f(ov, 2);
  sa = sa * bp + gp;
  return ov;
}

__device__ __forceinline__ void rwkv_scan_la(const Params& p, int l, int scan, int w, int rowoff, char* ring, volatile unsigned* fl) {
  constexpr int NW = 4, R = 1, RING = 64;
  constexpr int LPC = 8 / NW;
  constexpr int NCHR = RING / 8;
  static_assert(NW == 4 && (RING == 64 || RING == 32), "vmcnt immediates below are written for these cases");
  const int lane = otid() & 63;
  scan = __builtin_amdgcn_readfirstlane(scan);
  w = __builtin_amdgcn_readfirstlane(w);
  int b, hd, L, rowbase;
  const bool lat = scan < 96;
  if (lat) { b = scan / 12; hd = scan % 12; L = 1024; rowbase = NCTX + b * 1024; }
  else { int t2 = scan - 96; b = t2 / 12; hd = t2 % 12; L = 256; rowbase = b * 256; }
  const int h = hd >> 1, dir = hd & 1;
  const int k8 = lane & 7, vrow = rowoff + w * (8 * R) + (lane >> 3) * R;
  const float* rec = (const float*)(p.ws + OFF_REC);
  float* RO = (float*)(p.ws + OFF_RO) + (size_t)dir * NTOK * 384 + h * 64 + vrow + (R == 2 ? (k8 & 1) : 0);
  f32x2 S[R][4];
  if (lat) {
    const float* sb = p.in[I_SR] + ((((size_t)b * DEPTH + l) * 2 + dir) * 6 + h) * 4096 + vrow * 64 + k8 * 8;
#pragma unroll
    for (int r = 0; r < R; ++r)
#pragma unroll
      for (int i = 0; i < 2; ++i) { float4 v = *(const float4*)(sb + r * 64 + i * 4); S[r][2 * i] = f32x2{v.x, v.y}; S[r][2 * i + 1] = f32x2{v.z, v.w}; }
  } else {
#pragma unroll
    for (int r = 0; r < R; ++r)
#pragma unroll
      for (int i = 0; i < 4; ++i) S[r][i] = f32x2{0.f, 0.f};
  }
  VMW(0);
  const int NCH = L >> 3;
#define RW_REC(st) (rec + ((size_t)(rowbase + (dir ? L - 1 - (st) : (st))) * 6 + h) * 512)
#define RW_SLOTP(st) (ring + ((st) & (RING - 1)) * RW_SLOT)
#pragma unroll
  for (int c = 0; c < NCHR - 1; ++c)
#pragma unroll
    for (int t = 0; t < LPC; ++t) { const int s = 8 * c + NW * t + w; rw_fill(RW_REC(s), RW_SLOTP(s), lane, dir); }
  RwOpsLa oa{};
  float sa = 0.f;
  float osel = 0.f;
  for (int c = 0; c < NCH; ++c) {
    if (c + NCHR - 2 <= NCH - 1) { if (RING == 64) VMW(20); else VMW(4); } else VMW(0);
    if (lane == 0) fl[w] = (unsigned)(c + 2);
    rw_poll<NW>(fl, (unsigned)(c + 2));
    if (c == 0) {
      const f32x4* q0 = (const f32x4*)RW_SLOTP(0) + k8 * 2;
      const f32x4 a0 = q0[48], a1 = q0[49];
      f32x2 d0 = S[0][0] * f32x2{a0[0], a0[1]}, d1 = S[0][1] * f32x2{a0[2], a0[3]};
      d0 += S[0][2] * f32x2{a1[0], a1[1]}; d1 += S[0][3] * f32x2{a1[2], a1[3]};
      d0 += d1;
      sa = d0.x + d0.y;
      sa += dpp_f(sa, 0); sa += dpp_f(sa, 1); sa += dpp_f(sa, 2);
      rw_load_la(oa, RW_SLOTP(0), RW_SLOTP(1), k8, vrow);
    }
    for (int j = 0; j < 8; j += 2) {
      const int s = 8 * c + j;
      RwOpsLa ob;
      LGKM0;
      rw_load_la(ob, RW_SLOTP(s + 1), RW_SLOTP(s + 2), k8, vrow);
      __builtin_amdgcn_sched_barrier(0);
      {
        float o[R];
        o[0] = rw_step_la(S[0], sa, oa);
        if (R == 2) osel = ((s & 3) == (k8 >> 1)) ? ((k8 & 1) ? o[R - 1] : o[0]) : osel;
        else osel = ((s & 7) == k8) ? o[0] : osel;
      }
      __builtin_amdgcn_sched_barrier(0);
      LGKM0;
      rw_load_la(oa, RW_SLOTP(s + 2), RW_SLOTP(s + 3), k8, vrow);
      __builtin_amdgcn_sched_barrier(0);
      {
        float o[R];
        o[0] = rw_step_la(S[0], sa, ob);
        if (R == 2) {
          osel = (((s + 1) & 3) == (k8 >> 1)) ? ((k8 & 1) ? o[R - 1] : o[0]) : osel;
          if (((s + 1) & 3) == 3) {
            const int st = s - 2 + (k8 >> 1);
            const int n = dir ? L - 1 - st : st;
            RO[(size_t)(rowbase + n) * 384] = osel;
          }
        } else {
          osel = (((s + 1) & 7) == k8) ? o[0] : osel;
          if (((s + 1) & 7) == 7) {
            const int st = s - 6 + k8;
            const int n = dir ? L - 1 - st : st;
            RO[(size_t)(rowbase + n) * 384] = osel;
          }
        }
      }
      __builtin_amdgcn_sched_barrier(0);
    }
    asm volatile("" ::: "memory");
    if (lane == 0) fl[8 + w] = (unsigned)(c + 1);
    if (c + NCHR - 1 < NCH) {
      rw_poll<NW>(fl + 8, (unsigned)c);
#pragma unroll
      for (int t = 0; t < LPC; ++t) { const int s = 8 * (c + NCHR - 1) + NW * t + w; rw_fill(RW_REC(s), RW_SLOTP(s), lane, dir); }
    }
  }
#undef RW_REC
#undef RW_SLOTP
  if (!lat) {
    float* so = p.out + (size_t)NTOK * D + (size_t)16 * DEPTH * 2 * 6 * 2048 +
                ((((size_t)b * DEPTH + l) * 2 + dir) * 6 + h) * 4096 + vrow * 64 + k8 * 8;
#pragma unroll
    for (int r = 0; r < R; ++r)
#pragma unroll
      for (int i = 0; i < 2; ++i) *(float4*)(so + r * 64 + i * 4) = make_float4(S[r][2 * i].x, S[r][2 * i].y, S[r][2 * i + 1].x, S[r][2 * i + 1].y);
  }
  VMW(0);
}

template <int NE> struct GlOps { f32x4 Q[2], K[2], A[2]; float v[NE]; };
constexpr int GL_RING = 32, GL_SLOT = 768;
template <int NE>
__device__ __forceinline__ void gl_load(GlOps<NE>& o, const char* rec, int dir, int dq, int ecol) {
  const f32x4* q = (const f32x4*)rec;
#pragma unroll
  for (int i = 0; i < 2; ++i) { o.Q[i] = q[dq * 2 + i]; o.K[i] = q[8 + dq * 2 + i]; o.A[i] = q[16 + dir * 8 + dq * 2 + i]; }
  if (NE == 4) { f32x4 t = *(const f32x4*)((const float*)rec + 128 + ecol); o.v[0] = t[0]; o.v[1] = t[1]; o.v[NE - 2] = t[2]; o.v[NE - 1] = t[3]; }
  else { f32x2 t = *(const f32x2*)((const float*)rec + 128 + ecol); o.v[0] = t.x; o.v[1] = t.y; }
}
template <int NE>
__device__ __forceinline__ float gl_step(f32x2 (&S)[8][NE / 2], const GlOps<NE>& o, int dq) {
  f32x2 vv[NE / 2], acc[NE / 2];
#pragma unroll
  for (int e = 0; e < NE / 2; ++e) { vv[e] = f32x2{o.v[2 * e], o.v[2 * e + 1]}; acc[e] = f32x2{0.f, 0.f}; }
#pragma unroll
  for (int d = 0; d < 8; ++d) {
    const float a = o.A[d >> 2][d & 3], kk = o.K[d >> 2][d & 3], qq = o.Q[d >> 2][d & 3];
    const f32x2 av = {a, a}, kv = {kk, kk}, qv = {qq, qq};
#pragma unroll
    for (int e = 0; e < NE / 2; ++e) { S[d][e] = av * S[d][e] + kv * vv[e]; acc[e] += qv * S[d][e]; }
  }
  if (NE == 4) {
    const float r0 = quad_sum(acc[0].x), r1 = quad_sum(acc[0].y), r2 = quad_sum(acc[NE / 2 - 1].x), r3 = quad_sum(acc[NE / 2 - 1].y);
    return dq == 0 ? r0 : (dq == 1 ? r1 : (dq == 2 ? r2 : r3));
  } else {
    const float r0 = quad_sum(acc[0].x), r1 = quad_sum(acc[0].y);
    return (dq & 1) ? r1 : r0;
  }
}
template <int NE>
__device__ __forceinline__ void gla_scan(const Params& p, int l, int task, int eh, char* ring  ) {
  const int lane = otid() & 63;
  task = __builtin_amdgcn_readfirstlane(task);
  int b, hd, L, rowbase;
  const bool lat = task < 96;
  if (lat) { b = task / 12; hd = task % 12; L = 1024; rowbase = NCTX + b * 1024; }
  else { int t2 = task - 96; b = t2 / 12; hd = t2 % 12; L = 256; rowbase = b * 256; }
  const int h = hd >> 1, dir = hd & 1;
  const int dq = lane & 3, eg = lane >> 2;
  const int ecol = (NE == 4) ? eg * 4 : eh * 32 + eg * 2;
  const bool owner = (NE == 4) || dq < 2;
  const float* grec = (const float*)(p.ws + OFF_GREC);
  float* GO = (float*)(p.ws + OFF_GO) + (size_t)dir * NTOK * 384 + h * 64 + ecol + (NE == 4 ? dq : (dq & 1));
  f32x2 S[8][NE / 2];
  if (lat) {
    const float* s0 = p.in[I_SG] + ((((size_t)b * DEPTH + l) * 2 + dir) * 6 + h) * 2048 + (dq * 8) * 64 + ecol;
#pragma unroll
    for (int d = 0; d < 8; ++d)
#pragma unroll
      for (int e = 0; e < NE / 2; ++e) { f32x2 v = *(const f32x2*)(s0 + d * 64 + 2 * e); S[d][e] = v; }
  } else {
#pragma unroll
    for (int d = 0; d < 8; ++d)
#pragma unroll
      for (int e = 0; e < NE / 2; ++e) S[d][e] = f32x2{0.f, 0.f};
  }
  VMW(0);
#define GL_REC(st) ((const char*)(grec + ((size_t)(rowbase + (dir ? L - 1 - (st) : (st))) * 6 + h) * 256))
#pragma unroll
  for (int s = 0; s < GL_RING; ++s) { if (lane < 48) glds16(GL_REC(s) + lane * 16, ring + s * GL_SLOT); }
  GlOps<NE> oa{};
  VMW(31);
  gl_load<NE>(oa, ring, dir, dq, ecol);
  for (int s = 0; s < L; s += 2) {
    GlOps<NE> ob;
    LGKM0; if (s + GL_RING >= L) VMW(0); else VMW(30);
    gl_load<NE>(ob, ring + ((s + 1) & (GL_RING - 1)) * GL_SLOT, dir, dq, ecol);
    __builtin_amdgcn_sched_barrier(0);
    {
      float o = gl_step<NE>(S, oa, dq);
      const int n = dir ? L - 1 - s : s;
      if (owner) GO[(size_t)(rowbase + n) * 384] = o;
    }
    asm volatile("" ::: "memory");
    if (s + GL_RING < L && lane < 48) glds16(GL_REC(s + GL_RING) + lane * 16, ring + (s & (GL_RING - 1)) * GL_SLOT);
    __builtin_amdgcn_sched_barrier(0);
    LGKM0; if (s + 1 + GL_RING >= L) VMW(0); else VMW(30);
    gl_load<NE>(oa, ring + ((s + 2) & (GL_RING - 1)) * GL_SLOT, dir, dq, ecol);
    __builtin_amdgcn_sched_barrier(0);
    {
      float o = gl_step<NE>(S, ob, dq);
      const int n = dir ? L - 2 - s : s + 1;
      if (owner) GO[(size_t)(rowbase + n) * 384] = o;
    }
    asm volatile("" ::: "memory");
    if (s + 1 + GL_RING < L && lane < 48) glds16(GL_REC(s + 1 + GL_RING) + lane * 16, ring + ((s + 1) & (GL_RING - 1)) * GL_SLOT);
    __builtin_amdgcn_sched_barrier(0);
  }
#undef GL_REC
  if (!lat) {
    float* so = p.out + (size_t)NTOK * D + ((((size_t)b * DEPTH + l) * 2 + dir) * 6 + h) * 2048 + (dq * 8) * 64 + ecol;
#pragma unroll
    for (int d = 0; d < 8; ++d)
#pragma unroll
      for (int e = 0; e < NE / 2; ++e) *(f32x2*)(so + d * 64 + 2 * e) = S[d][e];
  }
  VMW(0);
}

constexpr int HY_TASKS = 768;
__device__ __forceinline__ void hyena_task(const Params& p, int l, int task) {
  const int lane = otid() & 63;
  int b, cgp, tb, L, rowbase;
  const float* ft = (const float*)(p.ws + OFF_FT) + (size_t)l * FT_LAYER;
  if (task < 512) { b = task >> 6; cgp = (task >> 5) & 1; tb = task & 31; L = 1024; rowbase = NCTX + b * 1024; ft += FT_L0; }
  else { int t2 = task - 512; b = t2 >> 4; cgp = (t2 >> 3) & 1; tb = t2 & 7; L = 256; rowbase = b * 256; }
  const int c = cgp * 128 + lane * 2;
  const int t0 = tb * 32;
  const float* hz = (const float*)(p.ws + OFF_HYZ) + (size_t)rowbase * 256 + c;
  const float* hx = (const float*)(p.ws + OFF_HYX) + (size_t)rowbase * 256 + c;
  const float* fc = ft + c;
  const unsigned short* hzb = (const unsigned short*)(p.ws + OFF_HZB) + (size_t)rowbase * 256 + c;
  const unsigned short* fcb = (const unsigned short*)(p.ws + OFF_FTB) + (size_t)(ft - (const float*)(p.ws + OFF_FT)) + c;
  f32x2 acc[32];
#pragma unroll
  for (int i = 0; i < 32; ++i) acc[i] = f32x2{0.f, 0.f};
  for (int s0 = 0; s0 < L; s0 += 16) {
    f32x2 z[16], f[47];
#pragma unroll
    for (int j = 0; j < 16; ++j) { const unsigned u = *(const unsigned*)(hzb + (size_t)(s0 + j) * 256); z[j] = f32x2{__uint_as_float(u << 16), __uint_as_float(u & 0xffff0000u)}; }
    const unsigned short* fb = fcb + (size_t)(t0 - s0 - 15 + L - 1) * 256;
#pragma unroll
    for (int m = 0; m < 47; ++m) { const unsigned u = *(const unsigned*)(fb + (size_t)m * 256); f[m] = f32x2{__uint_as_float(u << 16), __uint_as_float(u & 0xffff0000u)}; }
#pragma unroll
    for (int i = 0; i < 32; ++i)
#pragma unroll
      for (int j = 0; j < 16; ++j) acc[i] += f[i - j + 15] * z[j];
  }
  const f32x2 bias = *(const f32x2*)(p.in[I_HBIAS] + l * 256 + c);
  unsigned* O = (unsigned*)(p.ws + OFF_H);
#pragma unroll
  for (int i = 0; i < 32; ++i) {
    int t = t0 + i;
    f32x2 zz = *(const f32x2*)(hz + (size_t)t * 256), xx = *(const f32x2*)(hx + (size_t)t * 256);
    f32x2 y = xx * (acc[i] + zz * bias);
    O[((size_t)(rowbase + t) * D + 384 + c) >> 1] = (unsigned)f2bf(y.x) | ((unsigned)f2bf(y.y) << 16);
  }
}

constexpr int LDS_GLA = 98304, LDS_FLAGS = 147456, LDS_XB = 147584;
__device__ __forceinline__ void phase_mixers(const Params& p, int l, int cidx) {
  const int wave = otid() >> 6, lane = otid() & 63;
  const int bid = obid();
  volatile unsigned* fl = (volatile unsigned*)(smem + LDS_FLAGS);
  if (otid() < 32) fl[otid()] = 0u;
  __syncthreads();
  __builtin_amdgcn_s_setprio(3);
  if (bid < 192) {
    if (wave < 4) rwkv_scan_la(p, l, bid >> 1, wave, (bid & 1) * 32, smem, fl);
    else rwkv_scan<4, 2, 32>(p, l, 96 + bid, wave - 4, 0, smem + 98304, fl + 16);
  } else if (wave < 3) {
    const int g = (bid - 192) * 3 + wave;
    gla_scan<2>(p, l, g >> 1, g & 1, smem + wave * 24576);
  } else if (wave < 6) {
    gla_scan<4>(p, l, 96 + (bid - 192) * 3 + (wave - 3), 0, smem + wave * 24576);
  }
  __builtin_amdgcn_s_setprio(0);
  int* cnt = (int*)(p.ws + OFF_CNT) + cidx;
  const int ntask = HY_TASKS + (l < DEPTH - 1 ? 5312 : 0);
  while (true) {
    int t = 0;
    if (lane == 0) t = atomicAdd(cnt, 1);
    t = __shfl(t, 0);
    if (t >= ntask) break;
    if (t < HY_TASKS) hyena_task(p, l, t);
    else wconv_wave(p, l + 1, (l + 1) & 1, t - HY_TASKS);
  }
}

__device__ __forceinline__ void phase_post(const Params& p, int l) {
  const int wave = otid() >> 6, lane = otid() & 63;
  const float* GO = (const float*)(p.ws + OFF_GO);
  const float* RO = (const float*)(p.ws + OFF_RO);
  const float* grec = (const float*)(p.ws + OFF_GREC);
  const float* rec = (const float*)(p.ws + OFF_REC);
  unsigned short* O = (unsigned short*)(p.ws + OFF_H);
  const float gn = p.in[I_GN][l * 64 + lane];
  float lw[6], lb[6], rk[6];
#pragma unroll
  for (int h = 0; h < 6; ++h) { lw[h] = p.in[I_RLW][l * 384 + h * 64 + lane]; lb[h] = p.in[I_RLB][l * 384 + h * 64 + lane]; rk[h] = p.in[I_RRK][l * 384 + h * 64 + lane]; }
  const int nw = gridDim.x * 8;
  constexpr int NR = 3;
  for (int R0 = obid() * 8 + wave; R0 < NTOK; R0 += NR * nw) {
    float go[NR][6], gg[NR][6], ro[NR][6], r_[NR][6], k_[NR][6], v_[NR][6], g_[NR][6];
    int Rq[NR];
#pragma unroll
    for (int q = 0; q < NR; ++q) {
      const int R = (R0 + q * nw < NTOK) ? R0 + q * nw : R0;
      Rq[q] = R;
#pragma unroll
      for (int h = 0; h < 6; ++h) {
        go[q][h] = GO[(size_t)R * 384 + h * 64 + lane] + GO[(size_t)(NTOK + R) * 384 + h * 64 + lane];
        gg[q][h] = grec[((size_t)R * 6 + h) * 256 + 192 + lane];
        ro[q][h] = RO[(size_t)R * 384 + h * 64 + lane] + RO[(size_t)(NTOK + R) * 384 + h * 64 + lane];
        const float* rr = rec + ((size_t)R * 6 + h) * 512 + lane;
        r_[q][h] = rr[0]; k_[q][h] = rr[64]; v_[q][h] = rr[128]; g_[q][h] = rr[448];
      }
    }
    __builtin_amdgcn_sched_barrier(0);
#pragma unroll
    for (int q = 0; q < NR; ++q) {
      if (q >= 1 && R0 + q * nw >= NTOK) break;
      const int R = Rq[q];
      const int tokr = scan2tok(R);
#pragma unroll
      for (int h = 0; h < 6; ++h) {
        const float o = go[q][h];
        float ms = wave_sum(o * o) * (1.f / 64.f);
        float y = o * rsqrtf(ms + 1e-6f) * gn;
        O[(size_t)R * D + h * 64 + lane] = f2bf(y * siluf_(gg[q][h]));
      }
#pragma unroll
      for (int h = 0; h < 6; ++h) {
        const int c = h * 64 + lane;
        const float o = ro[q][h];
        float mean = wave_sum(o) * (1.f / 64.f);
        float dlt = o - mean;
        float var = wave_sum(dlt * dlt) * (1.f / 64.f);
        float y = dlt * rsqrtf(var + 64e-5f) * lw[h] + lb[h];
        float bonus = wave_sum(r_[q][h] * k_[q][h] * rk[h]) * v_[q][h];
        O[(size_t)tokr * D + 640 + c] = f2bf((y + bonus) * g_[q][h]);
      }
    }
  }
}

#define XB_TMO      128
#define XB_XCNT(j)  (256  + 64 * (j))
#define XB_XSUB(j)  (1280 + 64 * (j))
#define XB_XGEN(j)  (2304 + 64 * (j))
#define XB_TOP      3328
#define XB_TOPGEN   3392
#define XCD_BAR_WORDS 3456
#define XB_SPIN_CAP (1u << 18)
#define LAS __attribute__((address_space(3)))

__device__ __forceinline__ unsigned xb_ld(unsigned* p)              { return __hip_atomic_load(p, __ATOMIC_RELAXED, __HIP_MEMORY_SCOPE_AGENT); }
__device__ __forceinline__ unsigned xb_add(unsigned* p, unsigned v) { return __hip_atomic_fetch_add(p, v, __ATOMIC_RELAXED, __HIP_MEMORY_SCOPE_AGENT); }
__device__ __forceinline__ unsigned xb_xcc_id() { return (unsigned)__builtin_amdgcn_s_getreg((3 << 11) | 20) & 0xFu; }
#define XB_SPIN(cond, bar) do { unsigned _sp = 0; while (cond) { __builtin_amdgcn_s_sleep(1); \
    if ((++_sp & 255u) == 0u) { if (xb_ld(&(bar)[XB_TMO])) break; if (_sp > XB_SPIN_CAP) { atomicAdd(&(bar)[XB_TMO], 1u); break; } } } } while (0)

struct XcdBarrier {
    unsigned* bar; unsigned x;
    volatile LAS unsigned* st;
};

__device__ __forceinline__ XcdBarrier xcd_barrier_post(unsigned* bar, volatile LAS unsigned* st) {
    XcdBarrier b; b.bar = bar; b.x = xb_xcc_id(); b.st = st;
    if (threadIdx.x == 0) (void)xb_add(&bar[XB_XCNT(b.x)], 1u);
    return b;
}
__device__ __forceinline__ void xcd_barrier_complete(unsigned* bar, unsigned x, unsigned& nloc, unsigned& nx) {
    const unsigned G = gridDim.x * gridDim.y * gridDim.z;
    unsigned sum, cnt, mine, sp = 0u;
    for (;;) {
        sum = 0u; cnt = 0u; mine = 0u;
#pragma unroll
        for (unsigned j = 0; j < 16; ++j) { const unsigned c = xb_ld(&bar[XB_XCNT(j)]); sum += c; cnt += (c > 0u) ? 1u : 0u; mine = (j == x) ? c : mine; }
        if (sum == G) break;
        __builtin_amdgcn_s_sleep(1);
        if ((++sp & 255u) == 0u) { if (xb_ld(&bar[XB_TMO])) break; if (sp > XB_SPIN_CAP) { atomicAdd(&bar[XB_TMO], 1u); break; } }
    }
    nloc = mine > 0u ? mine : 1u; nx = cnt > 0u ? cnt : 1u;
}

__device__ __forceinline__ void xcd_barrier(const XcdBarrier& b) {
    asm volatile("s_waitcnt vmcnt(0)" ::: "memory");
    __syncthreads();
    if (threadIdx.x == 0) {
        unsigned* bar = b.bar;
        __builtin_amdgcn_s_waitcnt(0);
        unsigned nloc = b.st[0], nx = b.st[1];
        if (nloc == 0u) { xcd_barrier_complete(bar, b.x, nloc, nx); b.st[0] = nloc; b.st[1] = nx; }
        const unsigned old = xb_add(&bar[XB_XSUB(b.x)], 1u);
        const unsigned gen = old / nloc;
        if (old + 1u == (gen + 1u) * nloc) {
            __builtin_amdgcn_fence(__ATOMIC_RELEASE, "agent");
            asm volatile("s_waitcnt vmcnt(0)" ::: "memory");
            const unsigned og = xb_add(&bar[XB_TOP], 1u);
            const unsigned tg = og / nx;
            if (og + 1u == (tg + 1u) * nx) xb_add(&bar[XB_TOPGEN], 1u);
            else XB_SPIN(xb_ld(&bar[XB_TOPGEN]) == tg, bar);
            __builtin_amdgcn_fence(__ATOMIC_ACQUIRE, "agent");
            xb_add(&bar[XB_XGEN(b.x)], 1u);
            asm volatile("s_waitcnt vmcnt(0)" ::: "memory");
        } else {
            XB_SPIN(xb_ld(&bar[XB_XGEN(b.x)]) == gen, bar);
            __builtin_amdgcn_fence(__ATOMIC_ACQUIRE, "agent");
            asm volatile("s_waitcnt vmcnt(0)" ::: "memory");
        }
    }
    __syncthreads();
}

__global__ void __launch_bounds__(NTHR) fwd_megakernel(Params p) {
  cg::grid_group grid = cg::this_grid();
  if (threadIdx.x == 0) *(uint4*)(smem + 147584) = make_uint4(0u, 0u, 0u, 0u);
  __syncthreads();
  XcdBarrier xb = xcd_barrier_post((unsigned*)(p.ws + OFF_BAR), (volatile LAS unsigned*)(smem + 147584));
  if (obid() == 0 && otid() < 64) ((int*)(p.ws + OFF_CNT))[otid()] = 0;
  p0_copy_x(p);
  p0_filters(p);
  p0_mod(p);
  __syncthreads();
  phase_wconv(p, 0, 0);
  bf16* hbuf = (bf16*)(p.ws + OFF_H);
  bf16* hmid = (bf16*)(p.ws + OFF_HMID);
  float* xw = (float*)(p.ws + OFF_X);
  float* Pw = (float*)(p.ws + OFF_P);
  for (int l = 0; l < DEPTH; ++l) {
    const float* modl = (const float*)(p.ws + OFF_MOD) + (size_t)l * 9 * 9216;
    const size_t wset = (size_t)(l & 1) * WSET;
    if (l == 0) grid.sync();
    phase_norm(p, p.in[I_F1N] + l * D, modl, 0, 1);
    xcd_barrier(xb);
    phase_gemm(hbuf, p.ws + OFF_W1I + wset, 5632, 1024, EpiSwiglu{(unsigned short*)hmid});
    xcd_barrier(xb);
    phase_gemm(hmid, p.ws + OFF_W1O + wset, 1024, 2816, EpiResid{xw, modl, 2, 0.5f});
    xcd_barrier(xb);
    phase_norm(p, p.in[I_MN] + l * D, modl, 3, 4);
    xcd_barrier(xb);
    phase_gemm(hbuf, p.ws + OFF_WMI + wset, INCP, 1024, EpiP{Pw});
    xcd_barrier(xb);
    prep_rwkv(p, l);
    prep_gla(p, l);
    prep_hyena(p, l);
    xcd_barrier(xb);
    phase_mixers(p, l, l);
    xcd_barrier(xb);
    phase_post(p, l);
    xcd_barrier(xb);
    phase_gemm(hbuf, p.ws + OFF_WMO + wset, 1024, 1024, EpiResid{xw, modl, 5, 1.0f});
    xcd_barrier(xb);
    phase_norm(p, p.in[I_F2N] + l * D, modl, 6, 7);
    xcd_barrier(xb);
    phase_gemm(hbuf, p.ws + OFF_W2I + wset, 5632, 1024, EpiSwiglu{(unsigned short*)hmid});
    xcd_barrier(xb);
    phase_gemm(hmid, p.ws + OFF_W2O + wset, 1024, 2816, EpiResid{xw, modl, 8, 0.5f});
    xcd_barrier(xb);
  }
  phase_final_norm(p);
}

extern "C" void kernel_launch(void* const* d_in, const int* in_sizes, int n_in, void* d_out, int out_size, void* d_ws,
                              size_t ws_size, hipStream_t stream) {
  static int grid_blocks = 0;
  if (!grid_blocks) {
    int dev = 0, cus = 0, per_cu = 0;
    (void)hipGetDevice(&dev);
    (void)hipDeviceGetAttribute(&cus, hipDeviceAttributeMultiprocessorCount, dev);
    (void)hipFuncSetAttribute((const void*)fwd_megakernel, hipFuncAttributeMaxDynamicSharedMemorySize, LDS_BYTES);
    (void)hipOccupancyMaxActiveBlocksPerMultiprocessor(&per_cu, fwd_megakernel, NTHR, LDS_BYTES);
    if (per_cu < 1) per_cu = 1;
    grid_blocks = cus * per_cu;
    if (grid_blocks > 256) grid_blocks = 256;
  }
  if (ws_size < WS_NEED) fprintf(stderr, "workspace too small: %zu < %zu\n", ws_size, (size_t)WS_NEED);
  (void)hipMemsetAsync((char*)d_ws + OFF_BAR, 0, 16384, stream);
  Params p{};
  for (int i = 0; i < 41; ++i) p.in[i] = (const float*)d_in[i];
  p.out = (float*)d_out;
  p.ws = (char*)d_ws;
  void* args[] = {&p};
  hipError_t e = hipLaunchCooperativeKernel((void*)fwd_megakernel, dim3(grid_blocks), dim3(NTHR), args, LDS_BYTES, stream);
  if (e != hipSuccess) fprintf(stderr, "cooperative launch failed: %s (grid %d)\n", hipGetErrorString(e), grid_blocks);
}
```

```cpp
#include <hip/hip_runtime.h>
#include <hip/hip_bf16.h>
#include <hip/hip_cooperative_groups.h>
#include <cstdio>
namespace cg = cooperative_groups;

typedef __hip_bfloat16 bf16;
typedef __attribute__((ext_vector_type(8))) short bf16x8;
typedef __attribute__((ext_vector_type(4))) float f32x4;
typedef __attribute__((ext_vector_type(2))) float f32x2;

constexpr int D = 1024, NTOK = 12288, NCTX = 4096, DEPTH = 4, FH = 2816;
constexpr int INC = 3264, INCP = 3328;
constexpr int C_HY = 1184, C_RW = 1952;
constexpr int NTHR = 512;

constexpr size_t al256(size_t x) { return (x + 255) & ~(size_t)255; }
constexpr size_t OFF_CNT = 0;
constexpr size_t OFF_BAR = 4096;
constexpr size_t OFF_MOD = 4096 + 16384;
constexpr size_t SZ_MOD = (size_t)DEPTH * 9 * 9216 * 4;
constexpr size_t OFF_FT = al256(OFF_MOD + SZ_MOD);
constexpr size_t FT_L0 = 511 * 256, FT_L1 = 2047 * 256;
constexpr size_t FT_LAYER = FT_L0 + FT_L1;
constexpr size_t OFF_X = al256(OFF_FT + DEPTH * FT_LAYER * 4);
constexpr size_t OFF_H = al256(OFF_X + (size_t)NTOK * D * 4);
constexpr size_t OFF_W1I = al256(OFF_H + (size_t)NTOK * D * 2);
constexpr size_t OFF_W1O = al256(OFF_W1I + (size_t)5632 * 1024 * 2);
constexpr size_t OFF_WMI = al256(OFF_W1O + (size_t)1024 * 2816 * 2);
constexpr size_t OFF_WMO = al256(OFF_WMI + (size_t)INCP * 1024 * 2);
constexpr size_t OFF_W2I = al256(OFF_WMO + (size_t)1024 * 1024 * 2);
constexpr size_t OFF_W2O = al256(OFF_W2I + (size_t)5632 * 1024 * 2);
constexpr size_t WSET = al256(OFF_W2O + (size_t)1024 * 2816 * 2) - OFF_W1I;
constexpr size_t OFF_P = OFF_W1I + 2 * WSET;
constexpr size_t SZ_P = (size_t)NTOK * INC * 4;
constexpr size_t SZ_GO = (size_t)2 * NTOK * 384 * 4;
constexpr size_t OFF_GO = OFF_P;
constexpr size_t OFF_RO = OFF_P + SZ_GO;
constexpr size_t OFF_REC = al256(OFF_P + SZ_P);
constexpr size_t SZ_REC = (size_t)NTOK * 6 * 512 * 4;
constexpr size_t OFF_HMID = OFF_REC;
constexpr size_t OFF_GREC = al256(OFF_REC + SZ_REC);
constexpr size_t SZ_GREC = (size_t)NTOK * 6 * 256 * 4;
constexpr size_t OFF_HYZ = al256(OFF_GREC + SZ_GREC);
constexpr size_t OFF_HYX = al256(OFF_HYZ + (size_t)NTOK * 256 * 4);
constexpr size_t OFF_HZB = al256(OFF_HYX + (size_t)NTOK * 256 * 4);
constexpr size_t OFF_FTB = al256(OFF_HZB + (size_t)NTOK * 256 * 2);
constexpr size_t WS_NEED = al256(OFF_FTB + DEPTH * FT_LAYER * 2);

struct Params {
  const float* in[41];
  float* out;
  char* ws;
};

enum { I_XP = 0, I_XS, I_SG, I_SR, I_C, I_CCTX, I_ADAW, I_ADAB, I_F1N, I_F1WI, I_F1WO, I_MN, I_MWI, I_MWO,
       I_GW2, I_GB, I_GN, I_HCW, I_HCB, I_HW1, I_HB1, I_HW2, I_HB2, I_HFQ, I_HW3, I_HBIAS,
       I_RMU, I_RW0, I_RW2, I_RA0, I_RA2, I_RG2, I_RKK, I_RKA, I_RRK, I_RLW, I_RLB, I_F2N, I_F2WI, I_F2WO, I_FN };

extern __shared__ __attribute__((aligned(16))) char smem[];
constexpr int LDS_BYTES = 147600;

__device__ __forceinline__ int otid() { int t = (int)__builtin_amdgcn_workitem_id_x(); asm volatile("" : "+v"(t)); return t; }
__device__ __forceinline__ int obid() { int b = (int)__builtin_amdgcn_workgroup_id_x(); asm volatile("" : "+s"(b)); return b; }
__device__ __forceinline__ unsigned short f2bf(float f) {
  unsigned u = __float_as_uint(f);
  u += 0x7fffu + ((u >> 16) & 1u);
  return (unsigned short)(u >> 16);
}
__device__ __forceinline__ float dpp_f(float x, const int ctrl_sel) {
  int xi = __float_as_int(x), r;
  if (ctrl_sel == 0) r = __builtin_amdgcn_update_dpp(0, xi, 0xB1, 0xF, 0xF, true);
  else if (ctrl_sel == 1) r = __builtin_amdgcn_update_dpp(0, xi, 0x4E, 0xF, 0xF, true);
  else if (ctrl_sel == 2) r = __builtin_amdgcn_update_dpp(0, xi, 0x141, 0xF, 0xF, true);
  else r = __builtin_amdgcn_update_dpp(0, xi, 0x140, 0xF, 0xF, true);
  return __int_as_float(r);
}
__device__ __forceinline__ float wave_sum(float v) {
  v += dpp_f(v, 0); v += dpp_f(v, 1); v += dpp_f(v, 2); v += dpp_f(v, 3);
  const int vi = __float_as_int(v);
  return __int_as_float(__builtin_amdgcn_readlane(vi, 0)) + __int_as_float(__builtin_amdgcn_readlane(vi, 16)) +
         __int_as_float(__builtin_amdgcn_readlane(vi, 32)) + __int_as_float(__builtin_amdgcn_readlane(vi, 48));
}
__device__ __forceinline__ float sigmoidf_(float x) { return __builtin_amdgcn_rcpf(1.f + __builtin_amdgcn_exp2f(x * -1.4426950408889634f)); }
__device__ __forceinline__ float siluf_(float x) { return x * sigmoidf_(x); }
__device__ __forceinline__ int modrow(int row) { return row < NCTX ? 0 : 1 + ((row - NCTX) >> 10); }

__device__ __forceinline__ void p0_copy_x(const Params& p) {
  float4* x = (float4*)(p.ws + OFF_X);
  const float4* a = (const float4*)p.in[I_XP];
  const float4* b = (const float4*)p.in[I_XS];
  const size_t n4 = (size_t)NTOK * D / 4, nc4 = (size_t)NCTX * D / 4;
  for (size_t i = (size_t)obid() * NTHR + otid(); i < n4; i += (size_t)gridDim.x * NTHR)
    x[i] = i < nc4 ? a[i] : b[i - nc4];
}

__device__ __forceinline__ void p0_mod(const Params& p) {
  float* scond = (float*)smem;
  float* red = (float*)(smem + 40960);
  for (int i = otid(); i < 9 * 1024; i += NTHR) {
    int r = i >> 10, d = i & 1023;
    float c = r == 0 ? p.in[I_CCTX][d] : p.in[I_C][(r - 1) * 1024 + d];
    scond[i] = siluf_(c);
  }
  __syncthreads();
  float* mod = (float*)(p.ws + OFF_MOD);
  const int col = otid() & 63, ks = otid() >> 6;
  for (int task = obid(); task < DEPTH * 144; task += gridDim.x) {
    int l = task / 144, cg_ = task % 144;
    const float* w = p.in[I_ADAW] + (size_t)l * 1024 * 9216 + cg_ * 64 + col;
    float acc[9];
#pragma unroll
    for (int r = 0; r < 9; ++r) acc[r] = 0.f;
    for (int d0 = ks * 128; d0 < ks * 128 + 128; d0 += 8) {
      float wv[8];
#pragma unroll
      for (int u = 0; u < 8; ++u) wv[u] = w[(size_t)(d0 + u) * 9216];
#pragma unroll
      for (int u = 0; u < 8; ++u)
#pragma unroll
        for (int r = 0; r < 9; ++r) acc[r] += scond[r * 1024 + d0 + u] * wv[u];
    }
#pragma unroll
    for (int r = 0; r < 9; ++r) red[(ks * 9 + r) * 64 + col] = acc[r];
    __syncthreads();
    for (int i = otid(); i < 576; i += NTHR) {
      int r = i >> 6, c = i & 63;
      float s = 0.f;
#pragma unroll
      for (int k = 0; k < 8; ++k) s += red[(k * 9 + r) * 64 + c];
      int j = cg_ * 64 + c;
      mod[((size_t)l * 9 + r) * 9216 + j] = s + p.in[I_ADAB][l * 9216 + j];
    }
    __syncthreads();
  }
}

__device__ __forceinline__ void p0_filters(const Params& p) {
  const int wave = otid() >> 6, lane = otid() & 63;
  float* FT = (float*)(p.ws + OFF_FT);
  for (int task = obid() * 8 + wave; task < DEPTH * 1280; task += gridDim.x * 8) {
    int l = task / 1280, rem = task % 1280;
    int sel = rem >= 256, i = sel ? rem - 256 : rem, L = sel ? 1024 : 256;
    float t = (float)i / (float)(L - 1);
    float w = 6.283185307179586f * (float)i / (float)L;
    float zval = 0.f;
    {
      const float fstep = (15.f - 1e-4f) / 15.f;
      if (lane == 0) zval = t;
      else if (lane <= 16) zval = cosf((1e-4f + (float)(lane - 1) * fstep) * w);
      else if (lane <= 32) zval = -sinf((1e-4f + (float)(lane - 17) * fstep) * w);
    }
    const float* w1 = p.in[I_HW1] + l * 33 * 64;
    const float* w2 = p.in[I_HW2] + l * 64 * 64;
    const float* w3 = p.in[I_HW3] + l * 64 * 512;
    const float* fq = p.in[I_HFQ] + l * 128;
    float h1 = p.in[I_HB1][l * 64 + lane];
    for (int e = 0; e < 33; ++e) h1 += __shfl(zval, e) * w1[e * 64 + lane];
    h1 = sinf(fq[lane] * h1);
    float h2 = p.in[I_HB2][l * 64 + lane];
    for (int e = 0; e < 64; ++e) h2 += __shfl(h1, e) * w2[e * 64 + lane];
    h2 = sinf(fq[64 + lane] * h2);
    float acc[8];
#pragma unroll
    for (int m = 0; m < 8; ++m) acc[m] = 0.f;
    for (int e = 0; e < 64; ++e) {
      float hv = __shfl(h2, e);
#pragma unroll
      for (int m = 0; m < 8; ++m) acc[m] += hv * w3[e * 512 + m * 64 + lane];
    }
    float* ft = FT + (size_t)l * FT_LAYER + (sel ? FT_L0 : 0);
    const float a0 = -3.0701134573253945f, a1 = -15.350567286626973f;
#pragma unroll
    for (int m = 0; m < 8; ++m) {
      int cp = m * 64 + lane, c = cp & 255;
      float delta = fabsf(a0 + (float)c * ((a1 - a0) / 255.f));
      float val = acc[m] * expf(-t * delta);
      unsigned short* ftb = (unsigned short*)(p.ws + OFF_FTB) + (size_t)l * FT_LAYER + (sel ? FT_L0 : 0);
      if (cp < 256) { ft[(size_t)(L - 1 + i) * 256 + c] = val; ftb[(size_t)(L - 1 + i) * 256 + c] = f2bf(val); }
      else if (i >= 1) { ft[(size_t)(L - 1 - i) * 256 + c] = val; ftb[(size_t)(L - 1 - i) * 256 + c] = f2bf(val); }
    }
  }
}

__device__ __forceinline__ void conv_tile(const float* src, int srcN, int k0, int srccol0, bool zero, bf16* dst, int dstK, int n0) {
  float* tile = (float*)smem;
  const int tid = otid();
  {
    int r = tid >> 4, c4 = (tid & 15) * 4;
#pragma unroll
    for (int rr = 0; rr < 2; ++rr) {
      int row = r + rr * 32;
      float4 v = zero ? make_float4(0.f, 0.f, 0.f, 0.f)
                      : *(const float4*)(src + (size_t)(k0 + row) * srcN + srccol0 + c4);
      tile[row * 65 + c4 + 0] = v.x; tile[row * 65 + c4 + 1] = v.y;
      tile[row * 65 + c4 + 2] = v.z; tile[row * 65 + c4 + 3] = v.w;
    }
  }
  __syncthreads();
  {
    int nn = tid >> 3, ks = (tid & 7) * 8;
    unsigned short v[8];
#pragma unroll
    for (int j = 0; j < 8; ++j) v[j] = f2bf(tile[(ks + j) * 65 + nn]);
    uint4 o;
    o.x = v[0] | ((unsigned)v[1] << 16); o.y = v[2] | ((unsigned)v[3] << 16);
    o.z = v[4] | ((unsigned)v[5] << 16); o.w = v[6] | ((unsigned)v[7] << 16);
    *(uint4*)(dst + (size_t)(n0 + nn) * dstK + k0 + ks) = o;
  }
  __syncthreads();
}

__device__ __forceinline__ unsigned cvt_pk_bf16_(float lo, float hi) { unsigned r; asm volatile("v_cvt_pk_bf16_f32 %0, %1, %2" : "=v"(r) : "v"(lo), "v"(hi)); return r; }
struct WTile { const float* src; int srcN, k0, srccol, dstK, n0; bool zero; size_t dstoff; };
__device__ __forceinline__ WTile wtile_decode(const Params& p, int l, int u) {
  WTile w;
  w.zero = false;
  if (u < 1408 || (u >= 3200 && u < 4608)) {
    const bool second = u >= 3200;
    if (second) u -= 3200;
    w.src = p.in[second ? I_F2WI : I_F1WI] + (size_t)l * 1024 * 5632;
    w.dstoff = second ? OFF_W2I : OFF_W1I;
    const int tn = u % 88, tk = u / 88;
    const int n0 = tn * 64, pn = n0 >> 8, within = n0 & 255;
    w.srccol = within < 128 ? pn * 128 + within : 2816 + pn * 128 + (within - 128);
    w.srcN = 5632; w.k0 = tk * 64; w.dstK = 1024; w.n0 = n0;
  } else if ((u >= 1408 && u < 2112) || u >= 4608) {
    const bool second = u >= 4608;
    u -= second ? 4608 : 1408;
    w.src = p.in[second ? I_F2WO : I_F1WO] + (size_t)l * 2816 * 1024;
    w.dstoff = second ? OFF_W2O : OFF_W1O;
    const int tn = u % 16, tk = u / 16;
    w.srcN = 1024; w.k0 = tk * 64; w.srccol = tn * 64; w.dstK = 2816; w.n0 = tn * 64;
  } else if (u < 2944) {
    u -= 2112;
    w.src = p.in[I_MWI] + (size_t)l * 1024 * INC;
    w.dstoff = OFF_WMI;
    const int tn = u % 52, tk = u / 52;
    w.srcN = INC; w.k0 = tk * 64; w.srccol = tn * 64; w.dstK = 1024; w.n0 = tn * 64; w.zero = tn == 51;
  } else {
    u -= 2944;
    w.src = p.in[I_MWO] + (size_t)l * 1024 * 1024;
    w.dstoff = OFF_WMO;
    const int tn = u % 16, tk = u / 16;
    w.srcN = 1024; w.k0 = tk * 64; w.srccol = tn * 64; w.dstK = 1024; w.n0 = tn * 64;
  }
  return w;
}
__device__ __forceinline__ void phase_wconv(const Params& p, int l, int set) {
  for (int t = obid(); t < 5312; t += gridDim.x) {
    const WTile w = wtile_decode(p, l, t);
    conv_tile(w.src, w.srcN, w.k0, w.srccol, w.zero, (bf16*)(p.ws + w.dstoff + (size_t)set * WSET), w.dstK, w.n0);
  }
}
__device__ __forceinline__ void wconv_wave(const Params& p, int l, int set, int u) {
  const int lane = otid() & 63;
  const WTile w = wtile_decode(p, l, u);
  unsigned pk[32];
  if (!w.zero) {
    const float* s = w.src + (size_t)w.k0 * w.srcN + w.srccol + lane;
#pragma unroll
    for (int kk = 0; kk < 64; kk += 2) pk[kk >> 1] = cvt_pk_bf16_(s[(size_t)kk * w.srcN], s[(size_t)(kk + 1) * w.srcN]);
  } else {
#pragma unroll
    for (int i = 0; i < 32; ++i) pk[i] = 0u;
  }
  uint4* d = (uint4*)((unsigned short*)(p.ws + w.dstoff + (size_t)set * WSET) + (size_t)(w.n0 + lane) * w.dstK + w.k0);
#pragma unroll
  for (int i = 0; i < 8; ++i) d[i] = make_uint4(pk[4 * i], pk[4 * i + 1], pk[4 * i + 2], pk[4 * i + 3]);
}

template <bool FIRST>
__device__ __forceinline__ void phase_norm(const Params& p, const float* gain, const float* modl, int shi, int sci) {
  const int wave = otid() >> 6, lane = otid() & 63;
  const float* x = (const float*)(p.ws + OFF_X);
  bf16* h = (bf16*)(p.ws + OFF_H);
  const int nw = gridDim.x * 8;
  float4 g4[4];
#pragma unroll
  for (int i = 0; i < 4; ++i) g4[i] = ((const float4*)gain)[i * 64 + lane];
  constexpr int NR = 3;
  for (int row0 = obid() * 8 + wave; row0 < NTOK; row0 += NR * nw) {
    float4 v[NR][4], sc[NR][4], sh[NR][4];
    int rows[NR];
#pragma unroll
    for (int q = 0; q < NR; ++q) {
      const int row = (row0 + q * nw < NTOK) ? row0 + q * nw : row0;
      rows[q] = row;
      const float4* xr = FIRST ? (const float4*)(row < NCTX ? p.in[I_XP] + (size_t)row * D : p.in[I_XS] + (size_t)(row - NCTX) * D)
                               : (const float4*)(x + (size_t)row * D);
      const float* mr = modl + (size_t)modrow(row) * 9216;
#pragma unroll
      for (int i = 0; i < 4; ++i) {
        v[q][i] = xr[i * 64 + lane];
        sc[q][i] = ((const float4*)(mr + sci * 1024))[i * 64 + lane];
        sh[q][i] = ((const float4*)(mr + shi * 1024))[i * 64 + lane];
      }
    }
    __builtin_amdgcn_sched_barrier(0);
#pragma unroll
    for (int q = 0; q < NR; ++q) {
      if (q >= 1 && row0 + q * nw >= NTOK) break;
      float ss = 0.f;
#pragma unroll
      for (int i = 0; i < 4; ++i) ss += v[q][i].x * v[q][i].x + v[q][i].y * v[q][i].y + v[q][i].z * v[q][i].z + v[q][i].w * v[q][i].w;
      ss = wave_sum(ss);
      const float rstd = rsqrtf(ss * (1.f / 1024.f) + 1e-6f);
      if (FIRST) {
#pragma unroll
        for (int i = 0; i < 4; ++i) ((float4*)(p.ws + OFF_X + (size_t)rows[q] * D * 4))[i * 64 + lane] = v[q][i];
      }
#pragma unroll
      for (int i = 0; i < 4; ++i) {
        const float4 g = g4[i], s = sc[q][i], bq = sh[q][i];
        float y0 = v[q][i].x * rstd * g.x * (1.f + s.x) + bq.x;
        float y1 = v[q][i].y * rstd * g.y * (1.f + s.y) + bq.y;
        float y2 = v[q][i].z * rstd * g.z * (1.f + s.z) + bq.z;
        float y3 = v[q][i].w * rstd * g.w * (1.f + s.w) + bq.w;
        uint2 o;
        o.x = f2bf(y0) | ((unsigned)f2bf(y1) << 16);
        o.y = f2bf(y2) | ((unsigned)f2bf(y3) << 16);
        *(uint2*)(h + (size_t)rows[q] * D + (i * 64 + lane) * 4) = o;
      }
    }
  }
}

__device__ __forceinline__ void phase_final_norm(const Params& p) {
  const int wave = otid() >> 6, lane = otid() & 63;
  const float* x = (const float*)(p.ws + OFF_X);
  const float4* g4 = (const float4*)p.in[I_FN];
  for (int row = obid() * 8 + wave; row < NTOK; row += gridDim.x * 8) {
    const float4* xr = (const float4*)(x + (size_t)row * D);
    float4 v[4];
    float ss = 0.f;
#pragma unroll
    for (int i = 0; i < 4; ++i) {
      v[i] = xr[i * 64 + lane];
      ss += v[i].x * v[i].x + v[i].y * v[i].y + v[i].z * v[i].z + v[i].w * v[i].w;
    }
    ss = wave_sum(ss);
    float rstd = rsqrtf(ss * (1.f / 1024.f) + 1e-6f);
    float4* o = (float4*)(p.out + (size_t)row * D);
#pragma unroll
    for (int i = 0; i < 4; ++i) {
      float4 g = g4[i * 64 + lane];
      o[i * 64 + lane] = make_float4(v[i].x * rstd * g.x, v[i].y * rstd * g.y, v[i].z * rstd * g.z, v[i].w * rstd * g.w);
    }
  }
}

namespace pg8 {
#define PG8_LAS __attribute__((address_space(3)))
typedef unsigned short bf16_t;
typedef short bf16x8 __attribute__((ext_vector_type(8)));
typedef float f32x4 __attribute__((ext_vector_type(4)));
typedef unsigned u32x4 __attribute__((ext_vector_type(4)));
constexpr int BM = 256, BK = 64, HALF = 128, HTB = HALF * BK * 2  , STAGE_BYTES = 8 * HTB, NXCD = 8, WGM = 8;

__host__ __device__ __forceinline__ int lds_byte(int r, int c) { const int st = (r >> 4) * 2 + (c >> 5), rr = r & 15, cc = c & 31, ob = rr * 64 + cc * 2; return st * 1024 + (ob ^ (((ob >> 9) & 1) << 5)); }
__host__ __device__ __forceinline__ void stage_rc(int b, int& R, int& C) { const int st = b / 1024, sb = b % 1024, swz = sb ^ (((sb >> 9) & 1) << 5); R = (st >> 1) * 16 + swz / 64; C = (st & 1) * 32 + (swz % 64) / 2; }
__host__ __device__ __forceinline__ int perm32(int rho) { const int n = rho >> 4, i = rho & 15; return 8 * (i >> 2) + 4 * n + (i & 3); }

struct Unit { int pm, pn; };
struct Gemm { const bf16_t* A; const bf16_t* Bt; int M, N, K; };

struct StaticOrder {
    int nM, nN, nwg, G, c;
    __host__ __device__ void init(int M, int N, int G_, int c_) { nM = M / BM; nN = N / BM; nwg = nM * nN; G = G_; c = c_; }
    __host__ __device__ bool next(int i, Unit& u) const {
        const long L = (long)i * G + c; if (L >= nwg) return false;
        int wgid = (int)L; { const int q = nwg / NXCD, r = nwg % NXCD, xcd = wgid % NXCD, off = wgid / NXCD; wgid = (xcd < r ? xcd * (q + 1) : r * (q + 1) + (xcd - r) * q) + off; }
        const int nig = WGM * nN, gid = wgid / nig, fm = gid * WGM, gsz = (nM - fm) < WGM ? (nM - fm) : WGM;
        u.pm = fm + ((wgid % nig) % gsz); u.pn = (wgid % nig) / gsz; return true;
    }
    __device__ __forceinline__ void a_ready(const Unit&) const {}
    __device__ __forceinline__ void done(const Unit&) const {}
};
__device__ __forceinline__ unsigned cvt_pk_bf16(float lo, float hi) { unsigned r; asm volatile("v_cvt_pk_bf16_f32 %0, %1, %2" : "=v"(r) : "v"(lo), "v"(hi)); return r; }

template <class Epi, class Sched, bool STAMP = false>
__device__ __forceinline__ void gemm_phase(PG8_LAS unsigned char* lds, const Gemm g, const Sched& S, const Epi& E, unsigned long long* stamps) {
    const int tid = otid(), wid = __builtin_amdgcn_readfirstlane(tid >> 6), lane = tid & 63, wr = wid >> 2, wc = wid & 3, fr = lane & 15, fq = lane >> 4;
    const int K = g.K, nt = K / BK;
    int ts_lo = 0, ts_hi = 0, nts = 0; const unsigned long long rt_entry = STAMP ? (unsigned long long)wall_clock64() : 0ull;
#define PG8_STAMP() do { if (STAMP && wid == 0 && nts < 64) { const unsigned long long _c = (unsigned long long)clock64(); \
        ts_lo = (lane == nts) ? (int)(unsigned)_c : ts_lo; ts_hi = (lane == nts) ? (int)(unsigned)(_c >> 32) : ts_hi; ++nts; } } while (0)
    PG8_STAMP();
    unsigned voffA[2], voffB[2];
#pragma unroll
    for (int i = 0; i < 2; ++i) { int R, C; stage_rc(tid * 16 + i * 8192, R, C); const int Rb = Epi::PERM ? ((R & ~31) + perm32(R & 31)) : R;
        voffA[i] = (unsigned)(R * K + C) * 2u; voffB[i] = (unsigned)(Rb * K + C) * 2u; }
    const size_t kstep = (size_t)(BK * 2);
    const size_t hstep = (size_t)HALF * K * 2;
    const size_t tstep = 2 * hstep;
    const unsigned ldsw = (unsigned)wid * 1024u;
    const int aoff = lds_byte(wr * 64 + fr, fq * 8), boff = lds_byte(wc * 32 + fr, fq * 8);
#define PG8_SA(b, h) (((b) * 2 + (h)) * HTB)
#define PG8_SB(b, h) ((4 + (b) * 2 + (h)) * HTB)
#define PG8_STAGE(bufoff, gbase, voff) do { _Pragma("unroll") for (int _i = 0; _i < 2; ++_i) \
        __builtin_amdgcn_global_load_lds((const unsigned*)((const char*)(gbase) + (voff)[_i]), (PG8_LAS unsigned*)(lds + (bufoff) + ldsw + _i * 8192), 16, 0, 0); } while (0)
#define PG8_LDA(dst, b, h) do { _Pragma("unroll") for (int m = 0; m < 4; ++m) _Pragma("unroll") for (int k = 0; k < 2; ++k) dst[m][k] = *(const PG8_LAS bf16x8*)(lds + PG8_SA(b, h) + aoff + m * 2048 + k * 1024); } while (0)
#define PG8_LDB(dst, b, h) do { _Pragma("unroll") for (int n = 0; n < 2; ++n) _Pragma("unroll") for (int k = 0; k < 2; ++k) dst[n][k] = *(const PG8_LAS bf16x8*)(lds + PG8_SB(b, h) + boff + n * 2048 + k * 1024); } while (0)
#define PG8_MMA(ai, bj, At, Bt) do { __builtin_amdgcn_s_setprio(1); _Pragma("unroll") for (int m = 0; m < 4; ++m) _Pragma("unroll") for (int n = 0; n < 2; ++n) _Pragma("unroll") for (int k = 0; k < 2; ++k) \
        acc[ai][bj][m][n] = __builtin_amdgcn_mfma_f32_16x16x32_bf16(Bt[n][k], At[m][k], acc[ai][bj][m][n], 0, 0, 0); __builtin_amdgcn_s_setprio(0); } while (0)
#define PG8_WAIT_V(n) asm volatile("s_waitcnt vmcnt(" #n ")" ::: "memory")
#define PG8_WAIT_L(n) asm volatile("s_waitcnt lgkmcnt(" #n ")" ::: "memory")
#define PG8_BAR __builtin_amdgcn_s_barrier()
#define PG8_SCHED __builtin_amdgcn_sched_barrier(0)
    Unit cur, nxt; int ui = 0;
    if (!S.next(0, cur)) return;
    f32x4 acc[2][2][4][2];
#pragma unroll
    for (int a = 0; a < 2; ++a)
#pragma unroll
        for (int b = 0; b < 2; ++b)
#pragma unroll
            for (int m = 0; m < 4; ++m)
#pragma unroll
                for (int n = 0; n < 2; ++n) acc[a][b][m][n] = (f32x4){0.f, 0.f, 0.f, 0.f};
    bf16x8 At[4][2], B0[2][2], B1[2][2];
    const char* cA = (const char*)g.A + (size_t)cur.pm * tstep; const char* cB = (const char*)g.Bt + (size_t)cur.pn * tstep;
    S.a_ready(cur);
    PG8_STAGE(PG8_SB(0, 0), cB, voffB); PG8_STAGE(PG8_SA(0, 0), cA, voffA); PG8_STAGE(PG8_SB(0, 1), cB + hstep, voffB); PG8_STAGE(PG8_SA(0, 1), cA + hstep, voffA);
    if (wr == 1) PG8_BAR;
    PG8_WAIT_V(4); PG8_BAR;
    PG8_STAGE(PG8_SB(1, 0), cB + kstep, voffB); PG8_STAGE(PG8_SA(1, 0), cA + kstep, voffA); PG8_STAGE(PG8_SB(1, 1), cB + hstep + kstep, voffB);
    PG8_WAIT_V(6); PG8_BAR;
    PG8_STAMP();
    for (;;) {
        const bool has_next = S.next(ui + 1, nxt);
        const char* nA = has_next ? (const char*)g.A + (size_t)nxt.pm * tstep : cA; const char* nB = has_next ? (const char*)g.Bt + (size_t)nxt.pn * tstep : cB;
        for (int t = 0; t < nt; t += 2) {
            const bool last = (t == nt - 2);
            const char* a1 = cA + (size_t)(t + 1) * kstep;
            const char* a2 = last ? nA : cA + (size_t)(t + 2) * kstep; const char* b2 = last ? nB : cB + (size_t)(t + 2) * kstep;
            const char* a3 = a2 + kstep; const char* b3 = b2 + kstep;
            if (last && has_next) S.a_ready(nxt);
            PG8_LDB(B0, 0, 0); PG8_SCHED; PG8_LDA(At, 0, 0); PG8_STAGE(PG8_SA(1, 1), a1 + hstep, voffA);
            PG8_WAIT_L(8); PG8_BAR; PG8_WAIT_L(0); PG8_MMA(0, 0, At, B0); PG8_BAR; PG8_SCHED;
            PG8_LDB(B1, 0, 1); PG8_STAGE(PG8_SB(0, 0), b2, voffB);
            PG8_BAR; PG8_WAIT_L(0); PG8_MMA(0, 1, At, B1); PG8_BAR;
            PG8_LDA(At, 0, 1); PG8_STAGE(PG8_SA(0, 0), a2, voffA);
            PG8_BAR; PG8_WAIT_L(0); PG8_MMA(1, 0, At, B0); PG8_BAR; PG8_SCHED;
            PG8_STAGE(PG8_SB(0, 1), b2 + hstep, voffB);
            PG8_WAIT_V(6); PG8_BAR; PG8_MMA(1, 1, At, B1); PG8_BAR;
            PG8_LDB(B0, 1, 0); PG8_SCHED; PG8_LDA(At, 1, 0); PG8_STAGE(PG8_SA(0, 1), a2 + hstep, voffA);
            PG8_WAIT_L(8); PG8_BAR; PG8_WAIT_L(0); PG8_MMA(0, 0, At, B0); PG8_BAR; PG8_SCHED;
            PG8_LDB(B1, 1, 1); PG8_STAGE(PG8_SB(1, 0), b3, voffB);
            PG8_BAR; PG8_WAIT_L(0); PG8_MMA(0, 1, At, B1); PG8_BAR;
            PG8_LDA(At, 1, 1); PG8_STAGE(PG8_SA(1, 0), a3, voffA);
            PG8_BAR; PG8_WAIT_L(0); PG8_MMA(1, 0, At, B0); PG8_BAR; PG8_SCHED;
            PG8_STAGE(PG8_SB(1, 1), b3 + hstep, voffB);
            PG8_WAIT_V(6); PG8_BAR; PG8_MMA(1, 1, At, B1); PG8_BAR;
        }
        PG8_STAMP();
        if constexpr (!Epi::AFTER_DRAIN) { E(acc, cur, wr, wc, fr, fq); S.done(cur); }
        PG8_STAMP();
        if (!has_next) break;
#pragma unroll
        for (int a = 0; a < 2; ++a)
#pragma unroll
            for (int b = 0; b < 2; ++b)
#pragma unroll
                for (int m = 0; m < 4; ++m)
#pragma unroll
                    for (int n = 0; n < 2; ++n) acc[a][b][m][n] = (f32x4){0.f, 0.f, 0.f, 0.f};
        cur = nxt; cA = nA; cB = nB; ++ui;
    }
    PG8_WAIT_V(0);
    if (wr == 0) PG8_BAR;
    PG8_BAR;
    if constexpr (Epi::AFTER_DRAIN) { E.fused(acc, cur, wr, wc, fr, fq, lds, wid, lane); S.done(cur); }
    PG8_STAMP();
    if (STAMP && wid == 0) { stamps[lane] = lane < nts ? (((unsigned long long)(unsigned)ts_hi << 32) | (unsigned)ts_lo) : 0ull;
        if (lane == 62) stamps[62] = rt_entry; if (lane == 63) stamps[63] = (unsigned long long)wall_clock64(); }
#undef PG8_STAMP
#undef PG8_SA
#undef PG8_SB
#undef PG8_STAGE
#undef PG8_LDA
#undef PG8_LDB
#undef PG8_MMA
#undef PG8_WAIT_V
#undef PG8_WAIT_L
#undef PG8_BAR
#undef PG8_SCHED
}
}

struct EpiSwiglu {
  static constexpr bool PERM = true, AFTER_DRAIN = false;
  unsigned short* H;
  __device__ __forceinline__ void operator()(const pg8::f32x4 (&acc)[2][2][4][2], const pg8::Unit& u, int wr, int wc, int fr, int fq) const {
    const int row0 = u.pm * 256 + wr * 64 + fr, hc0 = u.pn * 128 + wc * 32 + 8 * fq;
#pragma unroll
    for (int ai = 0; ai < 2; ++ai)
#pragma unroll
      for (int m = 0; m < 4; ++m) {
        unsigned short* rowp = H + (size_t)(row0 + ai * 128 + m * 16) * FH + hc0;
        float v[8];
#pragma unroll
        for (int n = 0; n < 2; ++n)
#pragma unroll
          for (int i = 0; i < 4; ++i) v[n * 4 + i] = siluf_(acc[ai][0][m][n][i]) * acc[ai][1][m][n][i];
        pg8::u32x4 o;
        o[0] = pg8::cvt_pk_bf16(v[0], v[1]); o[1] = pg8::cvt_pk_bf16(v[2], v[3]);
        o[2] = pg8::cvt_pk_bf16(v[4], v[5]); o[3] = pg8::cvt_pk_bf16(v[6], v[7]);
        *(pg8::u32x4*)rowp = o;
      }
  }
};
struct EpiResid {
  static constexpr bool PERM = false, AFTER_DRAIN = false;
  float* X; const float* modl; int gidx; float scale;
  __device__ __forceinline__ void operator()(const pg8::f32x4 (&acc)[2][2][4][2], const pg8::Unit& u, int wr, int wc, int fr, int fq) const {
    const int row0 = u.pm * 256 + wr * 64 + fr, col0 = u.pn * 256 + wc * 32 + 4 * fq;
#pragma unroll
    for (int ai = 0; ai < 2; ++ai)
#pragma unroll
      for (int m = 0; m < 4; ++m) {
        const int row = row0 + ai * 128 + m * 16;
        const float* gt = modl + (size_t)modrow(row) * 9216 + gidx * 1024 + col0;
        float* xp = X + (size_t)row * D + col0;
        pg8::f32x4 gv[2][2], xv[2][2];
#pragma unroll
        for (int bj = 0; bj < 2; ++bj)
#pragma unroll
          for (int n = 0; n < 2; ++n) {
            gv[bj][n] = *(const pg8::f32x4*)(gt + bj * 128 + n * 16);
            xv[bj][n] = *(const pg8::f32x4*)(xp + bj * 128 + n * 16);
          }
#pragma unroll
        for (int bj = 0; bj < 2; ++bj)
#pragma unroll
          for (int n = 0; n < 2; ++n) *(pg8::f32x4*)(xp + bj * 128 + n * 16) = xv[bj][n] + (gv[bj][n] * scale) * acc[ai][bj][m][n];
      }
  }
};
struct EpiP {
  static constexpr bool PERM = false, AFTER_DRAIN = false;
  float* P;
  __device__ __forceinline__ void operator()(const pg8::f32x4 (&acc)[2][2][4][2], const pg8::Unit& u, int wr, int wc, int fr, int fq) const {
    const int row0 = u.pm * 256 + wr * 64 + fr, col0 = u.pn * 256 + wc * 32 + 4 * fq;
#pragma unroll
    for (int ai = 0; ai < 2; ++ai)
#pragma unroll
      for (int m = 0; m < 4; ++m) {
        float* rp = P + (size_t)(row0 + ai * 128 + m * 16) * INC;
#pragma unroll
        for (int bj = 0; bj < 2; ++bj)
#pragma unroll
          for (int n = 0; n < 2; ++n) {
            const int col = col0 + bj * 128 + n * 16;
            if (col < INC) *(pg8::f32x4*)(rp + col) = acc[ai][bj][m][n];
          }
      }
  }
};

template <class Epi>
__device__ __forceinline__ void phase_gemm(const void* A, const void* Bt, int N, int K, const Epi& E) {
  pg8::Gemm g; g.A = (const pg8::bf16_t*)A; g.Bt = (const pg8::bf16_t*)Bt; g.M = NTOK; g.N = N; g.K = K;
  int c_ = obid(), G_ = (int)gridDim.x;
  asm volatile("" : "+s"(c_), "+s"(G_));
  pg8::StaticOrder S; S.init(NTOK, N, G_, c_);
  pg8::gemm_phase<Epi, pg8::StaticOrder, false>((PG8_LAS unsigned char*)smem, g, S, E, nullptr);
  __syncthreads();
}

__device__ __forceinline__ int scan2tok(int R) {
  if (R < NCTX) return R;
  int q = R - NCTX, b = q >> 10, n = q & 1023;
  return NCTX + b * 1024 + (n & 15) * 64 + (n >> 4);
}

__device__ __forceinline__ float rw_shift(const float* P, int R, int n, int L, int c, float mu) {
  float pc = P[(size_t)scan2tok(R) * INC + C_RW + c];
  float pp = n > 0 ? P[(size_t)scan2tok(R - 1) * INC + C_RW + c] : 0.f;
  float pn = n < L - 1 ? P[(size_t)scan2tok(R + 1) * INC + C_RW + c] : 0.f;
  return pc + (0.5f * (pp + pn) - pc) * mu;
}

__device__ __forceinline__ float rdlane(float v, int l) { return __int_as_float(__builtin_amdgcn_readlane(__float_as_int(v), l)); }

__device__ __forceinline__ void prep_rwkv(const Params& p, int l) {
  const int wave = otid() >> 6, lane = otid() & 63;
  const float* P = (const float*)(p.ws + OFF_P);
  float* rec = (float*)(p.ws + OFF_REC);
  const float* mu = p.in[I_RMU] + l * 1312;
  const float* w0 = p.in[I_RW0] + l * 768;
  const float* w2 = p.in[I_RW2] + (size_t)l * 64 * 384;
  const float* a0 = p.in[I_RA0] + l * 384;
  const float* a2 = p.in[I_RA2] + (size_t)l * 32 * 384;
  const float* g2 = p.in[I_RG2] + (size_t)l * 64 * 384;
  const float* kkw = p.in[I_RKK] + l * 384;
  const float* kaw = p.in[I_RKA] + l * 384;
  float* wl = (float*)smem;
#pragma unroll 1
  for (int hp = 0; hp < 2; ++hp) {
    const int hb = hp * 3;
    __syncthreads();
    for (int i = otid(); i < 160 * 48; i += NTHR) {
      const int r = i / 48, c4 = (i % 48) * 4;
      const float* src = (r < 64 ? w2 + r * 384 : (r < 96 ? a2 + (r - 64) * 384 : g2 + (r - 96) * 384)) + hb * 64 + c4;
      *(float4*)(wl + r * 192 + c4) = *(const float4*)src;
    }
    __syncthreads();
    for (int task = obid() * 8 + wave; task < NTOK / 6; task += gridDim.x * 8) {
      const int R0 = task * 6;
      int nn[6], LL[6];
#pragma unroll
      for (int tp = 0; tp < 6; ++tp) {
        const int R = R0 + tp;
        if (R < NCTX) { nn[tp] = R & 255; LL[tp] = 256; } else { nn[tp] = (R - NCTX) & 1023; LL[tp] = 1024; }
      }
      float x0[6], x1[6], x2[6];
#pragma unroll
      for (int tp = 0; tp < 6; ++tp) {
        x0[tp] = rw_shift(P, R0 + tp, nn[tp], LL[tp], 1152 + lane, mu[1152 + lane]);
        x1[tp] = rw_shift(P, R0 + tp, nn[tp], LL[tp], 1216 + lane, mu[1216 + lane]);
        const int c2 = 1280 + (lane & 31);
        x2[tp] = rw_shift(P, R0 + tp, nn[tp], LL[tp], c2, mu[c2]);
        if (tp & 1) __builtin_amdgcn_sched_barrier(0);
      }
      float kx[3][6];
#pragma unroll
      for (int h = 0; h < 3; ++h) {
        const int c = (hb + h) * 64 + lane;
#pragma unroll
        for (int tp = 0; tp < 6; ++tp) {
          kx[h][tp] = rw_shift(P, R0 + tp, nn[tp], LL[tp], 384 + c, mu[384 + c]);
        }
      }
#pragma unroll
      for (int tp = 0; tp < 6; ++tp) {
        x0[tp] = tanhf(x0[tp]);
        x1[tp] = lane < 32 ? x1[tp] : sigmoidf_(x1[tp]);
        x2[tp] = sigmoidf_(x2[tp]);
      }
      float af[3][6], ab[3][6], aa[3][6], ag[3][6];
#pragma unroll
      for (int h = 0; h < 3; ++h)
#pragma unroll
        for (int tp = 0; tp < 6; ++tp) { af[h][tp] = 0.f; ab[h][tp] = 0.f; aa[h][tp] = 0.f; ag[h][tp] = 0.f; }
      const float* wlp = wl + lane;
      for (int j = 0; j < 32; ++j) {
        float wc[15];
#pragma unroll
        for (int h = 0; h < 3; ++h) {
          wc[h] = wlp[j * 192 + h * 64]; wc[3 + h] = wlp[(32 + j) * 192 + h * 64];
          wc[6 + h] = wlp[(64 + j) * 192 + h * 64]; wc[9 + h] = wlp[(96 + j) * 192 + h * 64]; wc[12 + h] = wlp[(128 + j) * 192 + h * 64];
        }
#pragma unroll
        for (int tp = 0; tp < 6; ++tp) {
          const float sf = rdlane(x0[tp], j), sb = rdlane(x0[tp], 32 + j), sA = rdlane(x1[tp], j), sg = rdlane(x1[tp], 32 + j), sh = rdlane(x2[tp], j);
#pragma unroll
          for (int h = 0; h < 3; ++h) {
            af[h][tp] += sf * wc[h]; ab[h][tp] += sb * wc[3 + h]; aa[h][tp] += sA * wc[6 + h];
            ag[h][tp] += sg * wc[9 + h]; ag[h][tp] += sh * wc[12 + h];
          }
        }
      }
      int R0e = R0;
      asm volatile("" : "+v"(R0e));
#pragma unroll
      for (int h = 0; h < 3; ++h) {
        const int c = (hb + h) * 64 + lane;
#pragma unroll
        for (int tp = 0; tp < 6; ++tp) {
          const int R = R0e + tp;
          const float kxv = kx[h][tp];
          const float aav = aa[h][tp], afv = af[h][tp], abv = ab[h][tp], agv = ag[h][tp];
          float a = sigmoidf_(a0[c] + aav);
          float kk = kxv * kkw[c];
          float ss = wave_sum(kk * kk);
          kk = kk * rsqrtf(fmaxf(ss, 1e-24f));
          float k2 = kxv * (1.f + (a - 1.f) * kaw[c]);
          float uf = w0[c] + afv, ub = w0[384 + c] + abv;
          float df = expf(-0.6065306597126334f * sigmoidf_(uf));
          float db = expf(-0.6065306597126334f * sigmoidf_(ub));
          const float r_ = rw_shift(P, R, nn[tp], LL[tp], c, mu[c]);
          const float v_ = rw_shift(P, R, nn[tp], LL[tp], 768 + c, mu[768 + c]);
          float* o = rec + ((size_t)R * 6 + hb + h) * 512 + lane;
          o[0] = r_; o[128] = v_;
          o[64] = k2; o[192] = -kk; o[256] = kk * a; o[320] = df; o[384] = db; o[448] = agv;
        }
      }
    }
  }
  __syncthreads();
}

__device__ __forceinline__ float logsigmoidf_(float x) { return fminf(x, 0.f) - log1pf(expf(-fabsf(x))); }

__device__ __forceinline__ void prep_gla(const Params& p, int l) {
  const int wave = otid() >> 6, lane = otid() & 63;
  const float* P = (const float*)(p.ws + OFF_P);
  float* grec = (float*)(p.ws + OFF_GREC);
  const float* w2 = p.in[I_GW2] + (size_t)l * 2 * 16 * 192;
  const float* ab = p.in[I_GB] + l * 384;
  const int z = lane >> 5, d = lane & 31;
  float wreg[6][16], breg[6];
#pragma unroll
  for (int h = 0; h < 6; ++h) {
    breg[h] = ab[z * 192 + h * 32 + d];
#pragma unroll
    for (int r = 0; r < 16; ++r) wreg[h][r] = w2[(z * 16 + r) * 192 + h * 32 + d];
  }
  for (int tok = obid() * 8 + wave; tok < NTOK; tok += gridDim.x * 8) {
    const float* pr = P + (size_t)tok * INC;
    float lr[16];
#pragma unroll
    for (int r4 = 0; r4 < 4; ++r4) {
      float4 v = *(const float4*)(pr + 1152 + z * 16 + r4 * 4);
      lr[r4 * 4 + 0] = v.x; lr[r4 * 4 + 1] = v.y; lr[r4 * 4 + 2] = v.z; lr[r4 * 4 + 3] = v.w;
    }
    float qk[6], vv[6], gg[6];
#pragma unroll
    for (int h = 0; h < 6; ++h) {
      qk[h] = lane < 32 ? pr[h * 32 + lane] : pr[192 + h * 32 + (lane - 32)];
      vv[h] = pr[384 + h * 64 + lane];
      gg[h] = pr[768 + h * 64 + lane];
    }
    __builtin_amdgcn_sched_barrier(0);
#pragma unroll
    for (int h = 0; h < 6; ++h) {
      float acc = breg[h];
#pragma unroll
      for (int r = 0; r < 16; ++r) acc += lr[r] * wreg[h][r];
      float alpha = expf(logsigmoidf_(acc) * (1.f / 16.f));
      float* o = grec + ((size_t)tok * 6 + h) * 256 + lane;
      o[0] = lane < 32 ? qk[h] * 0.17677669529663687f : qk[h];
      o[64] = alpha; o[128] = vv[h]; o[192] = gg[h];
    }
  }
}

__device__ __forceinline__ void prep_hyena(const Params& p, int l) {
  const float* P = (const float*)(p.ws + OFF_P);
  float* hz = (float*)(p.ws + OFF_HYZ);
  float* hx = (float*)(p.ws + OFF_HYX);
  const float* cw = p.in[I_HCW] + l * 3 * 768;
  const float* cb = p.in[I_HCB] + l * 768;
  const int c = otid() & 255, rsub = otid() >> 8;
  float w_[3][3], b_[3];
#pragma unroll
  for (int s = 0; s < 3; ++s) { b_[s] = cb[s * 256 + c]; for (int t = 0; t < 3; ++t) w_[s][t] = cw[t * 768 + s * 256 + c]; }
  for (int r0 = obid() * 8; r0 < NTOK; r0 += gridDim.x * 8) {
    float pv[4][3][3];
    int rows[4];
#pragma unroll
    for (int q = 0; q < 4; ++q) {
      const int row = r0 + q * 2 + rsub;
      rows[q] = row;
      int t, L;
      if (row < NCTX) { t = row & 255; L = 256; } else { t = (row - NCTX) & 1023; L = 1024; }
      const float* pc = P + (size_t)row * INC + C_HY + c;
#pragma unroll
      for (int s = 0; s < 3; ++s) {
        pv[q][s][1] = pc[s * 256];
        pv[q][s][0] = t > 0 ? pc[s * 256 - INC] : 0.f;
        pv[q][s][2] = t < L - 1 ? pc[s * 256 + INC] : 0.f;
      }
    }
#pragma unroll
    for (int q = 0; q < 4; ++q) {
      float u[3];
#pragma unroll
      for (int s = 0; s < 3; ++s) u[s] = pv[q][s][0] * w_[s][0] + pv[q][s][1] * w_[s][1] + pv[q][s][2] * w_[s][2] + b_[s];
      hx[(size_t)rows[q] * 256 + c] = u[0];
      hz[(size_t)rows[q] * 256 + c] = u[1] * u[2];
      ((unsigned short*)(p.ws + OFF_HZB))[(size_t)rows[q] * 256 + c] = f2bf(u[1] * u[2]);
    }
  }
}

__device__ __forceinline__ void glds16(const void* g, void* l) {
  __builtin_amdgcn_global_load_lds((const unsigned*)g, (unsigned*)l, 16, 0, 0);
}

#define VMW(n) asm volatile("s_waitcnt vmcnt(" #n ")" ::: "memory")
#define LGKM0 __builtin_amdgcn_s_waitcnt(0xC07F)
__device__ __forceinline__ float quad_sum(float x) {
  x += __int_as_float(__builtin_amdgcn_update_dpp(0, __float_as_int(x), 0xB1, 0xF, 0xF, true));
  x += __int_as_float(__builtin_amdgcn_update_dpp(0, __float_as_int(x), 0x4E, 0xF, 0xF, true));
  return x;
}

template <int R> struct RwOps { f32x4 A[2], B[2], K[2], W[2], Rr[2]; float v[R]; };
constexpr int RW_SLOT = 1536;
__device__ __forceinline__ void rw_fill(const float* recg, char* slot, int lane, int dir) {
  glds16((const char*)recg + lane * 16, slot);
  if (lane < 32) {
    const char* g2 = (const char*)recg + (lane < 16 ? 1024 + lane * 16 : (5 + dir) * 256 + (lane - 16) * 16);
    glds16(g2, slot + 1024);
  }
}
template <int R>
__device__ __forceinline__ void rw_load(RwOps<R>& o, const char* rec, int k8, int vrow) {
  const f32x4* q = (const f32x4*)rec + k8 * 2;
#pragma unroll
  for (int i = 0; i < 2; ++i) { o.Rr[i] = q[i]; o.K[i] = q[16 + i]; o.A[i] = q[48 + i]; o.B[i] = q[64 + i]; o.W[i] = q[80 + i]; }
  if (R == 2) { f32x2 t = *(const f32x2*)((const float*)rec + 128 + vrow); o.v[0] = t.x; o.v[R - 1] = t.y; }
  else o.v[0] = ((const float*)rec)[128 + vrow];
}
template <int R>
__device__ __forceinline__ void rw_step(f32x2 (&S)[R][4], const RwOps<R>& o, float (&res)[R]) {
  const f32x2 A0 = {o.A[0][0], o.A[0][1]}, A1 = {o.A[0][2], o.A[0][3]}, A2 = {o.A[1][0], o.A[1][1]}, A3 = {o.A[1][2], o.A[1][3]};
  float sa[R];
#pragma unroll
  for (int r = 0; r < R; ++r) {
    f32x2 p0 = S[r][0] * A0, q0 = S[r][1] * A1;
    p0 += S[r][2] * A2; q0 += S[r][3] * A3;
    p0 += q0;
    sa[r] = p0.x + p0.y;
  }
#pragma unroll
  for (int r = 0; r < R; ++r) sa[r] += dpp_f(sa[r], 0);
#pragma unroll
  for (int r = 0; r < R; ++r) sa[r] += dpp_f(sa[r], 1);
#pragma unroll
  for (int r = 0; r < R; ++r) sa[r] += dpp_f(sa[r], 2);
#pragma unroll
  for (int i = 0; i < 4; ++i) {
    const f32x2 W = {o.W[i >> 1][(i & 1) * 2], o.W[i >> 1][(i & 1) * 2 + 1]};
    const f32x2 B = {o.B[i >> 1][(i & 1) * 2], o.B[i >> 1][(i & 1) * 2 + 1]};
    const f32x2 K = {o.K[i >> 1][(i & 1) * 2], o.K[i >> 1][(i & 1) * 2 + 1]};
#pragma unroll
    for (int r = 0; r < R; ++r) S[r][i] = S[r][i] * W + (f32x2{sa[r], sa[r]} * B + f32x2{o.v[r], o.v[r]} * K);
  }
  const f32x2 R0 = {o.Rr[0][0], o.Rr[0][1]}, R1 = {o.Rr[0][2], o.Rr[0][3]}, R2 = {o.Rr[1][0], o.Rr[1][1]}, R3 = {o.Rr[1][2], o.Rr[1][3]};
#pragma unroll
  for (int r = 0; r < R; ++r) {
    f32x2 u0 = S[r][0] * R0, w0 = S[r][1] * R1;
    u0 += S[r][2] * R2; w0 += S[r][3] * R3;
    u0 += w0;
    res[r] = u0.x + u0.y;
  }
#pragma unroll
  for (int r = 0; r < R; ++r) res[r] += dpp_f(res[r], 0);
#pragma unroll
  for (int r = 0; r < R; ++r) res[r] += dpp_f(res[r], 1);
#pragma unroll
  for (int r = 0; r < R; ++r) res[r] += dpp_f(res[r], 2);
}

template <int NW>
__device__ __forceinline__ void rw_poll(volatile unsigned* f, unsigned target) {
  for (unsigned sp = 0; sp < (1u << 20); ++sp) {
    unsigned m = min(min(f[0], f[1]), min(f[2], f[3]));
    if (NW == 8) m = min(m, min(min(f[4], f[5]), min(f[6], f[7])));
    if ((unsigned)__builtin_amdgcn_readfirstlane((int)m) >= target) break;
    __builtin_amdgcn_s_sleep(1);
  }
  asm volatile("" ::: "memory");
}

constexpr int RQ_STEPS = 64;
template <int NW, int R, int RING>
__device__ __forceinline__ void rwkv_scan(const Params& p, int l, int scan, int w, int rowoff, char* ring, volatile unsigned* fl) {
  constexpr int LPC = 8 / NW;
  constexpr int NCHR = RING / 8;
  static_assert(NW == 4 && (RING == 64 || RING == 32), "vmcnt immediates below are written for these cases");
  const int lane = otid() & 63;
  scan = __builtin_amdgcn_readfirstlane(scan);
  w = __builtin_amdgcn_readfirstlane(w);
  int b, hd, L, rowbase;
  const bool lat = scan < 96;
  if (lat) { b = scan / 12; hd = scan % 12; L = 1024; rowbase = NCTX + b * 1024; }
  else { int t2 = scan - 96; b = t2 / 12; hd = t2 % 12; L = 256; rowbase = b * 256; }
  const int h = hd >> 1, dir = hd & 1;
  const int k8 = lane & 7, vrow = rowoff + w * (8 * R) + (lane >> 3) * R;
  const float* rec = (const float*)(p.ws + OFF_REC);
  float* RO = (float*)(p.ws + OFF_RO) + (size_t)dir * NTOK * 384 + h * 64 + vrow + (R == 2 ? (k8 & 1) : 0);
  f32x2 S[R][4];
  if (lat) {
    const float* sb = p.in[I_SR] + ((((size_t)b * DEPTH + l) * 2 + dir) * 6 + h) * 4096 + vrow * 64 + k8 * 8;
#pragma unroll
    for (int r = 0; r < R; ++r)
#pragma unroll
      for (int i = 0; i < 2; ++i) { float4 v = *(const float4*)(sb + r * 64 + i * 4); S[r][2 * i] = f32x2{v.x, v.y}; S[r][2 * i + 1] = f32x2{v.z, v.w}; }
  } else {
#pragma unroll
    for (int r = 0; r < R; ++r)
#pragma unroll
      for (int i = 0; i < 4; ++i) S[r][i] = f32x2{0.f, 0.f};
  }
  VMW(0);
  const int NCH = L >> 3;
#define RW_REC(st) (rec + ((size_t)(rowbase + (dir ? L - 1 - (st) : (st))) * 6 + h) * 512)
#define RW_SLOTP(st) (ring + ((st) & (RING - 1)) * RW_SLOT)
#pragma unroll
  for (int c = 0; c < NCHR - 1; ++c)
#pragma unroll
    for (int t = 0; t < LPC; ++t) { const int s = 8 * c + NW * t + w; rw_fill(RW_REC(s), RW_SLOTP(s), lane, dir); }
  RwOps<R> oa{};
  float osel = 0.f;
  for (int c = 0; c < NCH; ++c) {
    if (c + NCHR - 2 <= NCH - 1) { if (RING == 64) VMW(20); else VMW(4); } else VMW(0);
    if (lane == 0) fl[w] = (unsigned)(c + 2);
    rw_poll<NW>(fl, (unsigned)(c + 2));
    if (c == 0) rw_load<R>(oa, RW_SLOTP(0), k8, vrow);
    for (int j = 0; j < 8; j += 2) {
      const int s = 8 * c + j;
      RwOps<R> ob;
      LGKM0;
      rw_load<R>(ob, RW_SLOTP(s + 1), k8, vrow);
      __builtin_amdgcn_sched_barrier(0);
      {
        float o[R];
        rw_step<R>(S, oa, o);
        if (R == 2) osel = ((s & 3) == (k8 >> 1)) ? ((k8 & 1) ? o[R - 1] : o[0]) : osel;
        else osel = ((s & 7) == k8) ? o[0] : osel;
      }
      __builtin_amdgcn_sched_barrier(0);
      LGKM0;
      rw_load<R>(oa, RW_SLOTP(s + 2), k8, vrow);
      __builtin_amdgcn_sched_barrier(0);
      {
        float o[R];
        rw_step<R>(S, ob, o);
        if (R == 2) {
          osel = (((s + 1) & 3) == (k8 >> 1)) ? ((k8 & 1) ? o[R - 1] : o[0]) : osel;
          if (((s + 1) & 3) == 3) {
            const int st = s - 2 + (k8 >> 1);
            const int n = dir ? L - 1 - st : st;
            RO[(size_t)(rowbase + n) * 384] = osel;
          }
        } else {
          osel = (((s + 1) & 7) == k8) ? o[0] : osel;
          if (((s + 1) & 7) == 7) {
            const int st = s - 6 + k8;
            const int n = dir ? L - 1 - st : st;
            RO[(size_t)(rowbase + n) * 384] = osel;
          }
        }
      }
      __builtin_amdgcn_sched_barrier(0);
    }
    asm volatile("" ::: "memory");
    if (lane == 0) fl[8 + w] = (unsigned)(c + 1);
    if (c + NCHR - 1 < NCH) {
      rw_poll<NW>(fl + 8, (unsigned)c);
#pragma unroll
      for (int t = 0; t < LPC; ++t) { const int s = 8 * (c + NCHR - 1) + NW * t + w; rw_fill(RW_REC(s), RW_SLOTP(s), lane, dir); }
    }
  }
#undef RW_REC
#undef RW_SLOTP
  if (!lat) {
    float* so = p.out + (size_t)NTOK * D + (size_t)16 * DEPTH * 2 * 6 * 2048 +
                ((((size_t)b * DEPTH + l) * 2 + dir) * 6 + h) * 4096 + vrow * 64 + k8 * 8;
#pragma unroll
    for (int r = 0; r < R; ++r)
#pragma unroll
      for (int i = 0; i < 2; ++i) *(float4*)(so + r * 64 + i * 4) = make_float4(S[r][2 * i].x, S[r][2 * i].y, S[r][2 * i + 1].x, S[r][2 * i + 1].y);
  }
  VMW(0);
}

struct RwOpsLa { f32x4 An[2], B[2], K[2], W[2], Rr[2]; float v; };
__device__ __forceinline__ void rw_load_la(RwOpsLa& o, const char* rec, const char* recn, int k8, int vrow) {
  const f32x4* q = (const f32x4*)rec + k8 * 2;
  const f32x4* qn = (const f32x4*)recn + k8 * 2;
#pragma unroll
  for (int i = 0; i < 2; ++i) { o.Rr[i] = q[i]; o.K[i] = q[16 + i]; o.B[i] = q[64 + i]; o.W[i] = q[80 + i]; o.An[i] = qn[48 + i]; }
  o.v = ((const float*)rec)[128 + vrow];
}
__device__ __forceinline__ float rw_step_la(f32x2 (&S)[4], float& sa, const RwOpsLa& o) {
  f32x2 W2[4], B2[4], K2[4], A2[4], R2[4];
#pragma unroll
  for (int i = 0; i < 4; ++i) {
    const int a = i >> 1, c = (i & 1) * 2;
    W2[i] = f32x2{o.W[a][c], o.W[a][c + 1]}; B2[i] = f32x2{o.B[a][c], o.B[a][c + 1]}; K2[i] = f32x2{o.K[a][c], o.K[a][c + 1]};
    A2[i] = f32x2{o.An[a][c], o.An[a][c + 1]}; R2[i] = f32x2{o.Rr[a][c], o.Rr[a][c + 1]};
  }
  const f32x2 vv = {o.v, o.v};
  f32x2 T[4];
#pragma unroll
  for (int i = 0; i < 4; ++i) T[i] = S[i] * W2[i] + vv * K2[i];
  f32x2 g0 = T[0] * A2[0], g1 = T[1] * A2[1];
  g0 += T[2] * A2[2]; g1 += T[3] * A2[3]; g0 += g1;
  f32x2 b0 = B2[0] * A2[0], b1 = B2[1] * A2[1];
  b0 += B2[2] * A2[2]; b1 += B2[3] * A2[3]; b0 += b1;
  float gp = g0.x + g0.y, bp = b0.x + b0.y;
  gp += dpp_f(gp, 0); bp += dpp_f(bp, 0);
  gp += dpp_f(gp, 1); bp += dpp_f(bp, 1);
  gp += dpp_f(gp, 2); bp += dpp_f(bp, 2);
  const f32x2 sav = {sa, sa};
#pragma unroll
  for (int i = 0; i < 4; ++i) S[i] = sav * B2[i] + T[i];
  f32x2 u0 = S[0] * R2[0], u1 = S[1] * R2[1];
  u0 += S[2] * R2[2]; u1 += S[3] * R2[3]; u0 += u1;
  float ov = u0.x + u0.y;
  ov += dpp_f(ov, 0); ov += dpp_f(ov, 1); ov += dpp_f(ov, 2);
  sa = sa * bp + gp;
  return ov;
}

__device__ __forceinline__ void rwkv_scan_la(const Params& p, int l, int scan, int w, int rowoff, char* ring, volatile unsigned* fl) {
  constexpr int NW = 4, R = 1, RING = 64;
  constexpr int LPC = 8 / NW;
  constexpr int NCHR = RING / 8;
  static_assert(NW == 4 && (RING == 64 || RING == 32), "vmcnt immediates below are written for these cases");
  const int lane = otid() & 63;
  scan = __builtin_amdgcn_readfirstlane(scan);
  w = __builtin_amdgcn_readfirstlane(w);
  int b, hd, L, rowbase;
  const bool lat = scan < 96;
  if (lat) { b = scan / 12; hd = scan % 12; L = 1024; rowbase = NCTX + b * 1024; }
  else { int t2 = scan - 96; b = t2 / 12; hd = t2 % 12; L = 256; rowbase = b * 256; }
  const int h = hd >> 1, dir = hd & 1;
  const int k8 = lane & 7, vrow = rowoff + w * (8 * R) + (lane >> 3) * R;
  const float* rec = (const float*)(p.ws + OFF_REC);
  float* RO = (float*)(p.ws + OFF_RO) + (size_t)dir * NTOK * 384 + h * 64 + vrow + (R == 2 ? (k8 & 1) : 0);
  f32x2 S[R][4];
  if (lat) {
    const float* sb = p.in[I_SR] + ((((size_t)b * DEPTH + l) * 2 + dir) * 6 + h) * 4096 + vrow * 64 + k8 * 8;
#pragma unroll
    for (int r = 0; r < R; ++r)
#pragma unroll
      for (int i = 0; i < 2; ++i) { float4 v = *(const float4*)(sb + r * 64 + i * 4); S[r][2 * i] = f32x2{v.x, v.y}; S[r][2 * i + 1] = f32x2{v.z, v.w}; }
  } else {
#pragma unroll
    for (int r = 0; r < R; ++r)
#pragma unroll
      for (int i = 0; i < 4; ++i) S[r][i] = f32x2{0.f, 0.f};
  }
  VMW(0);
  const int NCH = L >> 3;
#define RW_REC(st) (rec + ((size_t)(rowbase + (dir ? L - 1 - (st) : (st))) * 6 + h) * 512)
#define RW_SLOTP(st) (ring + ((st) & (RING - 1)) * RW_SLOT)
#pragma unroll
  for (int c = 0; c < NCHR - 1; ++c)
#pragma unroll
    for (int t = 0; t < LPC; ++t) { const int s = 8 * c + NW * t + w; rw_fill(RW_REC(s), RW_SLOTP(s), lane, dir); }
  RwOpsLa oa{};
  float sa = 0.f;
  float osel = 0.f;
  for (int c = 0; c < NCH; ++c) {
    if (c + NCHR - 2 <= NCH - 1) { if (RING == 64) VMW(20); else VMW(4); } else VMW(0);
    if (lane == 0) fl[w] = (unsigned)(c + 2);
    rw_poll<NW>(fl, (unsigned)(c + 2));
    if (c == 0) {
      const f32x4* q0 = (const f32x4*)RW_SLOTP(0) + k8 * 2;
      const f32x4 a0 = q0[48], a1 = q0[49];
      f32x2 d0 = S[0][0] * f32x2{a0[0], a0[1]}, d1 = S[0][1] * f32x2{a0[2], a0[3]};
      d0 += S[0][2] * f32x2{a1[0], a1[1]}; d1 += S[0][3] * f32x2{a1[2], a1[3]};
      d0 += d1;
      sa = d0.x + d0.y;
      sa += dpp_f(sa, 0); sa += dpp_f(sa, 1); sa += dpp_f(sa, 2);
      rw_load_la(oa, RW_SLOTP(0), RW_SLOTP(1), k8, vrow);
    }
    for (int j = 0; j < 8; j += 2) {
      const int s = 8 * c + j;
      RwOpsLa ob;
      LGKM0;
      rw_load_la(ob, RW_SLOTP(s + 1), RW_SLOTP(s + 2), k8, vrow);
      __builtin_amdgcn_sched_barrier(0);
      {
        float o[R];
        o[0] = rw_step_la(S[0], sa, oa);
        if (R == 2) osel = ((s & 3) == (k8 >> 1)) ? ((k8 & 1) ? o[R - 1] : o[0]) : osel;
        else osel = ((s & 7) == k8) ? o[0] : osel;
      }
      __builtin_amdgcn_sched_barrier(0);
      LGKM0;
      rw_load_la(oa, RW_SLOTP(s + 2), RW_SLOTP(s + 3), k8, vrow);
      __builtin_amdgcn_sched_barrier(0);
      {
        float o[R];
        o[0] = rw_step_la(S[0], sa, ob);
        if (R == 2) {
          osel = (((s + 1) & 3) == (k8 >> 1)) ? ((k8 & 1) ? o[R - 1] : o[0]) : osel;
          if (((s + 1) & 3) == 3) {
            const int st = s - 2 + (k8 >> 1);
            const int n = dir ? L - 1 - st : st;
            RO[(size_t)(rowbase + n) * 384] = osel;
          }
        } else {
          osel = (((s + 1) & 7) == k8) ? o[0] : osel;
          if (((s + 1) & 7) == 7) {
            const int st = s - 6 + k8;
            const int n = dir ? L - 1 - st : st;
            RO[(size_t)(rowbase + n) * 384] = osel;
          }
        }
      }
      __builtin_amdgcn_sched_barrier(0);
    }
    asm volatile("" ::: "memory");
    if (lane == 0) fl[8 + w] = (unsigned)(c + 1);
    if (c + NCHR - 1 < NCH) {
      rw_poll<NW>(fl + 8, (unsigned)c);
#pragma unroll
      for (int t = 0; t < LPC; ++t) { const int s = 8 * (c + NCHR - 1) + NW * t + w; rw_fill(RW_REC(s), RW_SLOTP(s), lane, dir); }
    }
  }
#undef RW_REC
#undef RW_SLOTP
  if (!lat) {
    float* so = p.out + (size_t)NTOK * D + (size_t)16 * DEPTH * 2 * 6 * 2048 +
                ((((size_t)b * DEPTH + l) * 2 + dir) * 6 + h) * 4096 + vrow * 64 + k8 * 8;
#pragma unroll
    for (int r = 0; r < R; ++r)
#pragma unroll
      for (int i = 0; i < 2; ++i) *(float4*)(so + r * 64 + i * 4) = make_float4(S[r][2 * i].x, S[r][2 * i].y, S[r][2 * i + 1].x, S[r][2 * i + 1].y);
  }
  VMW(0);
}

template <int NE> struct GlOps { f32x4 Q[2], K[2], A[2]; float v[NE]; };
constexpr int GL_RING = 32, GL_SLOT = 768;
template <int NE>
__device__ __forceinline__ void gl_load(GlOps<NE>& o, const char* rec, int dir, int dq, int ecol) {
  const f32x4* q = (const f32x4*)rec;
#pragma unroll
  for (int i = 0; i < 2; ++i) { o.Q[i] = q[dq * 2 + i]; o.K[i] = q[8 + dq * 2 + i]; o.A[i] = q[16 + dir * 8 + dq * 2 + i]; }
  if (NE == 4) { f32x4 t = *(const f32x4*)((const float*)rec + 128 + ecol); o.v[0] = t[0]; o.v[1] = t[1]; o.v[NE - 2] = t[2]; o.v[NE - 1] = t[3]; }
  else { f32x2 t = *(const f32x2*)((const float*)rec + 128 + ecol); o.v[0] = t.x; o.v[1] = t.y; }
}
template <int NE>
__device__ __forceinline__ float gl_step(f32x2 (&S)[8][NE / 2], const GlOps<NE>& o, int dq) {
  f32x2 vv[NE / 2], acc[NE / 2];
#pragma unroll
  for (int e = 0; e < NE / 2; ++e) { vv[e] = f32x2{o.v[2 * e], o.v[2 * e + 1]}; acc[e] = f32x2{0.f, 0.f}; }
#pragma unroll
  for (int d = 0; d < 8; ++d) {
    const float a = o.A[d >> 2][d & 3], kk = o.K[d >> 2][d & 3], qq = o.Q[d >> 2][d & 3];
    const f32x2 av = {a, a}, kv = {kk, kk}, qv = {qq, qq};
#pragma unroll
    for (int e = 0; e < NE / 2; ++e) { S[d][e] = av * S[d][e] + kv * vv[e]; acc[e] += qv * S[d][e]; }
  }
  if (NE == 4) {
    const float r0 = quad_sum(acc[0].x), r1 = quad_sum(acc[0].y), r2 = quad_sum(acc[NE / 2 - 1].x), r3 = quad_sum(acc[NE / 2 - 1].y);
    return dq == 0 ? r0 : (dq == 1 ? r1 : (dq == 2 ? r2 : r3));
  } else {
    const float r0 = quad_sum(acc[0].x), r1 = quad_sum(acc[0].y);
    return (dq & 1) ? r1 : r0;
  }
}
template <int NE>
__device__ __forceinline__ void gla_scan(const Params& p, int l, int task, int eh, char* ring  ) {
  const int lane = otid() & 63;
  task = __builtin_amdgcn_readfirstlane(task);
  int b, hd, L, rowbase;
  const bool lat = task < 96;
  if (lat) { b = task / 12; hd = task % 12; L = 1024; rowbase = NCTX + b * 1024; }
  else { int t2 = task - 96; b = t2 / 12; hd = t2 % 12; L = 256; rowbase = b * 256; }
  const int h = hd >> 1, dir = hd & 1;
  const int dq = lane & 3, eg = lane >> 2;
  const int ecol = (NE == 4) ? eg * 4 : eh * 32 + eg * 2;
  const bool owner = (NE == 4) || dq < 2;
  const float* grec = (const float*)(p.ws + OFF_GREC);
  float* GO = (float*)(p.ws + OFF_GO) + (size_t)dir * NTOK * 384 + h * 64 + ecol + (NE == 4 ? dq : (dq & 1));
  f32x2 S[8][NE / 2];
  if (lat) {
    const float* s0 = p.in[I_SG] + ((((size_t)b * DEPTH + l) * 2 + dir) * 6 + h) * 2048 + (dq * 8) * 64 + ecol;
#pragma unroll
    for (int d = 0; d < 8; ++d)
#pragma unroll
      for (int e = 0; e < NE / 2; ++e) { f32x2 v = *(const f32x2*)(s0 + d * 64 + 2 * e); S[d][e] = v; }
  } else {
#pragma unroll
    for (int d = 0; d < 8; ++d)
#pragma unroll
      for (int e = 0; e < NE / 2; ++e) S[d][e] = f32x2{0.f, 0.f};
  }
  VMW(0);
#define GL_REC(st) ((const char*)(grec + ((size_t)(rowbase + (dir ? L - 1 - (st) : (st))) * 6 + h) * 256))
#pragma unroll
  for (int s = 0; s < GL_RING; ++s) { if (lane < 48) glds16(GL_REC(s) + lane * 16, ring + s * GL_SLOT); }
  GlOps<NE> oa{};
  VMW(31);
  gl_load<NE>(oa, ring, dir, dq, ecol);
  for (int s = 0; s < L; s += 2) {
    GlOps<NE> ob;
    LGKM0; if (s + GL_RING >= L) VMW(0); else VMW(30);
    gl_load<NE>(ob, ring + ((s + 1) & (GL_RING - 1)) * GL_SLOT, dir, dq, ecol);
    __builtin_amdgcn_sched_barrier(0);
    {
      float o = gl_step<NE>(S, oa, dq);
      const int n = dir ? L - 1 - s : s;
      if (owner) GO[(size_t)(rowbase + n) * 384] = o;
    }
    asm volatile("" ::: "memory");
    if (s + GL_RING < L && lane < 48) glds16(GL_REC(s + GL_RING) + lane * 16, ring + (s & (GL_RING - 1)) * GL_SLOT);
    __builtin_amdgcn_sched_barrier(0);
    LGKM0; if (s + 1 + GL_RING >= L) VMW(0); else VMW(30);
    gl_load<NE>(oa, ring + ((s + 2) & (GL_RING - 1)) * GL_SLOT, dir, dq, ecol);
    __builtin_amdgcn_sched_barrier(0);
    {
      float o = gl_step<NE>(S, ob, dq);
      const int n = dir ? L - 2 - s : s + 1;
      if (owner) GO[(size_t)(rowbase + n) * 384] = o;
    }
    asm volatile("" ::: "memory");
    if (s + 1 + GL_RING < L && lane < 48) glds16(GL_REC(s + 1 + GL_RING) + lane * 16, ring + ((s + 1) & (GL_RING - 1)) * GL_SLOT);
    __builtin_amdgcn_sched_barrier(0);
  }
#undef GL_REC
  if (!lat) {
    float* so = p.out + (size_t)NTOK * D + ((((size_t)b * DEPTH + l) * 2 + dir) * 6 + h) * 2048 + (dq * 8) * 64 + ecol;
#pragma unroll
    for (int d = 0; d < 8; ++d)
#pragma unroll
      for (int e = 0; e < NE / 2; ++e) *(f32x2*)(so + d * 64 + 2 * e) = S[d][e];
  }
  VMW(0);
}

constexpr int HY_TASKS = 768;
__device__ __forceinline__ void hyena_task(const Params& p, int l, int task) {
  const int lane = otid() & 63;
  int b, cgp, tb, L, rowbase;
  const float* ft = (const float*)(p.ws + OFF_FT) + (size_t)l * FT_LAYER;
  if (task < 512) { b = task >> 6; cgp = (task >> 5) & 1; tb = task & 31; L = 1024; rowbase = NCTX + b * 1024; ft += FT_L0; }
  else { int t2 = task - 512; b = t2 >> 4; cgp = (t2 >> 3) & 1; tb = t2 & 7; L = 256; rowbase = b * 256; }
  const int c = cgp * 128 + lane * 2;
  const int t0 = tb * 32;
  const float* hz = (const float*)(p.ws + OFF_HYZ) + (size_t)rowbase * 256 + c;
  const float* hx = (const float*)(p.ws + OFF_HYX) + (size_t)rowbase * 256 + c;
  const float* fc = ft + c;
  const unsigned short* hzb = (const unsigned short*)(p.ws + OFF_HZB) + (size_t)rowbase * 256 + c;
  const unsigned short* fcb = (const unsigned short*)(p.ws + OFF_FTB) + (size_t)(ft - (const float*)(p.ws + OFF_FT)) + c;
  f32x2 acc[32];
#pragma unroll
  for (int i = 0; i < 32; ++i) acc[i] = f32x2{0.f, 0.f};
  for (int s0 = 0; s0 < L; s0 += 16) {
    f32x2 z[16], f[47];
#pragma unroll
    for (int j = 0; j < 16; ++j) { const unsigned u = *(const unsigned*)(hzb + (size_t)(s0 + j) * 256); z[j] = f32x2{__uint_as_float(u << 16), __uint_as_float(u & 0xffff0000u)}; }
    const unsigned short* fb = fcb + (size_t)(t0 - s0 - 15 + L - 1) * 256;
#pragma unroll
    for (int m = 0; m < 47; ++m) { const unsigned u = *(const unsigned*)(fb + (size_t)m * 256); f[m] = f32x2{__uint_as_float(u << 16), __uint_as_float(u & 0xffff0000u)}; }
#pragma unroll
    for (int i = 0; i < 32; ++i)
#pragma unroll
      for (int j = 0; j < 16; ++j) acc[i] += f[i - j + 15] * z[j];
  }
  const f32x2 bias = *(const f32x2*)(p.in[I_HBIAS] + l * 256 + c);
  unsigned* O = (unsigned*)(p.ws + OFF_H);
#pragma unroll
  for (int i = 0; i < 32; ++i) {
    int t = t0 + i;
    f32x2 zz = *(const f32x2*)(hz + (size_t)t * 256), xx = *(const f32x2*)(hx + (size_t)t * 256);
    f32x2 y = xx * (acc[i] + zz * bias);
    O[((size_t)(rowbase + t) * D + 384 + c) >> 1] = (unsigned)f2bf(y.x) | ((unsigned)f2bf(y.y) << 16);
  }
}

constexpr int LDS_GLA = 98304, LDS_FLAGS = 147456, LDS_XB = 147584;
__device__ __forceinline__ void phase_mixers(const Params& p, int l, int cidx) {
  const int wave = otid() >> 6, lane = otid() & 63;
  const int bid = obid();
  volatile unsigned* fl = (volatile unsigned*)(smem + LDS_FLAGS);
  if (otid() < 32) fl[otid()] = 0u;
  __syncthreads();
  __builtin_amdgcn_s_setprio(3);
  if (bid < 192) {
    if (wave < 4) rwkv_scan_la(p, l, bid >> 1, wave, (bid & 1) * 32, smem, fl);
    else rwkv_scan<4, 2, 32>(p, l, 96 + bid, wave - 4, 0, smem + 98304, fl + 16);
  } else if (wave < 3) {
    const int g = (bid - 192) * 3 + wave;
    gla_scan<2>(p, l, g >> 1, g & 1, smem + wave * 24576);
  } else if (wave < 6) {
    gla_scan<4>(p, l, 96 + (bid - 192) * 3 + (wave - 3), 0, smem + wave * 24576);
  }
  __builtin_amdgcn_s_setprio(0);
  int* cnt = (int*)(p.ws + OFF_CNT) + cidx;
  const int ntask = HY_TASKS + (l < DEPTH - 1 ? 5312 : 0);
  while (true) {
    int t = 0;
    if (lane == 0) t = atomicAdd(cnt, 1);
    t = __shfl(t, 0);
    if (t >= ntask) break;
    if (t < HY_TASKS) hyena_task(p, l, t);
    else wconv_wave(p, l + 1, (l + 1) & 1, t - HY_TASKS);
  }
}

__device__ __forceinline__ void phase_post(const Params& p, int l) {
  const int wave = otid() >> 6, lane = otid() & 63;
  const float* GO = (const float*)(p.ws + OFF_GO);
  const float* RO = (const float*)(p.ws + OFF_RO);
  const float* grec = (const float*)(p.ws + OFF_GREC);
  const float* rec = (const float*)(p.ws + OFF_REC);
  unsigned short* O = (unsigned short*)(p.ws + OFF_H);
  const float gn = p.in[I_GN][l * 64 + lane];
  float lw[6], lb[6], rk[6];
#pragma unroll
  for (int h = 0; h < 6; ++h) { lw[h] = p.in[I_RLW][l * 384 + h * 64 + lane]; lb[h] = p.in[I_RLB][l * 384 + h * 64 + lane]; rk[h] = p.in[I_RRK][l * 384 + h * 64 + lane]; }
  const int nw = gridDim.x * 8;
  constexpr int NR = 3;
  for (int R0 = obid() * 8 + wave; R0 < NTOK; R0 += NR * nw) {
    float go[NR][6], gg[NR][6], ro[NR][6], r_[NR][6], k_[NR][6], v_[NR][6], g_[NR][6];
    int Rq[NR];
#pragma unroll
    for (int q = 0; q < NR; ++q) {
      const int R = (R0 + q * nw < NTOK) ? R0 + q * nw : R0;
      Rq[q] = R;
#pragma unroll
      for (int h = 0; h < 6; ++h) {
        go[q][h] = GO[(size_t)R * 384 + h * 64 + lane] + GO[(size_t)(NTOK + R) * 384 + h * 64 + lane];
        gg[q][h] = grec[((size_t)R * 6 + h) * 256 + 192 + lane];
        ro[q][h] = RO[(size_t)R * 384 + h * 64 + lane] + RO[(size_t)(NTOK + R) * 384 + h * 64 + lane];
        const float* rr = rec + ((size_t)R * 6 + h) * 512 + lane;
        r_[q][h] = rr[0]; k_[q][h] = rr[64]; v_[q][h] = rr[128]; g_[q][h] = rr[448];
      }
    }
    __builtin_amdgcn_sched_barrier(0);
#pragma unroll
    for (int q = 0; q < NR; ++q) {
      if (q >= 1 && R0 + q * nw >= NTOK) break;
      const int R = Rq[q];
      const int tokr = scan2tok(R);
#pragma unroll
      for (int h = 0; h < 6; ++h) {
        const float o = go[q][h];
        float ms = wave_sum(o * o) * (1.f / 64.f);
        float y = o * rsqrtf(ms + 1e-6f) * gn;
        O[(size_t)R * D + h * 64 + lane] = f2bf(y * siluf_(gg[q][h]));
      }
#pragma unroll
      for (int h = 0; h < 6; ++h) {
        const int c = h * 64 + lane;
        const float o = ro[q][h];
        float mean = wave_sum(o) * (1.f / 64.f);
        float dlt = o - mean;
        float var = wave_sum(dlt * dlt) * (1.f / 64.f);
        float y = dlt * rsqrtf(var + 64e-5f) * lw[h] + lb[h];
        float bonus = wave_sum(r_[q][h] * k_[q][h] * rk[h]) * v_[q][h];
        O[(size_t)tokr * D + 640 + c] = f2bf((y + bonus) * g_[q][h]);
      }
    }
  }
}

#define XB_TMO      128
#define XB_XCNT(j)  (256  + 64 * (j))
#define XB_XSUB(j)  (1280 + 64 * (j))
#define XB_XGEN(j)  (2304 + 64 * (j))
#define XB_TOP      3328
#define XB_TOPGEN   3392
#define XCD_BAR_WORDS 3456
#define XB_SPIN_CAP (1u << 18)
#define LAS __attribute__((address_space(3)))

__device__ __forceinline__ unsigned xb_ld(unsigned* p)              { return __hip_atomic_load(p, __ATOMIC_RELAXED, __HIP_MEMORY_SCOPE_AGENT); }
__device__ __forceinline__ unsigned xb_add(unsigned* p, unsigned v) { return __hip_atomic_fetch_add(p, v, __ATOMIC_RELAXED, __HIP_MEMORY_SCOPE_AGENT); }
__device__ __forceinline__ unsigned xb_xcc_id() { return (unsigned)__builtin_amdgcn_s_getreg((3 << 11) | 20) & 0xFu; }
#define XB_SPIN(cond, bar) do { unsigned _sp = 0; while (cond) { __builtin_amdgcn_s_sleep(1); \
    if ((++_sp & 255u) == 0u) { if (xb_ld(&(bar)[XB_TMO])) break; if (_sp > XB_SPIN_CAP) { atomicAdd(&(bar)[XB_TMO], 1u); break; } } } } while (0)

struct XcdBarrier {
    unsigned* bar; unsigned x;
    volatile LAS unsigned* st;
};

__device__ __forceinline__ XcdBarrier xcd_barrier_post(unsigned* bar, volatile LAS unsigned* st) {
    XcdBarrier b; b.bar = bar; b.x = xb_xcc_id(); b.st = st;
    if (threadIdx.x == 0) (void)xb_add(&bar[XB_XCNT(b.x)], 1u);
    return b;
}
__device__ __forceinline__ void xcd_barrier_complete(unsigned* bar, unsigned x, unsigned& nloc, unsigned& nx) {
    const unsigned G = gridDim.x * gridDim.y * gridDim.z;
    unsigned sum, cnt, mine, sp = 0u;
    for (;;) {
        sum = 0u; cnt = 0u; mine = 0u;
#pragma unroll
        for (unsigned j = 0; j < 16; ++j) { const unsigned c = xb_ld(&bar[XB_XCNT(j)]); sum += c; cnt += (c > 0u) ? 1u : 0u; mine = (j == x) ? c : mine; }
        if (sum == G) break;
        __builtin_amdgcn_s_sleep(1);
        if ((++sp & 255u) == 0u) { if (xb_ld(&bar[XB_TMO])) break; if (sp > XB_SPIN_CAP) { atomicAdd(&bar[XB_TMO], 1u); break; } }
    }
    nloc = mine > 0u ? mine : 1u; nx = cnt > 0u ? cnt : 1u;
}

__device__ __forceinline__ void xcd_barrier(const XcdBarrier& b) {
    asm volatile("s_waitcnt vmcnt(0)" ::: "memory");
    __syncthreads();
    if (threadIdx.x == 0) {
        unsigned* bar = b.bar;
        __builtin_amdgcn_s_waitcnt(0);
        unsigned nloc = b.st[0], nx = b.st[1];
        if (nloc == 0u) { xcd_barrier_complete(bar, b.x, nloc, nx); b.st[0] = nloc; b.st[1] = nx; }
        const unsigned old = xb_add(&bar[XB_XSUB(b.x)], 1u);
        const unsigned gen = old / nloc;
        if (old + 1u == (gen + 1u) * nloc) {
            __builtin_amdgcn_fence(__ATOMIC_RELEASE, "agent");
            asm volatile("s_waitcnt vmcnt(0)" ::: "memory");
            const unsigned og = xb_add(&bar[XB_TOP], 1u);
            const unsigned tg = og / nx;
            if (og + 1u == (tg + 1u) * nx) xb_add(&bar[XB_TOPGEN], 1u);
            else XB_SPIN(xb_ld(&bar[XB_TOPGEN]) == tg, bar);
            __builtin_amdgcn_fence(__ATOMIC_ACQUIRE, "agent");
            xb_add(&bar[XB_XGEN(b.x)], 1u);
            asm volatile("s_waitcnt vmcnt(0)" ::: "memory");
        } else {
            XB_SPIN(xb_ld(&bar[XB_XGEN(b.x)]) == gen, bar);
            __builtin_amdgcn_fence(__ATOMIC_ACQUIRE, "agent");
            asm volatile("s_waitcnt vmcnt(0)" ::: "memory");
        }
    }
    __syncthreads();
}

__global__ void __launch_bounds__(NTHR) fwd_megakernel(Params p) {
  cg::grid_group grid = cg::this_grid();
  if (threadIdx.x == 0) *(uint4*)(smem + 147584) = make_uint4(0u, 0u, 0u, 0u);
  __syncthreads();
  XcdBarrier xb = xcd_barrier_post((unsigned*)(p.ws + OFF_BAR), (volatile LAS unsigned*)(smem + 147584));
  if (obid() == 0 && otid() < 64) ((int*)(p.ws + OFF_CNT))[otid()] = 0;
  p0_filters(p);
  p0_mod(p);
  __syncthreads();
  phase_wconv(p, 0, 0);
  bf16* hbuf = (bf16*)(p.ws + OFF_H);
  bf16* hmid = (bf16*)(p.ws + OFF_HMID);
  float* xw = (float*)(p.ws + OFF_X);
  float* Pw = (float*)(p.ws + OFF_P);
  for (int l = 0; l < DEPTH; ++l) {
    const float* modl = (const float*)(p.ws + OFF_MOD) + (size_t)l * 9 * 9216;
    const size_t wset = (size_t)(l & 1) * WSET;
    if (l == 0) grid.sync();
    if (l == 0) phase_norm<true>(p, p.in[I_F1N] + l * D, modl, 0, 1); else phase_norm<false>(p, p.in[I_F1N] + l * D, modl, 0, 1);
    xcd_barrier(xb);
    phase_gemm(hbuf, p.ws + OFF_W1I + wset, 5632, 1024, EpiSwiglu{(unsigned short*)hmid});
    xcd_barrier(xb);
    phase_gemm(hmid, p.ws + OFF_W1O + wset, 1024, 2816, EpiResid{xw, modl, 2, 0.5f});
    xcd_barrier(xb);
    phase_norm<false>(p, p.in[I_MN] + l * D, modl, 3, 4);
    xcd_barrier(xb);
    phase_gemm(hbuf, p.ws + OFF_WMI + wset, INCP, 1024, EpiP{Pw});
    xcd_barrier(xb);
    prep_rwkv(p, l);
    prep_gla(p, l);
    prep_hyena(p, l);
    xcd_barrier(xb);
    phase_mixers(p, l, l);
    xcd_barrier(xb);
    phase_post(p, l);
    xcd_barrier(xb);
    phase_gemm(hbuf, p.ws + OFF_WMO + wset, 1024, 1024, EpiResid{xw, modl, 5, 1.0f});
    xcd_barrier(xb);
    phase_norm<false>(p, p.in[I_F2N] + l * D, modl, 6, 7);
    xcd_barrier(xb);
    phase_gemm(hbuf, p.ws + OFF_W2I + wset, 5632, 1024, EpiSwiglu{(unsigned short*)hmid});
    xcd_barrier(xb);
    phase_gemm(hmid, p.ws + OFF_W2O + wset, 1024, 2816, EpiResid{xw, modl, 8, 0.5f});
    xcd_barrier(xb);
  }
  phase_final_norm(p);
}

extern "C" void kernel_launch(void* const* d_in, const int* in_sizes, int n_in, void* d_out, int out_size, void* d_ws,
                              size_t ws_size, hipStream_t stream) {
  static int grid_blocks = 0;
  if (!grid_blocks) {
    int dev = 0, cus = 0, per_cu = 0;
    (void)hipGetDevice(&dev);
    (void)hipDeviceGetAttribute(&cus, hipDeviceAttributeMultiprocessorCount, dev);
    (void)hipFuncSetAttribute((const void*)fwd_megakernel, hipFuncAttributeMaxDynamicSharedMemorySize, LDS_BYTES);
    (void)hipOccupancyMaxActiveBlocksPerMultiprocessor(&per_cu, fwd_megakernel, NTHR, LDS_BYTES);
    if (per_cu < 1) per_cu = 1;
    grid_blocks = cus * per_cu;
    if (grid_blocks > 256) grid_blocks = 256;
  }
  if (ws_size < WS_NEED) fprintf(stderr, "workspace too small: %zu < %zu\n", ws_size, (size_t)WS_NEED);
  (void)hipMemsetAsync((char*)d_ws + OFF_BAR, 0, 16384, stream);
  Params p{};
  for (int i = 0; i < 41; ++i) p.in[i] = (const float*)d_in[i];
  p.out = (float*)d_out;
  p.ws = (char*)d_ws;
  void* args[] = {&p};
  hipError_t e = hipLaunchCooperativeKernel((void*)fwd_megakernel, dim3(grid_blocks), dim3(NTHR), args, LDS_BYTES, stream);
  if (e != hipSuccess) fprintf(stderr, "cooperative launch failed: %s (grid %d)\n", hipGetErrorString(e), grid_blocks);
}
```
